# Optimizing an MI355X kernel written in HIP

```python
import jax
import jax.numpy as jnp
from jax import lax
import numpy as np

D_MODEL = 2048
BATCH = 2
SEQ = 4096
DEPTH = 2
DEC_BATCH = 8
DEC_SEQ = 4
PAST_LEN = 16384
PAGE_SIZE = 128

N_MIXERS = 2
N_NSA_LAYERS = (DEPTH + 1) // 2
N_RET_LAYERS = DEPTH // 2
N_HEADS = 16
HEAD_DIM = D_MODEL // N_HEADS
N_KV_HEADS = 4
GQA_GROUP = N_HEADS // N_KV_HEADS
CMP_BLOCK = 32
CMP_STRIDE = 16
CMP_RATIO = CMP_BLOCK // CMP_STRIDE
CMP_HIDDEN = HEAD_DIM
SEL_BLOCK = 64
N_SEL = 16
N_LOCAL = 2
WINDOW = 512
Q_BLOCK = 128
ROPE_THETA = 10000.0
RET_HEADS = 8
RET_KDIM = D_MODEL // RET_HEADS
RET_VDIM = 2 * D_MODEL // RET_HEADS
RET_CHUNK = 128
D_FF = 4 * D_MODEL
NSA_PROJ = N_HEADS * HEAD_DIM + 6 * N_KV_HEADS * HEAD_DIM + 3 * N_HEADS
RET_PROJ = 2 * RET_HEADS * RET_KDIM + 2 * RET_HEADS * RET_VDIM
RMS_EPS = 1e-6
GN_EPS = 1e-5
NEG_INF = -1e30
FORCE_SCORE = 1e9
F32 = jnp.float32

kernel_name = 'nsa_retention_hybrid_step'


def rms_norm(x, g):
    xf = x.astype(F32)
    y = xf * lax.rsqrt(jnp.mean(xf * xf, axis=-1, keepdims=True) + RMS_EPS)
    return (y * g.astype(F32)).astype(x.dtype)


def rope(x, pos):
    half = x.shape[-1] // 2
    inv = ROPE_THETA ** (-jnp.arange(half, dtype=F32) / half)
    ang = pos.astype(F32)[:, None] * inv[None, :]
    cos = jnp.cos(ang)[None, :, None, :]
    sin = jnp.sin(ang)[None, :, None, :]
    xf = x.astype(F32)
    x1, x2 = xf[..., :half], xf[..., half:]
    return jnp.concatenate([x1 * cos - x2 * sin, x2 * cos + x1 * sin], axis=-1).astype(x.dtype)


def masked_softmax(s, mask):
    p = jax.nn.softmax(jnp.where(mask, s, NEG_INF), axis=-1)
    return jnp.where(mask, p, 0.0)


def gqa_attend(q, k, v, mask):
    b, tq, h, dh = q.shape
    g = k.shape[2]
    qg = q.reshape(b, tq, g, h // g, dh)
    s = jnp.einsum('bqgrd,bsgd->bgrqs', qg, k).astype(F32) * dh ** -0.5
    p = masked_softmax(s, mask)
    o = jnp.einsum('bgrqs,bsgd->bqgrd', p.astype(v.dtype), v)
    return o.reshape(b, tq, h, dh)


def window_mask(q_pos, k_pos):
    d = q_pos[:, None] - k_pos[None, :]
    return (d >= 0) & (d < WINDOW) & (k_pos[None, :] >= 0)


def nsa_project(x, w_in, pos):
    b, t, _ = x.shape
    nq = N_HEADS * HEAD_DIM
    nkv = 6 * N_KV_HEADS * HEAD_DIM
    z = x @ w_in
    q = rope(z[..., :nq].reshape(b, t, N_HEADS, HEAD_DIM), pos)
    kv = z[..., nq:nq + nkv].reshape(b, t, 3, 2, N_KV_HEADS, HEAD_DIM)
    k = rope(kv[:, :, :, 0].reshape(b, t, 3 * N_KV_HEADS, HEAD_DIM), pos).reshape(b, t, 3, N_KV_HEADS, HEAD_DIM)
    kv = jnp.stack([k, kv[:, :, :, 1]], axis=3)
    gates = jax.nn.sigmoid(z[..., nq + nkv:].astype(F32)).reshape(b, t, 3, N_HEADS)
    return q, kv[:, :, 0], kv[:, :, 1], kv[:, :, 2], gates


def compress_blocks(kv_raw, cmp_pos, w1, b1, w2):
    b, length = kv_raw.shape[:2]
    n_chunks = length // CMP_STRIDE
    n_cmp = n_chunks - CMP_RATIO + 1
    xc = kv_raw[:, :n_chunks * CMP_STRIDE].reshape(b, n_chunks, CMP_STRIDE, 2, N_KV_HEADS, HEAD_DIM)
    w1r = w1.reshape(2, CMP_RATIO, CMP_STRIDE, HEAD_DIM, CMP_HIDDEN)
    per = jnp.einsum('bcsegd,ersdh->rbcegh', xc, w1r)
    pos_term = jnp.einsum('ersd,ersdh->eh', cmp_pos.reshape(2, CMP_RATIO, CMP_STRIDE, HEAD_DIM), w1r)
    h = per[0, :, 0:n_cmp]
    for r in range(1, CMP_RATIO):
        h = h + per[r, :, r:r + n_cmp]
    h = jax.nn.gelu(h.astype(F32) + (pos_term + b1).astype(F32)[:, None, :])
    out = jnp.einsum('bcegh,ehd->bcegd', h.astype(w2.dtype), w2)
    return out[:, :, 0], out[:, :, 1]


def cmp_branch(q, k_c, v_c, q_pos):
    b, tq, h, dh = q.shape
    n_cmp = k_c.shape[1]
    blk_last = jnp.arange(n_cmp) * CMP_STRIDE + CMP_BLOCK - 1
    mask = blk_last[None, :] <= q_pos[:, None]
    qg = q.reshape(b, tq, N_KV_HEADS, GQA_GROUP, dh)
    s = jnp.einsum('bqgrd,bcgd->bgrqc', qg, k_c).astype(F32) * dh ** -0.5
    p = masked_softmax(s, mask)
    o = jnp.einsum('bgrqc,bcgd->bqgrd', p.astype(v_c.dtype), v_c).reshape(b, tq, h, dh)
    return o, p.sum(axis=2)


def select_blocks(imp_cmp, q_pos, n_blk):
    n_cmp = imp_cmp.shape[-1]
    c0 = jnp.arange(n_cmp) * CMP_STRIDE
    j0 = jnp.arange(n_blk) * SEL_BLOCK
    cover = ((c0[:, None] < j0[None, :] + SEL_BLOCK) & (c0[:, None] + CMP_BLOCK > j0[None, :])).astype(F32)
    imp = jnp.einsum('bgqc,cj->bgqj', imp_cmp, cover)
    jb = jnp.arange(n_blk)[None, :]
    cur = (q_pos // SEL_BLOCK)[:, None]
    visible = jb <= cur
    forced = (jb == 0) | (visible & (jb > cur - N_LOCAL))
    imp = jnp.where(forced, FORCE_SCORE, jnp.where(visible, imp, -FORCE_SCORE))
    _, idx = lax.top_k(imp, min(N_SEL, n_blk))
    return idx


def sel_branch(q, k_blk, v_blk, idx, q_pos):
    b, tq, h, dh = q.shape
    n_top = idx.shape[-1]
    take = jax.vmap(jax.vmap(lambda blocks, i: blocks[i]))
    kg = take(k_blk.transpose(0, 3, 1, 2, 4), idx).reshape(b, N_KV_HEADS, tq, n_top * SEL_BLOCK, dh)
    vg = take(v_blk.transpose(0, 3, 1, 2, 4), idx).reshape(b, N_KV_HEADS, tq, n_top * SEL_BLOCK, dh)
    k_pos = (idx[..., None] * SEL_BLOCK + jnp.arange(SEL_BLOCK)).reshape(b, N_KV_HEADS, tq, n_top * SEL_BLOCK)
    mask = (k_pos <= q_pos[None, None, :, None])[:, :, None]
    qg = q.reshape(b, tq, N_KV_HEADS, GQA_GROUP, dh)
    s = jnp.einsum('bqgrd,bgqsd->bgrqs', qg, kg).astype(F32) * dh ** -0.5
    p = masked_softmax(s, mask)
    o = jnp.einsum('bgrqs,bgqsd->bqgrd', p.astype(vg.dtype), vg)
    return o.reshape(b, tq, h, dh)


def merge_branches(gates, o_cmp, o_sel, o_win, w_out):
    g = gates.astype(o_cmp.dtype)[..., None]
    o = g[:, :, 0] * o_cmp + g[:, :, 1] * o_sel + g[:, :, 2] * o_win
    return o.reshape(o.shape[0], o.shape[1], -1) @ w_out


def nsa_prompt(x, w_in, w_out, cmp_pos, cmp_w1, cmp_b1, cmp_w2):
    b, t, _ = x.shape
    pos = jnp.arange(t)
    q, kv_cmp, kv_sel, kv_win, gates = nsa_project(x, w_in, pos)
    k_c, v_c = compress_blocks(kv_cmp, cmp_pos, cmp_w1, cmp_b1, cmp_w2)
    o_cmp, imp = cmp_branch(q, k_c, v_c, pos)
    n_blk = t // SEL_BLOCK
    idx = select_blocks(imp, pos, n_blk)
    k_blk = kv_sel[:, :, 0].reshape(b, n_blk, SEL_BLOCK, N_KV_HEADS, HEAD_DIM)
    v_blk = kv_sel[:, :, 1].reshape(b, n_blk, SEL_BLOCK, N_KV_HEADS, HEAD_DIM)
    win_pad = jnp.pad(kv_win, ((0, 0), (WINDOW, 0), (0, 0), (0, 0), (0, 0)))

    def query_block(i):
        start = i * Q_BLOCK
        qb = lax.dynamic_slice_in_dim(q, start, Q_BLOCK, axis=1)
        pb = start + jnp.arange(Q_BLOCK)
        ib = lax.dynamic_slice_in_dim(idx, start, Q_BLOCK, axis=2)
        o_s = sel_branch(qb, k_blk, v_blk, ib, pb)
        wb = lax.dynamic_slice_in_dim(win_pad, start, Q_BLOCK + WINDOW, axis=1)
        kp = start - WINDOW + jnp.arange(Q_BLOCK + WINDOW)
        o_w = gqa_attend(qb, wb[:, :, 0], wb[:, :, 1], window_mask(pb, kp))
        return o_s, o_w

    o_sel, o_win = lax.map(query_block, jnp.arange(t // Q_BLOCK))
    o_sel = o_sel.transpose(1, 0, 2, 3, 4).reshape(b, t, N_HEADS, HEAD_DIM)
    o_win = o_win.transpose(1, 0, 2, 3, 4).reshape(b, t, N_HEADS, HEAD_DIM)
    y = merge_branches(gates, o_cmp, o_sel, o_win, w_out)
    w_keep = min(WINDOW, t)
    return y, kv_cmp, kv_sel, kv_win[:, t - w_keep:]


def nsa_sample(x, cache_cmp, cache_sel, win_buf, page_table, past_len, w_in, w_out, cmp_pos, cmp_w1, cmp_b1, cmp_w2):
    b, tn, _ = x.shape
    pos = past_len + jnp.arange(tn)
    q, kv_cmp, kv_sel, kv_win, gates = nsa_project(x, w_in, pos)
    total = past_len + tn
    full_cmp = jnp.concatenate([cache_cmp[page_table].reshape(b, past_len, 2, N_KV_HEADS, HEAD_DIM), kv_cmp], axis=1)
    k_c, v_c = compress_blocks(full_cmp, cmp_pos, cmp_w1, cmp_b1, cmp_w2)
    o_cmp, imp = cmp_branch(q, k_c, v_c, pos)
    n_blk = -(-total // SEL_BLOCK)
    full_sel = jnp.concatenate([cache_sel[page_table].reshape(b, past_len, 2, N_KV_HEADS, HEAD_DIM), kv_sel], axis=1)
    full_sel = jnp.pad(full_sel, ((0, 0), (0, n_blk * SEL_BLOCK - total), (0, 0), (0, 0), (0, 0)))
    idx = select_blocks(imp, pos, n_blk)
    k_blk = full_sel[:, :, 0].reshape(b, n_blk, SEL_BLOCK, N_KV_HEADS, HEAD_DIM)
    v_blk = full_sel[:, :, 1].reshape(b, n_blk, SEL_BLOCK, N_KV_HEADS, HEAD_DIM)
    o_sel = sel_branch(q, k_blk, v_blk, idx, pos)
    w_buf = win_buf.shape[1]
    win_all = jnp.concatenate([win_buf, kv_win], axis=1)
    kp = past_len - w_buf + jnp.arange(w_buf + tn)
    o_win = gqa_attend(q, win_all[:, :, 0], win_all[:, :, 1], window_mask(pos, kp))
    y = merge_branches(gates, o_cmp, o_sel, o_win, w_out)
    return y, kv_cmp, kv_sel, win_all[:, tn:]


def ret_log_decay():
    return jnp.log(1.0 - 2.0 ** (-5.0 - jnp.arange(RET_HEADS, dtype=F32)))


def ret_project(x, w_in, pos):
    b, t, _ = x.shape
    nk = RET_HEADS * RET_KDIM
    nv = RET_HEADS * RET_VDIM
    z = x @ w_in
    q = rope(z[..., :nk].reshape(b, t, RET_HEADS, RET_KDIM), pos)
    k = rope(z[..., nk:2 * nk].reshape(b, t, RET_HEADS, RET_KDIM), pos)
    v = z[..., 2 * nk:2 * nk + nv].reshape(b, t, RET_HEADS, RET_VDIM)
    g = z[..., 2 * nk + nv:]
    return q, k, v, g


def ret_chunk(q, k, v, state, log_g):
    c = q.shape[1]
    i = jnp.arange(c, dtype=F32)
    rel = i[:, None] - i[None, :]
    decay = jnp.where(rel >= 0, jnp.exp(jnp.maximum(rel, 0.0)[None] * log_g[:, None, None]), 0.0)
    qf = q.astype(F32)
    kf = k.astype(F32) * RET_KDIM ** -0.5
    vf = v.astype(F32)
    s = jnp.einsum('bihd,bjhd->bhij', qf, kf) * decay[None]
    inner = jnp.einsum('bhij,bjhe->bihe', s, vf)
    q_dec = jnp.exp((i[:, None] + 1.0) * log_g[None, :])
    cross = jnp.einsum('bihd,bhde->bihe', qf, state) * q_dec[None, :, :, None]
    k_dec = jnp.exp((c - 1.0 - i)[:, None] * log_g[None, :])
    new_state = jnp.exp(c * log_g)[None, :, None, None] * state + jnp.einsum('bjhd,bjhe->bhde', kf * k_dec[None, :, :, None], vf)
    return inner + cross, new_state


def ret_output(o, g, gn, w_out):
    b, t = o.shape[:2]
    mu = jnp.mean(o, axis=-1, keepdims=True)
    var = jnp.mean(jnp.square(o - mu), axis=-1, keepdims=True)
    on = ((o - mu) * lax.rsqrt(var + GN_EPS)).reshape(b, t, -1) * gn.astype(F32)
    gated = (jax.nn.silu(g.astype(F32)) * on).astype(g.dtype)
    return gated @ w_out


def ret_prompt(x, w_in, gn, w_out):
    b, t, _ = x.shape
    q, k, v, g = ret_project(x, w_in, jnp.arange(t))
    log_g = ret_log_decay()
    nc = t // RET_CHUNK

    def to_chunks(a):
        return a.reshape(b, nc, RET_CHUNK, a.shape[2], a.shape[3]).swapaxes(0, 1)

    def step(state, qkv):
        o, state = ret_chunk(qkv[0], qkv[1], qkv[2], state, log_g)
        return state, o

    state0 = jnp.zeros((b, RET_HEADS, RET_KDIM, RET_VDIM), F32)
    state, o = lax.scan(step, state0, (to_chunks(q), to_chunks(k), to_chunks(v)))
    o = o.swapaxes(0, 1).reshape(b, t, RET_HEADS, RET_VDIM)
    return ret_output(o, g, gn, w_out), state


def ret_sample(x, state, past_len, w_in, gn, w_out):
    tn = x.shape[1]
    q, k, v, g = ret_project(x, w_in, past_len + jnp.arange(tn))
    o, new_state = ret_chunk(q, k, v, state.astype(F32), ret_log_decay())
    return ret_output(o, g, gn, w_out), new_state


def sq_relu_mlp(x, w1, w2):
    h = jax.nn.relu(x @ w1)
    return (h * h) @ w2


def setup_inputs(seed: int = 0) -> dict:
    key = jax.random.key(seed)
    ks = jax.random.split(key, 24)
    n_pages = PAST_LEN // PAGE_SIZE
    n_used = DEC_BATCH * n_pages
    pool = n_used + n_used // 4

    def nrm(k, shape, scale):
        return jax.random.normal(k, shape, F32) * scale

    kv_row = (2, N_KV_HEADS, HEAD_DIM)
    return {
        'x_prompt': nrm(ks[0], (BATCH, SEQ, D_MODEL), 1.0),
        'x_sample': nrm(ks[1], (DEC_BATCH, DEC_SEQ, D_MODEL), 1.0),
        'cache_cmp_kv': nrm(ks[2], (N_NSA_LAYERS, pool, PAGE_SIZE) + kv_row, 1.0),
        'cache_sel_kv': nrm(ks[3], (N_NSA_LAYERS, pool, PAGE_SIZE) + kv_row, 1.0),
        'state_win_kv': nrm(ks[4], (N_NSA_LAYERS, DEC_BATCH, min(WINDOW, PAST_LEN)) + kv_row, 1.0),
        'state_ret': nrm(ks[5], (N_RET_LAYERS, DEC_BATCH, RET_HEADS, RET_KDIM, RET_VDIM), 1.0),
        'page_table': jax.random.permutation(ks[6], pool)[:n_used].reshape(DEC_BATCH, n_pages).astype(jnp.int32),
        'norm_mix': 1.0 + nrm(ks[7], (DEPTH, D_MODEL), 0.02),
        'norm_ffn': 1.0 + nrm(ks[8], (DEPTH, D_MODEL), 0.02),
        'norm_final': 1.0 + nrm(ks[9], (D_MODEL,), 0.02),
        'nsa_w_in': nrm(ks[10], (N_NSA_LAYERS, D_MODEL, NSA_PROJ), D_MODEL ** -0.5),
        'nsa_w_out': nrm(ks[11], (N_NSA_LAYERS, N_HEADS * HEAD_DIM, D_MODEL), (N_HEADS * HEAD_DIM) ** -0.5),
        'nsa_cmp_pos': nrm(ks[12], (N_NSA_LAYERS, 2, CMP_BLOCK, HEAD_DIM), 0.1),
        'nsa_cmp_w1': nrm(ks[13], (N_NSA_LAYERS, 2, CMP_BLOCK, HEAD_DIM, CMP_HIDDEN), (CMP_BLOCK * HEAD_DIM) ** -0.5),
        'nsa_cmp_b1': nrm(ks[14], (N_NSA_LAYERS, 2, CMP_HIDDEN), 0.01),
        'nsa_cmp_w2': nrm(ks[15], (N_NSA_LAYERS, 2, CMP_HIDDEN, HEAD_DIM), CMP_HIDDEN ** -0.5),
        'ret_w_in': nrm(ks[16], (N_RET_LAYERS, D_MODEL, RET_PROJ), D_MODEL ** -0.5),
        'ret_gn': 1.0 + nrm(ks[17], (N_RET_LAYERS, RET_HEADS * RET_VDIM), 0.02),
        'ret_w_out': nrm(ks[18], (N_RET_LAYERS, RET_HEADS * RET_VDIM, D_MODEL), (RET_HEADS * RET_VDIM) ** -0.5),
        'ffn_w1': nrm(ks[19], (DEPTH, D_MODEL, D_FF), D_MODEL ** -0.5),
        'ffn_w2': nrm(ks[20], (DEPTH, D_FF, D_MODEL), D_FF ** -0.5),
    }


def reference(x_prompt, x_sample, cache_cmp_kv, cache_sel_kv, state_win_kv, state_ret, page_table,
              norm_mix, norm_ffn, norm_final, nsa_w_in, nsa_w_out, nsa_cmp_pos, nsa_cmp_w1, nsa_cmp_b1,
              nsa_cmp_w2, ret_w_in, ret_gn, ret_w_out, ffn_w1, ffn_w2):
    past_len = page_table.shape[1] * cache_sel_kv.shape[2]
    hp, hs = x_prompt, x_sample
    cmp_p, cmp_s, sel_p, sel_s, win_p, win_s, ret_p, ret_s = [], [], [], [], [], [], [], []
    for layer in range(DEPTH):
        xp = rms_norm(hp, norm_mix[layer])
        xs = rms_norm(hs, norm_mix[layer])
        if layer % N_MIXERS == 0:
            a = layer // N_MIXERS
            nsa_w = (nsa_w_in[a], nsa_w_out[a], nsa_cmp_pos[a], nsa_cmp_w1[a], nsa_cmp_b1[a], nsa_cmp_w2[a])
            yp, c_p, s_p, w_p = nsa_prompt(xp, *nsa_w)
            ys, c_s, s_s, w_s = nsa_sample(xs, cache_cmp_kv[a], cache_sel_kv[a], state_win_kv[a], page_table, past_len, *nsa_w)
            cmp_p.append(c_p)
            cmp_s.append(c_s)
            sel_p.append(s_p)
            sel_s.append(s_s)
            win_p.append(w_p)
            win_s.append(w_s)
        else:
            r = layer // N_MIXERS
            yp, st_p = ret_prompt(xp, ret_w_in[r], ret_gn[r], ret_w_out[r])
            ys, st_s = ret_sample(xs, state_ret[r], past_len, ret_w_in[r], ret_gn[r], ret_w_out[r])
            ret_p.append(st_p)
            ret_s.append(st_s)
        hp = hp + yp
        hs = hs + ys
        hp = hp + sq_relu_mlp(rms_norm(hp, norm_ffn[layer]), ffn_w1[layer], ffn_w2[layer])
        hs = hs + sq_relu_mlp(rms_norm(hs, norm_ffn[layer]), ffn_w1[layer], ffn_w2[layer])
    y_prompt = rms_norm(hp, norm_final)
    y_sample = rms_norm(hs, norm_final)
    return (y_prompt, y_sample, jnp.stack(cmp_p), jnp.stack(cmp_s), jnp.stack(sel_p), jnp.stack(sel_s),
            jnp.stack(win_p), jnp.stack(win_s), jnp.stack(ret_p), jnp.stack(ret_s))
```

```cpp
#include <hip/hip_runtime.h>
#include <cstdio>
#include <cstdint>
#include <cmath>
#define MK_CHECK 0
namespace pg8 {
#define PG8_LAS __attribute__((address_space(3)))
typedef unsigned short bf16_t;
typedef short bf16x8 __attribute__((ext_vector_type(8)));
typedef float f32x4 __attribute__((ext_vector_type(4)));
typedef unsigned u32x4 __attribute__((ext_vector_type(4)));
constexpr int BM = 256, BK = 64, HALF = 128, HTB = HALF * BK * 2  , STAGE_BYTES = 8 * HTB, NXCD = 8, WGM = 8;

__host__ __device__ __forceinline__ int lds_byte(int r, int c) { const int st = (r >> 4) * 2 + (c >> 5), rr = r & 15, cc = c & 31, ob = rr * 64 + cc * 2; return st * 1024 + (ob ^ (((ob >> 9) & 1) << 5)); }
__host__ __device__ __forceinline__ void stage_rc(int b, int& R, int& C) { const int st = b / 1024, sb = b % 1024, swz = sb ^ (((sb >> 9) & 1) << 5); R = (st >> 1) * 16 + swz / 64; C = (st & 1) * 32 + (swz % 64) / 2; }
__host__ __device__ __forceinline__ int perm32(int rho) { const int n = rho >> 4, i = rho & 15; return 8 * (i >> 2) + 4 * n + (i & 3); }

struct Unit { int pm, pn; };
struct Gemm { const bf16_t* A; const bf16_t* Bt; int M, N, K; };

struct StaticOrder {
    int nM, nN, nwg, G, c;
    __host__ __device__ void init(int M, int N, int G_, int c_) { nM = M / BM; nN = N / BM; nwg = nM * nN; G = G_; c = c_; }
    __host__ __device__ bool next(int i, Unit& u) const {
        const long L = (long)i * G + c; if (L >= nwg) return false;
        int wgid = (int)L; { const int q = nwg / NXCD, r = nwg % NXCD, xcd = wgid % NXCD, off = wgid / NXCD; wgid = (xcd < r ? xcd * (q + 1) : r * (q + 1) + (xcd - r) * q) + off; }
        const int nig = WGM * nN, gid = wgid / nig, fm = gid * WGM, gsz = (nM - fm) < WGM ? (nM - fm) : WGM;
        u.pm = fm + ((wgid % nig) % gsz); u.pn = (wgid % nig) / gsz; return true;
    }
    __device__ __forceinline__ void a_ready(const Unit&) const {}
    __device__ __forceinline__ void done(const Unit&) const {}
};

__device__ __forceinline__ unsigned cvt_pk_bf16(float lo, float hi) { unsigned r; asm volatile("v_cvt_pk_bf16_f32 %0, %1, %2" : "=v"(r) : "v"(lo), "v"(hi)); return r; }
typedef float f32x2 __attribute__((ext_vector_type(2)));
__device__ __forceinline__ f32x2 gelu_pk(f32x2 v) {
    const f32x2 av = __builtin_elementwise_abs(v), d = av * 0.2316418882f + 1.0f;
    f32x2 t; t.x = __builtin_amdgcn_rcpf(d.x); t.y = __builtin_amdgcn_rcpf(d.y);
    f32x2 q = t * 0.5307027145f + (-0.7265760135f); q = q * t + 0.7107068705f; q = q * t + (-0.142248368f); q = q * t + 0.127414796f; q = q * t;
    const f32x2 s = (v * v) * (-0.72134752044f);
    f32x2 e; e.x = __builtin_amdgcn_exp2f(s.x); e.y = __builtin_amdgcn_exp2f(s.y);
    const f32x2 m = v * (q * e), r = v - m;
    f32x2 o; o.x = v.x < 0.f ? m.x : r.x; o.y = v.y < 0.f ? m.y : r.y; return o;
}

template <int ACT  > struct EpiBf16 {
    static constexpr bool PERM = true, AFTER_DRAIN = false; static_assert(ACT == 0 || ACT == 1, "EpiBf16: ACT is 0 (none) or 1 (gelu_pk)");
    bf16_t* O; int ldc; const float* bias; int split_cols; size_t split_stride; float scale0;
    __device__ __forceinline__ void operator()(const f32x4 (&acc)[2][2][4][2], const Unit& u, int wr, int wc, int fr, int fq) const {
        const int row0 = u.pm * BM + wr * 64 + fr; int colt = u.pn * BM; bf16_t* base = O;
        float sc = 1.f; if (split_cols) { const int t = colt / split_cols; base += (size_t)t * split_stride; colt -= t * split_cols; if (t == 0) sc = scale0; }
        const int col0 = colt + wc * 32 + 8 * fq, bcol0 = u.pn * BM + wc * 32 + 8 * fq;
        f32x4 bv[2][2];
#pragma unroll
        for (int bj = 0; bj < 2; ++bj)
#pragma unroll
            for (int n = 0; n < 2; ++n) bv[bj][n] = bias ? *(const f32x4*)(bias + bcol0 + bj * HALF + 4 * n) : (f32x4){0.f, 0.f, 0.f, 0.f};
#pragma unroll
        for (int ai = 0; ai < 2; ++ai)
#pragma unroll
            for (int m = 0; m < 4; ++m) { bf16_t* rowp = base + (size_t)(row0 + ai * HALF + m * 16) * ldc + col0;
#pragma unroll
                for (int bj = 0; bj < 2; ++bj) { f32x4 v0 = acc[ai][bj][m][0] + bv[bj][0], v1 = acc[ai][bj][m][1] + bv[bj][1];
                    if (ACT == 1) { f32x2 a = gelu_pk((f32x2){v0[0], v0[1]}), b = gelu_pk((f32x2){v0[2], v0[3]}), c = gelu_pk((f32x2){v1[0], v1[1]}), d = gelu_pk((f32x2){v1[2], v1[3]});
                        v0 = (f32x4){a.x, a.y, b.x, b.y}; v1 = (f32x4){c.x, c.y, d.x, d.y}; }
                    v0 = v0 * sc; v1 = v1 * sc; u32x4 w; w.x = cvt_pk_bf16(v0[0], v0[1]); w.y = cvt_pk_bf16(v0[2], v0[3]); w.z = cvt_pk_bf16(v1[0], v1[1]); w.w = cvt_pk_bf16(v1[2], v1[3]);
                    *(u32x4*)(rowp + bj * HALF) = w; } }
    }
};
template <class Epi, class Sched, bool ALIGN_EPI = false, bool SP2 = false>
__device__ __forceinline__ void gemm_phase(PG8_LAS unsigned char* lds, const Gemm g, const Sched& S, const Epi& E) {
    const int tid = threadIdx.x, wid = __builtin_amdgcn_readfirstlane(tid >> 6), lane = tid & 63, wr = wid >> 2, wc = wid & 3, fr = lane & 15, fq = lane >> 4;
    const int K = g.K, nt = K / BK;
    unsigned voffA[2], voffB[2];
#pragma unroll
    for (int i = 0; i < 2; ++i) { int R, C; stage_rc(tid * 16 + i * 8192, R, C); const int Rb = Epi::PERM ? ((R & ~31) + perm32(R & 31)) : R;
        voffA[i] = (unsigned)(R * K + C) * 2u; voffB[i] = (unsigned)(Rb * K + C) * 2u; }
    const size_t kstep = (size_t)(BK * 2);
    const size_t hstep = (size_t)HALF * K * 2;
    const size_t tstep = 2 * hstep;
    const unsigned ldsw = (unsigned)wid * 1024u;
    const int aoff = lds_byte(wr * 64 + fr, fq * 8), boff = lds_byte(wc * 32 + fr, fq * 8);
#define PG8_SA(b, h) (((b) * 2 + (h)) * HTB)
#define PG8_SB(b, h) ((4 + (b) * 2 + (h)) * HTB)
#define PG8_STAGE(bufoff, gbase, voff) do { _Pragma("unroll") for (int _i = 0; _i < 2; ++_i) \
        __builtin_amdgcn_global_load_lds((const unsigned*)((const char*)(gbase) + (voff)[_i]), (PG8_LAS unsigned*)(lds + (bufoff) + ldsw + _i * 8192), 16, 0, 0); } while (0)
#define PG8_LDA(dst, b, h) do { _Pragma("unroll") for (int m = 0; m < 4; ++m) _Pragma("unroll") for (int k = 0; k < 2; ++k) dst[m][k] = *(const PG8_LAS bf16x8*)(lds + PG8_SA(b, h) + aoff + m * 2048 + k * 1024); } while (0)
#define PG8_LDB(dst, b, h) do { _Pragma("unroll") for (int n = 0; n < 2; ++n) _Pragma("unroll") for (int k = 0; k < 2; ++k) dst[n][k] = *(const PG8_LAS bf16x8*)(lds + PG8_SB(b, h) + boff + n * 2048 + k * 1024); } while (0)
#define PG8_MMA(ai, bj, At, Bt) do { __builtin_amdgcn_s_setprio(1); _Pragma("unroll") for (int m = 0; m < 4; ++m) _Pragma("unroll") for (int n = 0; n < 2; ++n) _Pragma("unroll") for (int k = 0; k < 2; ++k) \
        acc[ai][bj][m][n] = __builtin_amdgcn_mfma_f32_16x16x32_bf16(Bt[n][k], At[m][k], acc[ai][bj][m][n], 0, 0, 0); __builtin_amdgcn_s_setprio(0); } while (0)
#define PG8_WAIT_V(n) asm volatile("s_waitcnt vmcnt(" #n ")" ::: "memory")
#define PG8_WAIT_L(n) asm volatile("s_waitcnt lgkmcnt(" #n ")" ::: "memory")
#define PG8_BAR __builtin_amdgcn_s_barrier()
#define PG8_SCHED __builtin_amdgcn_sched_barrier(0)
    Unit cur, nxt; int ui = 0;
    if (!S.next(0, cur)) return;
    f32x4 acc[2][2][4][2];
#pragma unroll
    for (int a = 0; a < 2; ++a)
#pragma unroll
        for (int b = 0; b < 2; ++b)
#pragma unroll
            for (int m = 0; m < 4; ++m)
#pragma unroll
                for (int n = 0; n < 2; ++n) acc[a][b][m][n] = (f32x4){0.f, 0.f, 0.f, 0.f};
    bf16x8 At[4][2], B0[2][2], B1[2][2];
    const char* cA = (const char*)g.A + (size_t)cur.pm * tstep; const char* cB = (const char*)g.Bt + (size_t)cur.pn * tstep;
    S.a_ready(cur);
    if constexpr (SP2) {
        PG8_STAGE(PG8_SB(0, 0), cB, voffB); PG8_STAGE(PG8_SB(0, 1), cB + hstep, voffB); PG8_STAGE(PG8_SA(0, 0), cA, voffA); PG8_STAGE(PG8_SA(0, 1), cA + hstep, voffA);
        if (wr == 1) PG8_BAR;
        PG8_WAIT_V(2); PG8_BAR;
        PG8_STAGE(PG8_SB(1, 0), cB + kstep, voffB); PG8_STAGE(PG8_SA(1, 0), cA + kstep, voffA); PG8_STAGE(PG8_SB(1, 1), cB + hstep + kstep, voffB);
        PG8_WAIT_V(6); PG8_BAR;
    } else {
        PG8_STAGE(PG8_SB(0, 0), cB, voffB); PG8_STAGE(PG8_SA(0, 0), cA, voffA); PG8_STAGE(PG8_SB(0, 1), cB + hstep, voffB); PG8_STAGE(PG8_SA(0, 1), cA + hstep, voffA);
        if (wr == 1) PG8_BAR;
        PG8_WAIT_V(4); PG8_BAR;
        PG8_STAGE(PG8_SB(1, 0), cB + kstep, voffB); PG8_STAGE(PG8_SA(1, 0), cA + kstep, voffA); PG8_STAGE(PG8_SB(1, 1), cB + hstep + kstep, voffB);
        PG8_WAIT_V(6); PG8_BAR;
    }
    for (;;) {
        const bool has_next = S.next(ui + 1, nxt);
        const char* nA = has_next ? (const char*)g.A + (size_t)nxt.pm * tstep : cA; const char* nB = has_next ? (const char*)g.Bt + (size_t)nxt.pn * tstep : cB;
        for (int t = 0; t < nt; t += 2) {
            const bool last = (t == nt - 2);
            const char* a1 = cA + (size_t)(t + 1) * kstep;
            const char* a2 = last ? nA : cA + (size_t)(t + 2) * kstep; const char* b2 = last ? nB : cB + (size_t)(t + 2) * kstep;
            const char* a3 = a2 + kstep; const char* b3 = b2 + kstep;
            if (last && has_next) S.a_ready(nxt);
            if constexpr (SP2) {
            PG8_LDB(B0, 0, 0); PG8_LDB(B1, 0, 1); PG8_SCHED; PG8_LDA(At, 0, 0); PG8_STAGE(PG8_SA(1, 1), a1 + hstep, voffA);
            PG8_WAIT_V(8); PG8_WAIT_L(0); PG8_BAR; PG8_MMA(0, 0, At, B0); PG8_MMA(0, 1, At, B1); PG8_BAR; PG8_SCHED;
            PG8_LDA(At, 0, 1); PG8_STAGE(PG8_SB(0, 0), b2, voffB); PG8_STAGE(PG8_SB(0, 1), b2 + hstep, voffB); PG8_STAGE(PG8_SA(0, 0), a2, voffA);
            PG8_WAIT_V(8); PG8_WAIT_L(0); PG8_BAR; PG8_MMA(1, 0, At, B0); PG8_MMA(1, 1, At, B1); PG8_BAR; PG8_SCHED;
            PG8_LDB(B0, 1, 0); PG8_LDB(B1, 1, 1); PG8_SCHED; PG8_LDA(At, 1, 0); PG8_STAGE(PG8_SA(0, 1), a2 + hstep, voffA);
            PG8_WAIT_V(8); PG8_WAIT_L(0); PG8_BAR; PG8_MMA(0, 0, At, B0); PG8_MMA(0, 1, At, B1); PG8_BAR; PG8_SCHED;
            PG8_LDA(At, 1, 1); PG8_STAGE(PG8_SB(1, 0), b3, voffB); PG8_STAGE(PG8_SB(1, 1), b3 + hstep, voffB); PG8_STAGE(PG8_SA(1, 0), a3, voffA);
            PG8_WAIT_V(8); PG8_WAIT_L(0); PG8_BAR; PG8_MMA(1, 0, At, B0); PG8_MMA(1, 1, At, B1); PG8_BAR; PG8_SCHED;
            } else {
            PG8_LDB(B0, 0, 0); PG8_SCHED; PG8_LDA(At, 0, 0); PG8_STAGE(PG8_SA(1, 1), a1 + hstep, voffA);
            PG8_WAIT_L(8); PG8_BAR; PG8_WAIT_L(0); PG8_MMA(0, 0, At, B0); PG8_BAR; PG8_SCHED;
            PG8_LDB(B1, 0, 1); PG8_STAGE(PG8_SB(0, 0), b2, voffB);
            PG8_BAR; PG8_WAIT_L(0); PG8_MMA(0, 1, At, B1); PG8_BAR;
            PG8_LDA(At, 0, 1); PG8_STAGE(PG8_SA(0, 0), a2, voffA);
            PG8_BAR; PG8_WAIT_L(0); PG8_MMA(1, 0, At, B0); PG8_BAR; PG8_SCHED;
            PG8_STAGE(PG8_SB(0, 1), b2 + hstep, voffB);
            PG8_WAIT_V(6); PG8_BAR; PG8_MMA(1, 1, At, B1); PG8_BAR;
            PG8_LDB(B0, 1, 0); PG8_SCHED; PG8_LDA(At, 1, 0); PG8_STAGE(PG8_SA(0, 1), a2 + hstep, voffA);
            PG8_WAIT_L(8); PG8_BAR; PG8_WAIT_L(0); PG8_MMA(0, 0, At, B0); PG8_BAR; PG8_SCHED;
            PG8_LDB(B1, 1, 1); PG8_STAGE(PG8_SB(1, 0), b3, voffB);
            PG8_BAR; PG8_WAIT_L(0); PG8_MMA(0, 1, At, B1); PG8_BAR;
            PG8_LDA(At, 1, 1); PG8_STAGE(PG8_SA(1, 0), a3, voffA);
            PG8_BAR; PG8_WAIT_L(0); PG8_MMA(1, 0, At, B0); PG8_BAR; PG8_SCHED;
            PG8_STAGE(PG8_SB(1, 1), b3 + hstep, voffB);
            PG8_WAIT_V(6); PG8_BAR; PG8_MMA(1, 1, At, B1); PG8_BAR;
            }
        }
        if constexpr (ALIGN_EPI) { if (wr == 0) PG8_BAR; }
        if constexpr (!Epi::AFTER_DRAIN) { E(acc, cur, wr, wc, fr, fq); S.done(cur); }
        if (!has_next) break;
#pragma unroll
        for (int a = 0; a < 2; ++a)
#pragma unroll
            for (int b = 0; b < 2; ++b)
#pragma unroll
                for (int m = 0; m < 4; ++m)
#pragma unroll
                    for (int n = 0; n < 2; ++n) acc[a][b][m][n] = (f32x4){0.f, 0.f, 0.f, 0.f};
        cur = nxt; cA = nA; cB = nB; ++ui;
        if constexpr (ALIGN_EPI) { if (wr == 1) PG8_BAR; }
    }
    PG8_WAIT_V(0);
    if constexpr (!ALIGN_EPI) { if (wr == 0) PG8_BAR; }
    PG8_BAR;
    if constexpr (Epi::AFTER_DRAIN) { E.fused(acc, cur, wr, wc, fr, fq, lds, wid, lane); S.done(cur); }
#undef PG8_SA
#undef PG8_SB
#undef PG8_STAGE
#undef PG8_LDA
#undef PG8_LDB
#undef PG8_MMA
#undef PG8_WAIT_V
#undef PG8_WAIT_L
#undef PG8_BAR
#undef PG8_SCHED
}
}
#ifndef MK_ONE_LAUNCH
#define MK_ONE_LAUNCH 1
#endif
constexpr int NWAVES = 8, NTHR = 512;
constexpr int DM = 2048, SEQ = 4096, MP = 8192  , NS = 32  ;
constexpr int NSA_N = 5168, NSA_NP = 5376, DFF = 8192, RET_N = 12288;
constexpr int PAST = 16384;
constexpr int NPOSE = 4100;
constexpr size_t O_YP = 0, O_YS = 16777216, O_CMPP = O_YS + 65536, O_CMPS = O_CMPP + 8388608, O_SELP = O_CMPS + 32768, O_SELS = O_SELP + 8388608,
                 O_WINP = O_SELS + 32768, O_WINS = O_WINP + 1048576, O_RETP = O_WINS + 4194304, O_RETS = O_RETP + 2097152, O_END = O_RETS + 8388608;
constexpr size_t MiB = 1u << 20;
constexpr size_t WS_CTL = 0, CTL_ZERO_BYTES = 2 * MiB;
constexpr size_t WS_WIN_T = 2 * MiB, WS_WO_T = 24 * MiB, WS_RIN_T = 32 * MiB, WS_RO_T = 80 * MiB, WS_W1_T = 96 * MiB, WS_W2_T = 160 * MiB;
constexpr size_t WS_CW1_T = 224 * MiB, WS_CW2_T = 226 * MiB, WS_POSP = 226 * MiB + 65536, WS_POSB = WS_POSP + 65536;
constexpr size_t WS_ROPEN = 227 * MiB, WS_ROPER = 230 * MiB;
constexpr size_t WS_XN = 236 * MiB, WS_XS = 268 * MiB, WS_HFFS = 269 * MiB, WS_Q = 270 * MiB, WS_KV = 302 * MiB  , WS_GATES = 350 * MiB, WS_QS = 352 * MiB;
constexpr size_t WS_KCP = 357 * MiB, WS_KCS = 358 * MiB, WS_AO = 374 * MiB, WS_AOS = 406 * MiB;
constexpr size_t WS_H1 = 408 * MiB, WS_H2 = 474 * MiB, WS_HFF = 540 * MiB;
constexpr size_t WS_KVC = 670 * MiB  , WS_CC = 686 * MiB  ;
constexpr size_t WS_PER = 942 * MiB  , WS_PERS = WS_PER + 4 * MiB;
constexpr size_t WS_RQ = 1010 * MiB, WS_RK = 1042 * MiB, WS_RV = 1074 * MiB, WS_RG = 1138 * MiB, WS_RS = 1202 * MiB, WS_RO = 1218 * MiB, WS_RGA = 1282 * MiB;
constexpr size_t WS_SMP = 1346 * MiB;
constexpr size_t WS_END = 1354 * MiB;
constexpr int CW_TMO = 0;
constexpr int CW_BAR = 4096;
constexpr int CW_SSQ = 65536;
constexpr int SSQ_STRIDE = 8448;
constexpr int RING_OFF = 0, RING_BYTES = 131072;
constexpr int LDSCTL_OFF = RING_BYTES, MISC_OFF = LDSCTL_OFF + 320;
constexpr int LDS_BYTES = 147456;

#define GAS __attribute__((address_space(1)))
#define LAS __attribute__((address_space(3)))
typedef unsigned short bf16;
typedef unsigned v4u __attribute__((ext_vector_type(4)));
typedef unsigned v2u __attribute__((ext_vector_type(2)));
typedef float f32x4 __attribute__((ext_vector_type(4)));
typedef float f32x2 __attribute__((ext_vector_type(2)));
typedef short bf16x8 __attribute__((ext_vector_type(8)));
typedef GAS unsigned gu32;
#define RLX_AGENT __ATOMIC_RELAXED, __HIP_MEMORY_SCOPE_AGENT
#define LDS_WAIT() asm volatile("s_waitcnt lgkmcnt(0)" ::: "memory")
#define VM_WAIT() asm volatile("s_waitcnt vmcnt(0)" ::: "memory")
__device__ __forceinline__ unsigned f2bf(float f) { unsigned u = __builtin_bit_cast(unsigned, f); return (u + 0x7fffu + ((u >> 16) & 1u)) >> 16; }
__device__ __forceinline__ unsigned pk2(float lo, float hi) { return f2bf(lo) | (f2bf(hi) << 16); }
__device__ __forceinline__ float bf2f(unsigned short h) { return __builtin_bit_cast(float, (unsigned)h << 16); }
__device__ __forceinline__ float wave_sum(float v) {
#pragma unroll
    for (int o = 1; o < 64; o <<= 1) v += __shfl_xor(v, o);
    return v;
}
__device__ __forceinline__ float wave_max(float v) {
#pragma unroll
    for (int o = 1; o < 64; o <<= 1) v = fmaxf(v, __shfl_xor(v, o));
    return v;
}

#define XB_TMO      128
#define XB_XCNT(j)  (256  + 64 * (j))
#define XB_XSUB(j)  (1280 + 64 * (j))
#define XB_XGEN(j)  (2304 + 64 * (j))
#define XB_TOP      3328
#define XB_TOPGEN   3392
#define XCD_BAR_WORDS 3456
#define XB_SPIN_CAP (1u << 18)

__device__ __forceinline__ unsigned xb_ld(unsigned* p)              { return __hip_atomic_load(p, __ATOMIC_RELAXED, __HIP_MEMORY_SCOPE_AGENT); }
__device__ __forceinline__ unsigned xb_add(unsigned* p, unsigned v) { return __hip_atomic_fetch_add(p, v, __ATOMIC_RELAXED, __HIP_MEMORY_SCOPE_AGENT); }
__device__ __forceinline__ unsigned xb_xcc_id() { return (unsigned)__builtin_amdgcn_s_getreg((3 << 11) | 20) & 0xFu; }
#define XB_SPIN(cond, bar) do { unsigned _sp = 0; while (cond) { __builtin_amdgcn_s_sleep(1); \
    if ((++_sp & 255u) == 0u) { if (xb_ld(&(bar)[XB_TMO])) break; if (_sp > XB_SPIN_CAP) { atomicAdd(&(bar)[XB_TMO], 1u); break; } } } } while (0)

struct XcdBarrier {
    unsigned* bar; unsigned x;
    volatile LAS unsigned* st;
};
__device__ __forceinline__ XcdBarrier xcd_barrier_post(unsigned* bar, volatile LAS unsigned* st) {
    XcdBarrier b; b.bar = bar; b.x = xb_xcc_id(); b.st = st;
    if (threadIdx.x == 0) (void)xb_add(&bar[XB_XCNT(b.x)], 1u);
    return b;
}
__device__ __forceinline__ void xcd_barrier_complete(unsigned* bar, unsigned x, unsigned& nloc, unsigned& nx) {
    const unsigned G = gridDim.x * gridDim.y * gridDim.z;
    unsigned sum, cnt, mine, sp = 0u;
    for (;;) {
        sum = 0u; cnt = 0u; mine = 0u;
#pragma unroll
        for (unsigned j = 0; j < 16; ++j) { const unsigned c = xb_ld(&bar[XB_XCNT(j)]); sum += c; cnt += (c > 0u) ? 1u : 0u; mine = (j == x) ? c : mine; }
        if (sum == G) break;
        __builtin_amdgcn_s_sleep(1);
        if ((++sp & 255u) == 0u) { if (xb_ld(&bar[XB_TMO])) break; if (sp > XB_SPIN_CAP) { atomicAdd(&bar[XB_TMO], 1u); break; } }
    }
    nloc = mine > 0u ? mine : 1u; nx = cnt > 0u ? cnt : 1u;
}
__device__ __forceinline__ void xcd_barrier(const XcdBarrier& b) {
    asm volatile("s_waitcnt vmcnt(0)" ::: "memory");
    __syncthreads();
    if (threadIdx.x == 0) {
        unsigned* bar = b.bar;
        __builtin_amdgcn_s_waitcnt(0);
        unsigned nloc = b.st[0], nx = b.st[1];
        if (nloc == 0u) { xcd_barrier_complete(bar, b.x, nloc, nx); b.st[0] = nloc; b.st[1] = nx; }
        const unsigned old = xb_add(&bar[XB_XSUB(b.x)], 1u);
        const unsigned gen = old / nloc;
        if (old + 1u == (gen + 1u) * nloc) {
            __builtin_amdgcn_fence(__ATOMIC_RELEASE, "agent");
            asm volatile("s_waitcnt vmcnt(0)" ::: "memory");
            const unsigned og = xb_add(&bar[XB_TOP], 1u);
            const unsigned tg = og / nx;
            if (og + 1u == (tg + 1u) * nx) xb_add(&bar[XB_TOPGEN], 1u);
            else XB_SPIN(xb_ld(&bar[XB_TOPGEN]) == tg, bar);
            __builtin_amdgcn_fence(__ATOMIC_ACQUIRE, "agent");
            xb_add(&bar[XB_XGEN(b.x)], 1u);
            asm volatile("s_waitcnt vmcnt(0)" ::: "memory");
        } else {
            XB_SPIN(xb_ld(&bar[XB_XGEN(b.x)]) == gen, bar);
            __builtin_amdgcn_fence(__ATOMIC_ACQUIRE, "agent");
            asm volatile("s_waitcnt vmcnt(0)" ::: "memory");
        }
    }
    __syncthreads();
}

struct Args { const float* in[21]; float* out; unsigned char* ws; int ph_lo, ph_hi; };
struct Frame {
    LAS unsigned char* lds;
    volatile LAS unsigned* MISC;
    gu32* ctl;
    int tid, lane, wave, G;
    int gw, NGW;
    unsigned char* ws; float* out;
};
__host__ __device__ __forceinline__ int head_col_of_d(int d) { return ((d & 63) >> 4) * 32 + (d >> 6) * 16 + (d & 15); }
__host__ __device__ __forceinline__ int inproj_dest(int n) { if (n >= 5120) return n; return (n & ~127) + head_col_of_d(n & 127); }

template <class DF> __device__ __forceinline__ void transpose_item(const float* W, int N, int k0, int n0, LAS float* scr, int lane, const DF& dstf) {
    const int nl0 = lane & 31; const bool ok = (n0 + nl0) < N;
#pragma unroll 8
    for (int i = 0; i < 32; ++i) { const int kk = 2 * i + (lane >> 5); scr[kk * 33 + nl0] = ok ? W[(size_t)(k0 + kk) * N + n0 + nl0] : 0.f; }
    LDS_WAIT(); asm volatile("" ::: "memory");
    const int c = lane & 7;
#pragma unroll
    for (int j = 0; j < 4; ++j) { const int nl = (lane >> 3) + 8 * j; const LAS float* s = scr + (8 * c) * 33 + nl;
        v4u o; o.x = pk2(s[0 * 33], s[1 * 33]); o.y = pk2(s[2 * 33], s[3 * 33]); o.z = pk2(s[4 * 33], s[5 * 33]); o.w = pk2(s[6 * 33], s[7 * 33]);
        if (n0 + nl < N) { bf16* d = dstf(n0 + nl, k0); *(GAS v4u*)(d + 8 * c) = o; } }
    LDS_WAIT(); asm volatile("" ::: "memory");
}
struct DstPlain { bf16* WT; int K; __device__ __forceinline__ bf16* operator()(int n, int k0) const { return WT + (size_t)n * K + k0; } };
struct DstInproj { bf16* WT; __device__ __forceinline__ bf16* operator()(int n, int k0) const { return WT + (size_t)inproj_dest(n) * DM + k0; } };
struct DstCw1 { bf16* WT; __device__ __forceinline__ bf16* operator()(int n, int k0) const { return WT + ((size_t)((k0 >> 11) * 128 + n)) * 2048 + (k0 & 2047); } };

__device__ __forceinline__ void rms_row_to_bf16(const float* xrow, const float* g, bf16* orow, int lane) {
    const GAS f32x4* xr = (const GAS f32x4*)xrow + lane; f32x4 v[8]; float s = 0.f;
#pragma unroll
    for (int j = 0; j < 8; ++j) { v[j] = xr[64 * j]; s += (v[j].x * v[j].x + v[j].y * v[j].y) + (v[j].z * v[j].z + v[j].w * v[j].w); }
    const float rstd = 1.0f / sqrtf(wave_sum(s) * (1.f / DM) + 1e-6f);
    const GAS f32x4* gr = (const GAS f32x4*)g + lane; GAS v2u* o8 = (GAS v2u*)orow + lane;
#pragma unroll
    for (int j = 0; j < 8; ++j) { const f32x4 gg = gr[64 * j]; v2u o; o.x = pk2(v[j].x * rstd * gg.x, v[j].y * rstd * gg.y); o.y = pk2(v[j].z * rstd * gg.z, v[j].w * rstd * gg.w); o8[64 * j] = o; }
}
__device__ __forceinline__ void cossin_acc(float ang, float& c, float& s) {
    const double x = (double)ang; const double n = __builtin_rint(x * 0.15915494309189535); const double r = x - n * 6.283185307179586476925;
    const double qd = __builtin_rint(r * 0.63661977236758134); const double y = r - qd * 1.5707963267948966192; const int q = ((int)qd) & 3;
    const double y2 = y * y;
    const double sp = y * (1.0 + y2 * (-1.6666666666666666e-1 + y2 * (8.3333333333333332e-3 + y2 * (-1.9841269841269841e-4 + y2 * (2.7557319223985893e-6 + y2 * (-2.5052108385441720e-8))))));
    const double cp = 1.0 + y2 * (-0.5 + y2 * (4.1666666666666664e-2 + y2 * (-1.3888888888888889e-3 + y2 * (2.4801587301587302e-5 + y2 * (-2.7557319223985888e-7 + y2 * 2.0876756987868099e-9)))));
    const double sv = (q == 0) ? sp : (q == 1) ? cp : (q == 2) ? -sp : -cp;
    const double cv = (q == 0) ? cp : (q == 1) ? -sp : (q == 2) ? -cp : sp;
    c = (float)cv; s = (float)sv;
}
struct P0Args { const float *x_prompt, *x_sample, *cache_cmp, *state_win, *norm_mix, *nsa_w_in, *nsa_w_out, *cmp_pos, *cmp_w1, *cmp_w2, *ret_w_in, *ret_w_out, *ffn_w1, *ffn_w2; const int* page_table; };
__device__ __forceinline__ void p0_prologue(Frame& F, const P0Args& A) {
    unsigned char* ws = F.ws;
    LAS float* scr = (LAS float*)(F.lds + RING_OFF + F.wave * 16384);
    const int lane = F.lane, gw = F.gw, NGW = F.NGW;
    constexpr int I_IN = 32 * 162, I_WO = 32 * 64, I_RIN = 32 * 384, I_RO = 64 * 64, I_W1 = 32 * 256, I_W2 = 128 * 64, I_CW1 = 64 * 4, I_CW2 = 2 * 4;
    constexpr int NITEMS = I_IN + I_WO + I_RIN + I_RO + 2 * I_W1 + 2 * I_W2 + 2 * I_CW1 + 2 * I_CW2;
    for (int it = gw; it < NITEMS; it += NGW) {
        int r = it;
        if (r < I_IN) { const int kb = r / 162, nb = r % 162; transpose_item(A.nsa_w_in, NSA_N, 64 * kb, 32 * nb, scr, lane, DstInproj{(bf16*)(ws + WS_WIN_T)}); continue; } r -= I_IN;
        if (r < I_WO) { const int kb = r / 64, nb = r % 64; transpose_item(A.nsa_w_out, DM, 64 * kb, 32 * nb, scr, lane, DstPlain{(bf16*)(ws + WS_WO_T), DM}); continue; } r -= I_WO;
        if (r < I_RIN) { const int kb = r / 384, nb = r % 384; transpose_item(A.ret_w_in, RET_N, 64 * kb, 32 * nb, scr, lane, DstPlain{(bf16*)(ws + WS_RIN_T), DM}); continue; } r -= I_RIN;
        if (r < I_RO) { const int kb = r / 64, nb = r % 64; transpose_item(A.ret_w_out, DM, 64 * kb, 32 * nb, scr, lane, DstPlain{(bf16*)(ws + WS_RO_T), 4096}); continue; } r -= I_RO;
        if (r < 2 * I_W1) { const int l = r / I_W1; r %= I_W1; const int kb = r / 256, nb = r % 256;
            transpose_item(A.ffn_w1 + (size_t)l * DM * DFF, DFF, 64 * kb, 32 * nb, scr, lane, DstPlain{(bf16*)(ws + WS_W1_T) + (size_t)l * DM * DFF, DM}); continue; } r -= 2 * I_W1;
        if (r < 2 * I_W2) { const int l = r / I_W2; r %= I_W2; const int kb = r / 64, nb = r % 64;
            transpose_item(A.ffn_w2 + (size_t)l * DM * DFF, DM, 64 * kb, 32 * nb, scr, lane, DstPlain{(bf16*)(ws + WS_W2_T) + (size_t)l * DM * DFF, DFF}); continue; } r -= 2 * I_W2;
        if (r < 2 * I_CW1) { const int e = r / I_CW1; r %= I_CW1; const int kb = r / 4, nb = r % 4;
            transpose_item(A.cmp_w1 + (size_t)e * 4096 * 128, 128, 64 * kb, 32 * nb, scr, lane, DstCw1{(bf16*)(ws + WS_CW1_T) + (size_t)e * 256 * 2048}); continue; } r -= 2 * I_CW1;
        { const int e = r / I_CW2; r %= I_CW2; const int kb = r / 4, nb = r % 4;
            transpose_item(A.cmp_w2 + (size_t)e * 128 * 128, 128, 64 * kb, 32 * nb, scr, lane, DstPlain{(bf16*)(ws + WS_CW2_T) + (size_t)e * 128 * 128, 128}); }
    }
    { GAS v4u* z = (GAS v4u*)((bf16*)(ws + WS_WIN_T) + (size_t)NSA_N * DM); const int n16 = (NSA_NP - NSA_N) * DM / 8;
      for (int i = gw * 64 + lane; i < n16; i += NGW * 64) z[i] = (v4u){0u, 0u, 0u, 0u}; }
    for (int m = gw; m < MP + NS; m += NGW) {
        if (m < MP) rms_row_to_bf16(A.x_prompt + (size_t)m * DM, A.norm_mix, (bf16*)(ws + WS_XN) + (size_t)m * DM, lane);
        else rms_row_to_bf16(A.x_sample + (size_t)(m - MP) * DM, A.norm_mix, (bf16*)(ws + WS_XS) + (size_t)(m - MP) * DM, lane);
    }
    { f32x2* tn = (f32x2*)(ws + WS_ROPEN); f32x2* tr = (f32x2*)(ws + WS_ROPER); const int NT1 = NPOSE * 64, NT2 = NPOSE * 128;
      for (int i = gw * 64 + lane; i < NT1 + NT2; i += NGW * 64) {
          int p, k, half; if (i < NT1) { p = i >> 6; k = i & 63; half = 64; } else { const int j = i - NT1; p = j >> 7; k = j & 127; half = 128; }
          const float pos = (float)(p < 4096 ? p : PAST + (p - 4096));
          const float inv = (float)exp2(-(double)k / (double)half * 13.287712379549449);
          const float ang = pos * inv; float c, s; cossin_acc(ang, c, s);
          if (i < NT1) tn[i] = (f32x2){c, s}; else tr[i - NT1] = (f32x2){c, s}; } }
    for (int it = gw; it < 256; it += NGW) { const int e = it >> 7, hg = (it >> 6) & 1, sl = it & 63, h = hg * 64 + lane;
        const float* pp = A.cmp_pos + (size_t)e * 4096 + sl * 64; const float* ww = A.cmp_w1 + ((size_t)e * 4096 + sl * 64) * 128 + h; float a = 0.f;
#pragma unroll 8
        for (int k = 0; k < 64; ++k) a += pp[k] * ww[(size_t)k * 128];
        ((float*)(ws + WS_POSP))[(e * 64 + sl) * 128 + h] = a; }
    for (int it = gw; it < 8 * 508; it += NGW) { const int b = it / 508, i = it % 508;
        const GAS f32x4* s = (const GAS f32x4*)(A.state_win + ((size_t)b * 512 + i + 4) * 1024) + lane; GAS f32x4* d = (GAS f32x4*)(F.out + O_WINS + ((size_t)b * 512 + i) * 1024) + lane;
#pragma unroll
        for (int j = 0; j < 4; ++j) d[64 * j] = s[64 * j]; }
    for (int it = gw; it < 8 * PAST; it += NGW) { const int b = it >> 14, tok = it & (PAST - 1); const int page = A.page_table[b * 128 + (tok >> 7)];
        const f32x4* s = (const f32x4*)(A.cache_cmp + ((size_t)page * 128 + (tok & 127)) * 1024) + lane; bf16* cc = (bf16*)(ws + WS_CC);
#pragma unroll
        for (int j = 0; j < 4; ++j) { const f32x4 v = __builtin_nontemporal_load(s + 64 * j); const int col = 4 * (lane + 64 * j), e = col >> 9, g = (col >> 7) & 3, d = col & 127;
            v2u o; o.x = pk2(v.x, v.y); o.y = pk2(v.z, v.w); *(GAS v2u*)(cc + ((((size_t)e * 8 + b) * 4 + g) * PAST + tok) * 128 + d) = o; } }
}
__device__ __forceinline__ void skinny_mma(const bf16* A, const bf16* Wt, int K, int col0, int lane, f32x4 (&acc)[2][2]) {
    const int r = lane & 15, q = lane >> 4;
    const bf16* a0 = A + (size_t)r * K + q * 8; const bf16* a1 = a0 + (size_t)16 * K;
    const bf16* w0 = Wt + (size_t)(col0 + r) * K + q * 8; const bf16* w1 = w0 + (size_t)16 * K;
#pragma unroll
    for (int i = 0; i < 2; ++i)
#pragma unroll
        for (int j = 0; j < 2; ++j) acc[i][j] = (f32x4){0.f, 0.f, 0.f, 0.f};
#pragma unroll 4
    for (int k0 = 0; k0 < K; k0 += 32) {
        const bf16x8 fa0 = *(const bf16x8*)(a0 + k0), fa1 = *(const bf16x8*)(a1 + k0), fw0 = *(const bf16x8*)(w0 + k0), fw1 = *(const bf16x8*)(w1 + k0);
        acc[0][0] = __builtin_amdgcn_mfma_f32_16x16x32_bf16(fw0, fa0, acc[0][0], 0, 0, 0);
        acc[0][1] = __builtin_amdgcn_mfma_f32_16x16x32_bf16(fw1, fa0, acc[0][1], 0, 0, 0);
        acc[1][0] = __builtin_amdgcn_mfma_f32_16x16x32_bf16(fw0, fa1, acc[1][0], 0, 0, 0);
        acc[1][1] = __builtin_amdgcn_mfma_f32_16x16x32_bf16(fw1, fa1, acc[1][1], 0, 0, 0);
    }
}
__device__ __forceinline__ float sigmoidf_(float x) { return 1.0f / (1.0f + __expf(-x)); }
__device__ __forceinline__ void rope4(const f32x4 x1, const f32x4 x2, const f32x4 csA, const f32x4 csB, f32x4& o1, f32x4& o2) {
    o1 = (f32x4){x1[0] * csA[0] - x2[0] * csA[1], x1[1] * csA[2] - x2[1] * csA[3], x1[2] * csB[0] - x2[2] * csB[1], x1[3] * csB[2] - x2[3] * csB[3]};
    o2 = (f32x4){x2[0] * csA[0] + x1[0] * csA[1], x2[1] * csA[2] + x1[1] * csA[3], x2[2] * csB[0] + x1[2] * csB[1], x2[3] * csB[2] + x1[3] * csB[3]};
}
__device__ __forceinline__ v2u pk4(const f32x4 v) { v2u o; o.x = pk2(v[0], v[1]); o.y = pk2(v[2], v[3]); return o; }

struct EpiNsaIn {
    static constexpr bool PERM = false, AFTER_DRAIN = false;
    bf16* Q; bf16* KV; bf16* KVC; float* gates; float* out; const float* rope;
    __device__ __forceinline__ void operator()(const pg8::f32x4 (&acc)[2][2][4][2], const pg8::Unit& u, int wr, int wc, int fr, int fq) const {
        const int pn = u.pn;
        if (pn == 20) {
            if (wc < 2) {
#pragma unroll
                for (int ai = 0; ai < 2; ++ai)
#pragma unroll
                    for (int m = 0; m < 4; ++m) { const int row = u.pm * 256 + ai * 128 + wr * 64 + m * 16 + fr;
#pragma unroll
                        for (int n = 0; n < 2; ++n) { const int c = 32 * wc + 16 * n + 4 * fq;
                            if (c < 48) { const f32x4 v = acc[ai][0][m][n]; *(GAS f32x4*)(gates + (size_t)row * 48 + c) = (f32x4){sigmoidf_(v[0]), sigmoidf_(v[1]), sigmoidf_(v[2]), sigmoidf_(v[3])}; } } }
            }
            return;
        }
        const int d = wc * 16 + 4 * fq;
#pragma unroll
        for (int ai = 0; ai < 2; ++ai)
#pragma unroll
            for (int m = 0; m < 4; ++m) { const int row = u.pm * 256 + ai * 128 + wr * 64 + m * 16 + fr, b = row >> 12, t = row & 4095;
                const f32x4 csA = *(const GAS f32x4*)(rope + ((size_t)t * 64 + d) * 2), csB = *(const GAS f32x4*)(rope + ((size_t)t * 64 + d) * 2 + 4);
#pragma unroll
                for (int bj = 0; bj < 2; ++bj) { const int hh = 2 * pn + bj; const f32x4 x1 = acc[ai][bj][m][0], x2 = acc[ai][bj][m][1]; f32x4 o1 = x1, o2 = x2;
                    if (hh < 16) { rope4(x1, x2, csA, csB, o1, o2); bf16* q = Q + ((size_t)(b * 16 + hh) * SEQ + t) * 128 + d; *(GAS v2u*)q = pk4(o1); *(GAS v2u*)(q + 64) = pk4(o2); }
                    else { const int hk = hh - 16, br = hk >> 3, e = (hk >> 2) & 1, g = hk & 3;
                        if (e == 0) rope4(x1, x2, csA, csB, o1, o2);
                        bf16* kv = (br == 0 ? KVC + ((size_t)((e * 2 + b) * 4 + g) * SEQ + t) * 128 : KV + ((size_t)((((br - 1) * 2 + e) * 2 + b) * 4 + g) * SEQ + t) * 128) + d; *(GAS v2u*)kv = pk4(o1); *(GAS v2u*)(kv + 64) = pk4(o2);
                        float* o = nullptr;
                        if (br == 0) o = out + O_CMPP + (size_t)row * 1024; else if (br == 1) o = out + O_SELP + (size_t)row * 1024; else if (t >= SEQ - 512) o = out + O_WINP + ((size_t)b * 512 + (t - (SEQ - 512))) * 1024;
                        if (o) { o += e * 512 + g * 128 + d; *(GAS f32x4*)o = o1; *(GAS f32x4*)(o + 64) = o2; } } } }
    }
};
__device__ __forceinline__ void p1_sample(Frame& F, const bf16* XS, const bf16* WinT, const float* rope, float* QS, float* GS) {
    const int lane = F.lane, r16 = lane & 15, q4 = lane >> 4;
    for (int sl = F.gw; sl < 162; sl += F.NGW) {
        f32x4 acc[2][2]; const int col0 = 32 * sl; skinny_mma(XS, WinT, DM, col0, lane, acc);
#pragma unroll
        for (int rh = 0; rh < 2; ++rh) { const int sr = rh * 16 + r16, b = sr >> 2, t = sr & 3;
            if (col0 >= 5120) {
#pragma unroll
                for (int cs = 0; cs < 2; ++cs) { const int c = col0 - 5120 + cs * 16 + 4 * q4;
                    if (c < 48) { const f32x4 v = acc[rh][cs]; *(f32x4*)(GS + sr * 48 + c) = (f32x4){sigmoidf_(v[0]), sigmoidf_(v[1]), sigmoidf_(v[2]), sigmoidf_(v[3])}; } }
            } else {
                const int hh = col0 >> 7, wc = (col0 & 127) >> 5, d = wc * 16 + 4 * q4;
                const f32x4 csA = *(const f32x4*)(rope + ((size_t)(4096 + t) * 64 + d) * 2), csB = *(const f32x4*)(rope + ((size_t)(4096 + t) * 64 + d) * 2 + 4);
                const f32x4 x1 = acc[rh][0], x2 = acc[rh][1]; f32x4 o1 = x1, o2 = x2;
                if (hh < 16) { rope4(x1, x2, csA, csB, o1, o2); float* q = QS + (size_t)sr * DM + hh * 128 + d; *(f32x4*)q = o1; *(f32x4*)(q + 64) = o2; }
                else { const int hk = hh - 16, br = hk >> 3, e = (hk >> 2) & 1, g = hk & 3;
                    if (e == 0) rope4(x1, x2, csA, csB, o1, o2);
                    float* o = (br == 0) ? F.out + O_CMPS + (size_t)sr * 1024 : (br == 1) ? F.out + O_SELS + (size_t)sr * 1024 : F.out + O_WINS + ((size_t)b * 512 + 508 + t) * 1024;
                    o += e * 512 + g * 128 + d; *(f32x4*)o = o1; *(f32x4*)(o + 64) = o2; }
            }
        }
    }
}
struct CmpOrder {
    int G, c;
    __device__ bool next(int i, pg8::Unit& u) const { const int L = i * G + c; if (L >= 256) return false; u.pm = 16 + L; u.pn = L >> 7; return true; }
    __device__ __forceinline__ void a_ready(const pg8::Unit&) const {}
    __device__ __forceinline__ void done(const pg8::Unit&) const {}
};
struct EpiPer {
    static constexpr bool PERM = false, AFTER_DRAIN = false;
    float* PER;
    __device__ __forceinline__ void operator()(const pg8::f32x4 (&acc)[2][2][4][2], const pg8::Unit& u, int wr, int wc, int fr, int fq) const {
#pragma unroll
        for (int ai = 0; ai < 2; ++ai)
#pragma unroll
            for (int m = 0; m < 4; ++m) { float* rowp = PER + (size_t)(u.pm * 256 + ai * 128 + wr * 64 + m * 16 + fr) * 256 + wc * 32 + 4 * fq;
#pragma unroll
                for (int bj = 0; bj < 2; ++bj)
#pragma unroll
                    for (int n = 0; n < 2; ++n) *(GAS f32x4*)(rowp + bj * 128 + n * 16) = acc[ai][bj][m][n]; }
    }
};
__device__ __forceinline__ void p2_prompt_per(Frame& F) {
    unsigned char* ws = F.ws; const int lane = F.lane, r16 = lane & 15, q4 = lane >> 4;
    for (int it = F.gw; it < 1024; it += F.NGW) { const int e = it >> 9, rg = (it >> 3) & 63, cg = it & 7;
        f32x4 acc[2][2]; skinny_mma((const bf16*)(ws + WS_KVC) + ((size_t)e * 2048 + rg * 32) * 2048, (const bf16*)(ws + WS_CW1_T) + (size_t)e * 256 * 2048, 2048, cg * 32, lane, acc);
        float* per = (float*)(ws + WS_PER);
#pragma unroll
        for (int rh = 0; rh < 2; ++rh)
#pragma unroll
            for (int cs = 0; cs < 2; ++cs) *(f32x4*)(per + ((size_t)e * 2048 + rg * 32 + rh * 16 + r16) * 256 + cg * 32 + cs * 16 + 4 * q4) = acc[rh][cs]; }
}
__device__ __forceinline__ float gelu_tanh(float x) { const float u = 0.7978845608028654f * (x + 0.044715f * x * x * x); const float t = 1.0f - 2.0f / (__expf(2.0f * u) + 1.0f); return 0.5f * x * (1.0f + t); }
__device__ __forceinline__ void p3_finish(Frame& F) {
    unsigned char* ws = F.ws; const int lane = F.lane, r16 = lane & 15, q4 = lane >> 4;
    const float* per = (const float*)(ws + WS_PER); const float* posb = (const float*)(ws + WS_POSB);
    for (int it = F.gw; it < 2 * (128 + 2048); it += F.NGW) {
        int e, R0, NCH; size_t perbase; bf16* dst;
        if (it < 256) { e = it >> 7; R0 = (it & 127) * 16; NCH = 256; perbase = (size_t)e * 2048; dst = (bf16*)(ws + WS_KCP) + (size_t)e * 2048 * 128; }
        else { const int j = it - 256; e = j >> 11; R0 = (j & 2047) * 16; NCH = 1024; perbase = 4096 + (size_t)e * 32768; dst = (bf16*)(ws + WS_KCS) + (size_t)e * 32768 * 128; }
        const int R = R0 + r16, i = R & (NCH - 1); const bool valid = i < NCH - 1;
        bf16x8 af[4];
#pragma unroll
        for (int kk = 0; kk < 4; ++kk) { const int h0 = kk * 32 + q4 * 8; f32x4 a0 = {0.f, 0.f, 0.f, 0.f}, a1 = a0;
            if (valid) { const float* p0 = per + (perbase + R) * 256 + h0; const float* p1 = per + (perbase + R + 1) * 256 + 128 + h0; const float* pb = posb + e * 128 + h0;
                a0 = *(const f32x4*)p0 + *(const f32x4*)p1 + *(const f32x4*)pb; a1 = *(const f32x4*)(p0 + 4) + *(const f32x4*)(p1 + 4) + *(const f32x4*)(pb + 4);
#pragma unroll
                for (int j = 0; j < 4; ++j) { a0[j] = gelu_tanh(a0[j]); a1[j] = gelu_tanh(a1[j]); } }
            v4u w; w.x = pk2(a0[0], a0[1]); w.y = pk2(a0[2], a0[3]); w.z = pk2(a1[0], a1[1]); w.w = pk2(a1[2], a1[3]); af[kk] = __builtin_bit_cast(bf16x8, w); }
        const bf16* w2t = (const bf16*)(ws + WS_CW2_T) + (size_t)e * 128 * 128;
#pragma unroll
        for (int nt = 0; nt < 8; ++nt) { f32x4 acc = {0.f, 0.f, 0.f, 0.f};
#pragma unroll
            for (int kk = 0; kk < 4; ++kk) { const bf16x8 wf = *(const bf16x8*)(w2t + (size_t)(nt * 16 + r16) * 128 + kk * 32 + q4 * 8); acc = __builtin_amdgcn_mfma_f32_16x16x32_bf16(wf, af[kk], acc, 0, 0, 0); }
            *(v2u*)(dst + (size_t)R * 128 + nt * 16 + 4 * q4) = pk4(acc); }
    }
}
namespace att {
typedef short s16x4 __attribute__((ext_vector_type(4)));
typedef float f32x16 __attribute__((ext_vector_type(16)));
typedef unsigned u32x4 __attribute__((ext_vector_type(4)));
constexpr float SCALE = 0.08838834764831845f;
constexpr float THR = 8.f;
constexpr int SHM_V = 64 * 128 * 2, SHM_K = 64 * 128 * 2;
constexpr int L_V = 0, L_K = 2 * SHM_V, L_ACC = 65536, L_WS = 131072 + 1024, L_SELM = L_WS + 8 * 512;
#define KSWZ(row, colB) ((row) * 256 + ((colB) ^ (((row) & 7) << 4)))
#define SBAR() __builtin_amdgcn_sched_barrier(0)
__device__ __forceinline__ int v_st(int k, int c) { const int kk = (k & ~0xC) | ((k & 4) << 1) | ((k & 8) >> 1); return ((kk >> 3) * 4 + (c >> 5)) * 512 + ((kk & 7) * 32 + (c & 31)) * 2; }
__device__ __forceinline__ int v_rd_base(int lane) { return ((lane & 3) << 3) | (((lane >> 2) & 3) << 6) | (((lane >> 4) & 1) << 5) | (((lane >> 5) & 1) << 8); }
constexpr int v_rd_off(int d0, int ks, int half) { return d0 * 512 + ks * 4096 + half * 2048; }
__device__ __forceinline__ int crow(int r, int hi) { return (r & 3) + 8 * (r >> 2) + 4 * hi; }
__device__ __forceinline__ unsigned cvtpk(float lo, float hi) { unsigned r; asm volatile("v_cvt_pk_bf16_f32 %0, %1, %2" : "=v"(r) : "v"(lo), "v"(hi)); return r; }
__device__ __forceinline__ void mask_lohi(f32x16& p0, f32x16& p1, int lo, int lim, int hi) {
    const float NEG = -__builtin_inff();
#pragma unroll
    for (int r = 0; r < 16; ++r) { const int c = (r & 3) + 8 * (r >> 2) + 4 * hi;
        if (c < lo || c > lim) p0[r] = NEG;
        if (c + 32 < lo || c + 32 > lim) p1[r] = NEG; }
}
__device__ __forceinline__ void partialSM(f32x16& p0, f32x16& p1, float& m_reg, float& mn, float& alpha) {
    float pmax = p0[0];
#pragma unroll
    for (int r = 1; r < 16; ++r) pmax = fmaxf(pmax, p0[r]);
#pragma unroll
    for (int r = 0; r < 16; ++r) pmax = fmaxf(pmax, p1[r]);
    { auto rr = __builtin_amdgcn_permlane32_swap(__float_as_uint(pmax), __float_as_uint(pmax), false, false);
      pmax = fmaxf(__uint_as_float(rr[0]), __uint_as_float(rr[1])); }
    constexpr float C2 = 1.4426950408889634f * SCALE;
    if (__builtin_expect(__all((pmax - m_reg) * SCALE <= THR), 1)) { mn = m_reg; alpha = 1.f; }
    else { mn = fmaxf(m_reg, pmax); alpha = __builtin_amdgcn_exp2f((m_reg - mn) * C2); m_reg = mn; }
    const float mnL = -mn * C2;
#pragma unroll
    for (int r = 0; r < 16; ++r) p0[r] = fmaf(p0[r], C2, mnL);
#pragma unroll
    for (int r = 0; r < 16; ++r) p1[r] = fmaf(p1[r], C2, mnL);
#pragma unroll
    for (int r = 0; r < 16; ++r) p0[r] = __builtin_amdgcn_exp2f(p0[r]);
}
__device__ __forceinline__ void finishSM(f32x16& p0, f32x16& p1, float alpha, float& l_reg, bf16x8& pa0, bf16x8& pa1, bf16x8& pa2, bf16x8& pa3) {
#pragma unroll
    for (int r = 0; r < 16; ++r) p1[r] = __builtin_amdgcn_exp2f(p1[r]);
    float ps = 0;
#pragma unroll
    for (int r = 0; r < 16; ++r) ps += p0[r];
#pragma unroll
    for (int r = 0; r < 16; ++r) ps += p1[r];
    { auto rr = __builtin_amdgcn_permlane32_swap(__float_as_uint(ps), __float_as_uint(ps), false, false);
      ps = __uint_as_float(rr[0]) + __uint_as_float(rr[1]); }
    l_reg = l_reg * alpha + ps;
#define PK4(P, B_, OUT) do { unsigned a0 = cvtpk(P[B_+0], P[B_+1]), a1 = cvtpk(P[B_+2], P[B_+3]);                          \
        unsigned b0 = cvtpk(P[B_+4], P[B_+5]), b1 = cvtpk(P[B_+6], P[B_+7]);                                             \
        auto r0 = __builtin_amdgcn_permlane32_swap(a0, b0, false, false); auto r1 = __builtin_amdgcn_permlane32_swap(a1, b1, false, false); \
        u32x4 w = {r0[0], r1[0], r0[1], r1[1]}; OUT = *reinterpret_cast<bf16x8*>(&w); } while (0)
    PK4(p0, 0, pa0); PK4(p0, 8, pa1); PK4(p1, 0, pa2); PK4(p1, 8, pa3);
#undef PK4
}
template <int KB>
__device__ __forceinline__ void qkt(f32x16& p0, f32x16& p1, const char* K_lds, int r32, int hi, const bf16x8* qr) {
    p0 = f32x16{}; p1 = f32x16{};
    const char* kb[4];
#pragma unroll
    for (int dd = 0; dd < 4; ++dd) kb[dd] = K_lds + KB * SHM_K + KSWZ(r32, (dd * 16 + hi * 8) * 2);
#pragma unroll
    for (int d0 = 0; d0 < 8; ++d0) { const char* a = kb[d0 & 3] + (d0 >> 2) * 128;
        bf16x8 b0 = *reinterpret_cast<const bf16x8*>(a);
        bf16x8 b1 = *reinterpret_cast<const bf16x8*>(a + 32 * 256);
        p0 = __builtin_amdgcn_mfma_f32_32x32x16_bf16(b0, qr[d0], p0, 0, 0, 0);
        p1 = __builtin_amdgcn_mfma_f32_32x32x16_bf16(b1, qr[d0], p1, 0, 0, 0); }
}
template <int VB>
__device__ __forceinline__ void pv_tile(f32x16* o, int vb0, bf16x8 pa0, bf16x8 pa1, bf16x8 pa2, bf16x8 pa3) {
#define TRRD(dst, off) asm volatile("ds_read_b64_tr_b16 %0, %1 offset:%2" : "=&v"(dst) : "v"(vb0), "i"(off) : "memory")
#define PV_D0(d0) do { s16x4 l0, l1, l2, l3, h0, h1, h2, h3; constexpr int b_ = VB * SHM_V + v_rd_off(d0, 0, 0); \
        TRRD(l0, b_); TRRD(h0, b_ + 2048); TRRD(l1, b_ + 4096); TRRD(h1, b_ + 6144); TRRD(l2, b_ + 8192); TRRD(h2, b_ + 10240); TRRD(l3, b_ + 12288); TRRD(h3, b_ + 14336); \
        asm volatile("s_waitcnt lgkmcnt(0)" ::: "memory"); SBAR();   \
        o[d0] = __builtin_amdgcn_mfma_f32_32x32x16_bf16(pa0, (bf16x8){l0[0], l0[1], l0[2], l0[3], h0[0], h0[1], h0[2], h0[3]}, o[d0], 0, 0, 0);   \
        o[d0] = __builtin_amdgcn_mfma_f32_32x32x16_bf16(pa1, (bf16x8){l1[0], l1[1], l1[2], l1[3], h1[0], h1[1], h1[2], h1[3]}, o[d0], 0, 0, 0);   \
        o[d0] = __builtin_amdgcn_mfma_f32_32x32x16_bf16(pa2, (bf16x8){l2[0], l2[1], l2[2], l2[3], h2[0], h2[1], h2[2], h2[3]}, o[d0], 0, 0, 0);   \
        o[d0] = __builtin_amdgcn_mfma_f32_32x32x16_bf16(pa3, (bf16x8){l3[0], l3[1], l3[2], l3[3], h3[0], h3[1], h3[2], h3[3]}, o[d0], 0, 0, 0); } while (0)
    PV_D0(0); PV_D0(1); PV_D0(2); PV_D0(3);
#undef PV_D0
#undef TRRD
}
struct St { f32x16 o[4]; float m, l; };
struct MaskCmp { int t; __device__ __forceinline__ void operator()(f32x16& p0, f32x16& p1, int tile, int hi) const { const int lim = ((t - 31) >> 4) - 64 * tile; if (!__all(lim >= 63)) mask_lohi(p0, p1, 0, lim, hi); } };
struct MaskSel { int tl, qb; unsigned long long sel; __device__ __forceinline__ void operator()(f32x16& p0, f32x16& p1, int tile, int hi) const {
    const bool rs = (sel >> tile) & 1ull; const int lim = rs ? (tile == qb ? tl : 63) : -1; if (!__all(lim >= 63)) mask_lohi(p0, p1, 0, lim, hi); } };
struct MaskWin { int t; __device__ __forceinline__ void operator()(f32x16& p0, f32x16& p1, int tile, int hi) const {
    const int lo = t - 511 - 64 * tile, lim = t - 64 * tile; if (!__all(lo <= 0 && lim >= 63)) mask_lohi(p0, p1, lo, lim, hi); } };

template <int BUF, class MaskF>
__device__ __forceinline__ void flash_tile(char* lds, const bf16x8* qr, St& S, int vb0, int r32, int hi, float* al_l, const MaskF& mk, int tile) {
    f32x16 p0, p1; qkt<BUF>(p0, p1, lds + L_K, r32, hi, qr);
    mk(p0, p1, tile, hi);
    float mn, alpha; partialSM(p0, p1, S.m, mn, alpha);
    if (__any(alpha < 1.f)) { if (hi == 0) al_l[r32] = alpha; asm volatile("s_waitcnt lgkmcnt(0)" ::: "memory");
#pragma unroll
        for (int d_ = 0; d_ < 4; ++d_)
#pragma unroll
            for (int r = 0; r < 16; ++r) S.o[d_][r] *= al_l[crow(r, hi)]; }
    bf16x8 pa0, pa1, pa2, pa3; finishSM(p0, p1, alpha, S.l, pa0, pa1, pa2, pa3); SBAR();
    pv_tile<BUF>(S.o, vb0, pa0, pa1, pa2, pa3);
}
template <int BUF>
__device__ __forceinline__ void imp_tile(char* lds, const bf16x8* qr, float m, float rl, int r32, int hi, const MaskCmp& mk, int tt, float& carry, float* imp_row) {
    f32x16 p0, p1; qkt<BUF>(p0, p1, lds + L_K, r32, hi, qr);
    mk(p0, p1, tt, hi);
    constexpr float C2 = 1.4426950408889634f * SCALE; const float mnL = -m * C2;
#pragma unroll
    for (int r = 0; r < 16; ++r) { p0[r] = __builtin_amdgcn_exp2f(fmaf(p0[r], C2, mnL)) * rl; p1[r] = __builtin_amdgcn_exp2f(fmaf(p1[r], C2, mnL)) * rl; }
    float G[8], PL[8];
#pragma unroll
    for (int kk = 0; kk < 4; ++kk) { G[kk] = (p0[4 * kk] + p0[4 * kk + 1]) + (p0[4 * kk + 2] + p0[4 * kk + 3]); G[4 + kk] = (p1[4 * kk] + p1[4 * kk + 1]) + (p1[4 * kk + 2] + p1[4 * kk + 3]);
        PL[kk] = __shfl_xor(p0[4 * kk + 3], 32); PL[4 + kk] = __shfl_xor(p1[4 * kk + 3], 32); }
#pragma unroll
    for (int kk = 0; kk < 8; ++kk) { const float prev = hi ? PL[kk] : (kk ? PL[kk > 0 ? kk - 1 : 0] : carry); imp_row[16 * tt + 2 * kk + hi] = G[kk] + prev; }
    carry = PL[7];
}

struct Stage { bf16x8 k0, k1, v0, v1; };
#define ATT_LOAD(St_, Kg_, Vg_, tile_) do { const size_t ro_ = ((size_t)(tile_) * 64 + sr) * 128 + sc; St_.k0 = *(const bf16x8*)((Kg_) + ro_); St_.k1 = *(const bf16x8*)((Kg_) + ro_ + 32 * 128); \
        if (Vg_) { St_.v0 = *(const bf16x8*)((Vg_) + ro_); St_.v1 = *(const bf16x8*)((Vg_) + ro_ + 32 * 128); } } while (0)
#define ATT_WRITE(St_, buf_, hasv_) do { *(bf16x8*)(lds + L_K + (buf_) * SHM_K + kws) = St_.k0; *(bf16x8*)(lds + L_K + (buf_) * SHM_K + kws + 32 * 256) = St_.k1; \
        if (hasv_) { *(bf16x8*)(lds + L_V + (buf_) * SHM_V + vst0) = St_.v0; *(bf16x8*)(lds + L_V + (buf_) * SHM_V + vst1) = St_.v1; } } while (0)

template <class MaskF>
__device__ __forceinline__ void flash_branch(char* lds, const bf16* Kg, const bf16* Vg, int j_lo, int j_hi, const MaskF& mk, const bf16x8* qr, St& S, int vb0, int r32, int hi, float* al_l, int sr, int sc, int kws, int vst0, int vst1) {
    const int n = j_hi - j_lo; Stage sg;
    ATT_LOAD(sg, Kg, Vg, j_lo); ATT_WRITE(sg, 0, true); if (n > 1) ATT_LOAD(sg, Kg, Vg, j_lo + 1);
    __syncthreads();
    for (int t = 0; t < n; t += 2) {
        flash_tile<0>(lds, qr, S, vb0, r32, hi, al_l, mk, j_lo + t);
        if (t + 1 < n) { ATT_WRITE(sg, 1, true); if (t + 2 < n) ATT_LOAD(sg, Kg, Vg, j_lo + t + 2); }
        __syncthreads();
        if (t + 1 < n) {
            flash_tile<1>(lds, qr, S, vb0, r32, hi, al_l, mk, j_lo + t + 1);
            if (t + 2 < n) { ATT_WRITE(sg, 0, true); if (t + 3 < n) ATT_LOAD(sg, Kg, Vg, j_lo + t + 3); }
            __syncthreads();
        }
    }
}
__device__ __forceinline__ void merge_branch(St& S, bf16* accw, float* sc_l, float gate, int r32, int hi, bool first) {
    if (hi == 0) sc_l[r32] = S.l > 0.f ? gate / S.l : 0.f;
    asm volatile("s_waitcnt lgkmcnt(0)" ::: "memory");
#pragma unroll
    for (int r = 0; r < 16; ++r) { const int row = crow(r, hi); const float s = sc_l[row];
#pragma unroll
        for (int d0 = 0; d0 < 4; ++d0) { bf16* a = accw + row * 128 + d0 * 32 + r32; const float v = S.o[d0][r] * s; *a = (bf16)f2bf(first ? v : bf2f(*a) + v); } }
    asm volatile("s_waitcnt lgkmcnt(0)" ::: "memory");
}

__device__ __forceinline__ void attn_unit(char* lds, int b, int g, int qb, const bf16* Qb, const bf16* KCP, const bf16* KV, const float* gates, bf16* AO) {
    int tid = threadIdx.x; asm volatile("" : "+v"(tid));
    const int wid = __builtin_amdgcn_readfirstlane(tid >> 6), lane = tid & 63, r32 = lane & 31, hi = lane >> 5;
    const int hr = wid & 3, qh = wid >> 2, h = 4 * g + hr, ql = qh * 32 + r32, t = 64 * qb + ql;
    const int sr = tid >> 4, sc = (tid & 15) * 8, vst0 = v_st(sr, sc), vst1 = v_st(32 + sr, sc), kws = KSWZ(sr, sc * 2);
    const int vb0 = (int)(uintptr_t)(lds + L_V) + v_rd_base(lane);
    float* wsf = (float*)(lds + L_WS) + wid * 128; float* al_l = wsf; float* sc_l = wsf + 32;
    bf16* accw = (bf16*)(lds + L_ACC) + wid * 32 * 128;
    float* imp4 = (float*)(lds + L_ACC);
    unsigned long long* selm = (unsigned long long*)(lds + L_SELM);
    bf16x8 qr[8];
    { const bf16* qp = Qb + ((size_t)(b * 16 + h) * SEQ + t) * 128 + hi * 8;
#pragma unroll
      for (int d0 = 0; d0 < 8; ++d0) qr[d0] = *(const bf16x8*)(qp + d0 * 16); }
    const float* grow = gates + (size_t)(b * SEQ + t) * 48 + h;
    const float g_cmp = grow[0], g_sel = grow[16], g_win = grow[32];
    const int bg = b * 4 + g;
    St S;
    const bf16* Kc = KCP + (size_t)(0 * 8 + bg) * 256 * 128; const bf16* Vc = KCP + (size_t)(1 * 8 + bg) * 256 * 128;
    const int nt_cmp = (4 * qb + 2) / 64 + 1;
    const MaskCmp mc{t};
#pragma unroll
    for (int d_ = 0; d_ < 4; ++d_) S.o[d_] = f32x16{};
    S.m = -1e30f; S.l = 0.f;
    flash_branch(lds, Kc, Vc, 0, nt_cmp, mc, qr, S, vb0, r32, hi, al_l, sr, sc, kws, vst0, vst1);
    { const float rl = S.l > 0.f ? 1.0f / S.l : 0.f; float carry = 0.f; float* imp_row = imp4 + ((size_t)hr * 64 + ql) * 64; Stage sg; const bf16* nov = nullptr;
      ATT_LOAD(sg, Kc, nov, 0); ATT_WRITE(sg, 0, false); if (nt_cmp > 1) ATT_LOAD(sg, Kc, nov, 1);
      __syncthreads();
      for (int tt = 0; tt < 4; tt += 2) {
          if (tt < nt_cmp) imp_tile<0>(lds, qr, S.m, rl, r32, hi, mc, tt, carry, imp_row);
          else {
#pragma unroll
              for (int kk = 0; kk < 8; ++kk) imp_row[16 * tt + 2 * kk + hi] = 0.f; }
          if (tt + 1 < nt_cmp) { ATT_WRITE(sg, 1, false); if (tt + 2 < nt_cmp) ATT_LOAD(sg, Kc, nov, tt + 2); }
          __syncthreads();
          if (tt + 1 < nt_cmp) imp_tile<1>(lds, qr, S.m, rl, r32, hi, mc, tt + 1, carry, imp_row);
          else {
#pragma unroll
              for (int kk = 0; kk < 8; ++kk) imp_row[16 * (tt + 1) + 2 * kk + hi] = 0.f; }
          if (tt + 2 < nt_cmp) { ATT_WRITE(sg, 0, false); if (tt + 3 < nt_cmp) ATT_LOAD(sg, Kc, nov, tt + 3); }
          __syncthreads();
      } }
    { int j = lane; asm volatile("" : "+v"(j));
      for (int qi = 0; qi < 8; ++qi) { const int q = wid * 8 + qi;
        const float v = ((imp4[(0 * 64 + q) * 64 + j] + imp4[(1 * 64 + q) * 64 + j]) + imp4[(2 * 64 + q) * 64 + j]) + imp4[(3 * 64 + q) * 64 + j];
        const bool visible = j <= qb, forced = (j == 0) || (visible && j > qb - 2);
        const unsigned kb_ = forced ? 0xFFFFFFFFu : (visible ? __float_as_uint(v) + 1u : 0u);
        const unsigned klo = (unsigned)(63 - j);
        int rank = 0;
#pragma unroll 8
        for (int jp = 0; jp < 64; ++jp) { const unsigned ob = __builtin_amdgcn_readlane(kb_, jp), ol = __builtin_amdgcn_readlane(klo, jp); rank += (ob > kb_ || (ob == kb_ && ol > klo)) ? 1 : 0; }
        const unsigned long long mask = __ballot(rank < 16 && visible);
        if (lane == 0) selm[q] = mask; } }
    __syncthreads();
    const unsigned long long mysel = selm[ql];
    __syncthreads();
    merge_branch(S, accw, sc_l, g_cmp, r32, hi, true);
    { const bf16* Ks = KV + (size_t)(((0 * 2 + 0) * 2 + b) * 4 + g) * SEQ * 128; const bf16* Vs = KV + (size_t)(((0 * 2 + 1) * 2 + b) * 4 + g) * SEQ * 128;
#pragma unroll
      for (int d_ = 0; d_ < 4; ++d_) S.o[d_] = f32x16{};
      S.m = -1e30f; S.l = 0.f;
      const MaskSel ms{ql, qb, mysel};
      flash_branch(lds, Ks, Vs, 0, qb + 1, ms, qr, S, vb0, r32, hi, al_l, sr, sc, kws, vst0, vst1);
      merge_branch(S, accw, sc_l, g_sel, r32, hi, false); }
    { const bf16* Kw = KV + (size_t)(((1 * 2 + 0) * 2 + b) * 4 + g) * SEQ * 128; const bf16* Vw = KV + (size_t)(((1 * 2 + 1) * 2 + b) * 4 + g) * SEQ * 128;
#pragma unroll
      for (int d_ = 0; d_ < 4; ++d_) S.o[d_] = f32x16{};
      S.m = -1e30f; S.l = 0.f;
      const MaskWin mw{t};
      flash_branch(lds, Kw, Vw, qb >= 8 ? qb - 8 : 0, qb + 1, mw, qr, S, vb0, r32, hi, al_l, sr, sc, kws, vst0, vst1);
      merge_branch(S, accw, sc_l, g_win, r32, hi, false); }
    int lane2 = lane; asm volatile("" : "+v"(lane2));
#pragma unroll
    for (int i = 0; i < 8; ++i) { const int row = i * 4 + (lane2 >> 4), ch = lane2 & 15; const v4u w = *(const v4u*)(accw + row * 128 + ch * 8);
        *(GAS v4u*)(AO + (size_t)(b * SEQ + 64 * qb + qh * 32 + row) * DM + h * 128 + ch * 8) = w; }
    __syncthreads();
}
#undef KSWZ
#undef SBAR
}
__device__ __forceinline__ void p4_attention(Frame& F) {
    unsigned char* ws = F.ws;
    for (int it2 = blockIdx.x * 2; it2 < 512; it2 += (it2 & 1) ? 2 * F.G - 1 : 1) { const int it = it2 >> 1, b = it >> 7, g = (it >> 5) & 3, p = it & 31, qb = (it2 & 1) ? 63 - p : p;
        att::attn_unit((char*)F.lds, b, g, qb, (const bf16*)(ws + WS_Q), (const bf16*)(ws + WS_KCP), (const bf16*)(ws + WS_KV), (const float*)(ws + WS_GATES), (bf16*)(ws + WS_AO)); }
}
struct KRow { const void* p; int f32; };
__device__ __forceinline__ void krow_load8(const KRow& r, int d8, float (&v)[8]) {
    if (r.f32) { const f32x4 a = *((const f32x4*)r.p + 2 * d8), b = *((const f32x4*)r.p + 2 * d8 + 1); v[0] = a[0]; v[1] = a[1]; v[2] = a[2]; v[3] = a[3]; v[4] = b[0]; v[5] = b[1]; v[6] = b[2]; v[7] = b[3]; }
    else { const v4u w = *((const v4u*)r.p + d8); v[0] = bf2f(w.x & 0xffff); v[1] = bf2f(w.x >> 16); v[2] = bf2f(w.y & 0xffff); v[3] = bf2f(w.y >> 16); v[4] = bf2f(w.z & 0xffff); v[5] = bf2f(w.z >> 16); v[6] = bf2f(w.w & 0xffff); v[7] = bf2f(w.w >> 16); }
}
__device__ __forceinline__ f32x2 krow_load2(const KRow& r, int d2) {
    if (r.f32) return *((const f32x2*)r.p + d2);
    const unsigned w = *((const unsigned*)r.p + d2); return (f32x2){bf2f(w & 0xffff), bf2f(w >> 16)};
}
struct VAttnCtx {
    int smp;
    int b, g, t, pos;
    const bf16 *KC, *VC;
    int n_cmp, n_blk;
    const bf16 *Ks, *Vs, *Kw, *Vw;
    const float *cache_sel, *state_win, *out; const int* page_table;
};
__device__ __forceinline__ bool sel_key(const VAttnCtx& C, int blk, int kin, KRow& kr, KRow& vr) {
    const int kpos = blk * 64 + kin; if (kpos > C.pos) return false;
    if (!C.smp) { kr = KRow{C.Ks + (size_t)kpos * 128, 0}; vr = KRow{C.Vs + (size_t)kpos * 128, 0}; return true; }
    if (kpos >= PAST) { const float* r = C.out + O_SELS + (size_t)(C.b * 4 + (kpos - PAST)) * 1024 + C.g * 128; kr = KRow{r, 1}; vr = KRow{r + 512, 1}; return true; }
    const int page = C.page_table[C.b * 128 + (kpos >> 7)]; const float* r = C.cache_sel + ((size_t)page * 128 + (kpos & 127)) * 1024 + C.g * 128; kr = KRow{r, 1}; vr = KRow{r + 512, 1}; return true;
}
__device__ __forceinline__ bool win_key(const VAttnCtx& C, int i, KRow& kr, KRow& vr) {
    if (!C.smp) { const int kpos = C.pos - 511 + i; if (kpos < 0 || kpos > C.pos) return false; kr = KRow{C.Kw + (size_t)kpos * 128, 0}; vr = KRow{C.Vw + (size_t)kpos * 128, 0}; return true; }
    const int kpos = PAST - 512 + i, dlt = C.pos - kpos; if (dlt < 0 || dlt >= 512) return false;
    const float* r = (i < 512) ? C.state_win + ((size_t)C.b * 512 + i) * 1024 + C.g * 128 : C.out + O_WINS + ((size_t)C.b * 512 + 508 + (i - 512)) * 1024 + C.g * 128;
    kr = KRow{r, 1}; vr = KRow{r + 512, 1}; return true;
}
template <int BR>
__device__ __forceinline__ void vattn_branch(const VAttnCtx& C, LAS float* L, int nkeys, const LAS int* sel_idx, float (&oacc)[4][2], float (&lsum)[4]) {
    const int tid = threadIdx.x, lane = tid & 63, wave = tid >> 6;
    LAS float* q = L; LAS float* sc = L + 512; LAS float* red = L + 4864; LAS float* opart = L + 5120;
    float lmax[4] = {-__builtin_inff(), -__builtin_inff(), -__builtin_inff(), -__builtin_inff()};
    for (int k = tid; k < nkeys; k += NTHR) { KRow kr{nullptr, 0}, vr{nullptr, 0}; bool ok;
        if (BR == 0) { ok = (16 * k + 31) <= C.pos; kr = KRow{C.KC + (size_t)k * 128, 0}; }
        else if (BR == 1) ok = sel_key(C, sel_idx[k >> 6], k & 63, kr, vr);
        else ok = win_key(C, k, kr, vr);
        float s[4] = {0.f, 0.f, 0.f, 0.f};
        if (ok) { for (int d8 = 0; d8 < 16; ++d8) { float kv[8]; krow_load8(kr, d8, kv);
#pragma unroll
                for (int r = 0; r < 4; ++r) { const LAS float* qq = q + r * 128 + d8 * 8;
#pragma unroll
                    for (int j = 0; j < 8; ++j) s[r] += qq[j] * kv[j]; } } }
#pragma unroll
        for (int r = 0; r < 4; ++r) { s[r] = ok ? s[r] * 0.08838834764831845f : -__builtin_inff(); sc[k * 4 + r] = s[r]; lmax[r] = fmaxf(lmax[r], s[r]); } }
#pragma unroll
    for (int r = 0; r < 4; ++r) { lmax[r] = wave_max(lmax[r]); if (lane == 0) red[wave * 4 + r] = lmax[r]; }
    __syncthreads();
    float m[4];
#pragma unroll
    for (int r = 0; r < 4; ++r) { float v = red[r]; for (int w = 1; w < 8; ++w) v = fmaxf(v, red[w * 4 + r]); m[r] = v; }
    __syncthreads();
    float ls[4] = {0.f, 0.f, 0.f, 0.f};
    for (int k = tid; k < nkeys; k += NTHR) {
#pragma unroll
        for (int r = 0; r < 4; ++r) { const float s = sc[k * 4 + r]; const float p = (s == -__builtin_inff()) ? 0.f : __expf(s - m[r]); sc[k * 4 + r] = p; ls[r] += p; } }
#pragma unroll
    for (int r = 0; r < 4; ++r) { ls[r] = wave_sum(ls[r]); if (lane == 0) red[wave * 4 + r] = ls[r]; }
    __syncthreads();
#pragma unroll
    for (int r = 0; r < 4; ++r) { float v = 0.f; for (int w = 0; w < 8; ++w) v += red[w * 4 + r]; lsum[r] = v; }
    float o[4][2] = {{0.f, 0.f}, {0.f, 0.f}, {0.f, 0.f}, {0.f, 0.f}};
    for (int k = wave; k < nkeys; k += 8) { KRow kr{nullptr, 0}, vr{nullptr, 0}; bool ok;
        if (BR == 0) { ok = (16 * k + 31) <= C.pos; vr = KRow{C.VC + (size_t)k * 128, 0}; }
        else if (BR == 1) ok = sel_key(C, sel_idx[k >> 6], k & 63, kr, vr);
        else ok = win_key(C, k, kr, vr);
        if (!ok) continue;
        const f32x2 v2 = krow_load2(vr, lane); const f32x4 p = *(const LAS f32x4*)(sc + k * 4);
#pragma unroll
        for (int r = 0; r < 4; ++r) { o[r][0] += p[r] * v2[0]; o[r][1] += p[r] * v2[1]; } }
#pragma unroll
    for (int r = 0; r < 4; ++r) { opart[(wave * 4 + r) * 128 + 2 * lane] = o[r][0]; opart[(wave * 4 + r) * 128 + 2 * lane + 1] = o[r][1]; }
    __syncthreads();
    if (wave == 0) {
#pragma unroll
        for (int r = 0; r < 4; ++r) { float a0 = 0.f, a1 = 0.f; for (int w = 0; w < 8; ++w) { a0 += opart[(w * 4 + r) * 128 + 2 * lane]; a1 += opart[(w * 4 + r) * 128 + 2 * lane + 1]; } oacc[r][0] = a0; oacc[r][1] = a1; } }
    __syncthreads();
}
template <class QF, class EmitF>
__device__ __forceinline__ void vattn_unit(const VAttnCtx& C, LAS float* L, const QF& qf, const float* gates_row, const EmitF& emit) {
    const int tid = threadIdx.x, lane = tid & 63, wave = tid >> 6;
    LAS float* sc = L + 512; LAS float* imp = L + 9216; LAS float* score = L + 10240; LAS int* idx = (LAS int*)(L + 10512);
    L[tid] = qf(tid >> 7, tid & 127);
    __syncthreads();
    float ocmp[4][2], osel[4][2], owin[4][2], lc[4], lsl[4], lw[4];
    vattn_branch<0>(C, L, C.n_cmp, nullptr, ocmp, lc);
    for (int c = tid; c < 1024; c += NTHR) { float v = 0.f; if (c < C.n_cmp) {
#pragma unroll
            for (int r = 0; r < 4; ++r) v += lc[r] > 0.f ? sc[c * 4 + r] / lc[r] : 0.f; } imp[c] = v; }
    __syncthreads();
    const int cur = C.pos >> 6;
    if (tid < C.n_blk) { float v = 0.f; for (int c = 4 * tid - 1; c <= 4 * tid + 3; ++c) if (c >= 0 && c < C.n_cmp) v += imp[c];
        const bool visible = tid <= cur, forced = (tid == 0) || (visible && tid > cur - 2); score[tid] = forced ? 1e9f : (visible ? v : -1e9f); }
    __syncthreads();
    if (tid < C.n_blk) { const float s = score[tid]; int rank = 0; for (int j = 0; j < C.n_blk; ++j) { const float o = score[j]; rank += (o > s || (o == s && j < tid)) ? 1 : 0; } if (rank < 16) idx[rank] = tid; }
    __syncthreads();
    vattn_branch<1>(C, L, 16 * 64, idx, osel, lsl);
    vattn_branch<2>(C, L, C.smp ? 516 : 512, nullptr, owin, lw);
    if (wave == 0) {
#pragma unroll
        for (int r = 0; r < 4; ++r) { const int h = 4 * C.g + r; const float g0 = gates_row[h], g1 = gates_row[16 + h], g2 = gates_row[32 + h];
            const float s0 = lc[r] > 0.f ? g0 / lc[r] : 0.f, s1 = lsl[r] > 0.f ? g1 / lsl[r] : 0.f, s2 = lw[r] > 0.f ? g2 / lw[r] : 0.f;
            emit(r, 2 * lane, ocmp[r][0] * s0 + osel[r][0] * s1 + owin[r][0] * s2); emit(r, 2 * lane + 1, ocmp[r][1] * s0 + osel[r][1] * s1 + owin[r][1] * s2); } }
    __syncthreads();
}

__device__ __forceinline__ void p4_sample_attention(Frame& F, const float* cache_sel, const float* state_win, const int* page_table) {
    unsigned char* ws = F.ws; LAS float* L = (LAS float*)(F.lds + RING_OFF);
    for (int it = blockIdx.x; it < 128; it += F.G) { const int b = it >> 4, g = (it >> 2) & 3, t = it & 3, bg = b * 4 + g, sr = b * 4 + t;
        VAttnCtx C{}; C.smp = 1; C.b = b; C.g = g; C.t = t; C.pos = PAST + t; C.KC = (const bf16*)(ws + WS_KCS) + (size_t)(0 * 32 + bg) * 1024 * 128; C.VC = (const bf16*)(ws + WS_KCS) + (size_t)(1 * 32 + bg) * 1024 * 128;
        C.n_cmp = 1023; C.n_blk = 257; C.cache_sel = cache_sel; C.state_win = state_win; C.out = F.out; C.page_table = page_table;
        const float* qs = (const float*)(ws + WS_QS) + (size_t)sr * DM + 4 * g * 128; bf16* ao = (bf16*)(ws + WS_AOS) + (size_t)sr * DM + 4 * g * 128;
        vattn_unit(C, L, [=](int r, int d) { return qs[r * 128 + d]; }, (const float*)(ws + WS_GATES) + (size_t)(MP + sr) * 48, [=](int r, int d, float v) { ao[r * 128 + d] = (bf16)f2bf(v); }); }
}
__device__ __forceinline__ float rstd_of(const float* ssq, int row) { return 1.0f / sqrtf(ssq[row] * (1.f / DM) + 1e-6f); }

struct EpiResid {
    static constexpr bool PERM = false, AFTER_DRAIN = false;
    const float* Hin; float* H; bf16* XN; const float* gnext; float* ssq;
    __device__ __forceinline__ void operator()(const pg8::f32x4 (&acc)[2][2][4][2], const pg8::Unit& u, int wr, int wc, int fr, int fq) const {
        const int col0 = u.pn * 256 + wc * 32 + 4 * fq;
        f32x4 gv[2][2];
#pragma unroll
        for (int bj = 0; bj < 2; ++bj)
#pragma unroll
            for (int n = 0; n < 2; ++n) gv[bj][n] = *(const GAS f32x4*)(gnext + col0 + bj * 128 + n * 16);
#pragma unroll
        for (int ai = 0; ai < 2; ++ai)
#pragma unroll
            for (int m = 0; m < 4; ++m) { const int row = u.pm * 256 + ai * 128 + wr * 64 + m * 16 + fr; const size_t off = (size_t)row * DM + col0; float s = 0.f;
#pragma unroll
                for (int bj = 0; bj < 2; ++bj)
#pragma unroll
                    for (int n = 0; n < 2; ++n) { const f32x4 h = *(const GAS f32x4*)(Hin + off + bj * 128 + n * 16) + acc[ai][bj][m][n]; *(GAS f32x4*)(H + off + bj * 128 + n * 16) = h;
                        s += (h[0] * h[0] + h[1] * h[1]) + (h[2] * h[2] + h[3] * h[3]); const f32x4 x = h * gv[bj][n]; *(GAS v2u*)(XN + off + bj * 128 + n * 16) = pk4(x); }
                s += __shfl_xor(s, 16); s += __shfl_xor(s, 32);
                if (fq == 0) atomicAdd(ssq + row, s); }
    }
};
struct EpiFfn1 {
    static constexpr bool PERM = true, AFTER_DRAIN = false;
    bf16* O; const float* ssq;
    __device__ __forceinline__ void operator()(const pg8::f32x4 (&acc)[2][2][4][2], const pg8::Unit& u, int wr, int wc, int fr, int fq) const {
        const int col0 = u.pn * 256 + wc * 32 + 8 * fq;
#pragma unroll
        for (int ai = 0; ai < 2; ++ai)
#pragma unroll
            for (int m = 0; m < 4; ++m) { const int row = u.pm * 256 + ai * 128 + wr * 64 + m * 16 + fr; const float rs = rstd_of(ssq, row); bf16* rowp = O + (size_t)row * DFF + col0;
#pragma unroll
                for (int bj = 0; bj < 2; ++bj) { f32x4 v0 = acc[ai][bj][m][0] * rs, v1 = acc[ai][bj][m][1] * rs;
#pragma unroll
                    for (int j = 0; j < 4; ++j) { const float a = fmaxf(v0[j], 0.f), b = fmaxf(v1[j], 0.f); v0[j] = a * a; v1[j] = b * b; }
                    v4u w; w.x = pk2(v0[0], v0[1]); w.y = pk2(v0[2], v0[3]); w.z = pk2(v1[0], v1[1]); w.w = pk2(v1[2], v1[3]); *(GAS v4u*)(rowp + bj * 128) = w; } }
    }
};
__device__ __forceinline__ float siluf_(float x) { return x / (1.0f + __expf(-x)); }
struct EpiRetIn {
    static constexpr bool PERM = false, AFTER_DRAIN = false;
    bf16 *RQ, *RK, *RV, *RG; const float* rope; const float* ssq;
    __device__ __forceinline__ void operator()(const pg8::f32x4 (&acc)[2][2][4][2], const pg8::Unit& u, int wr, int wc, int fr, int fq) const {
        const int pn = u.pn, cw = wc * 32 + 4 * fq;
#pragma unroll
        for (int ai = 0; ai < 2; ++ai)
#pragma unroll
            for (int m = 0; m < 4; ++m) { const int row = u.pm * 256 + ai * 128 + wr * 64 + m * 16 + fr, b = row >> 12, t = row & 4095; const float rs = rstd_of(ssq, row);
                if (pn < 16) { const int h = pn & 7; const float sc = pn < 8 ? rs : rs * 0.0625f; bf16* dst = (pn < 8 ? RQ : RK) + ((size_t)(b * 8 + h) * SEQ + t) * 256;
#pragma unroll
                    for (int n = 0; n < 2; ++n) { const int d = cw + 16 * n; const f32x4 csA = *(const GAS f32x4*)(rope + ((size_t)t * 128 + d) * 2), csB = *(const GAS f32x4*)(rope + ((size_t)t * 128 + d) * 2 + 4);
                        f32x4 o1, o2; rope4(acc[ai][0][m][n] * sc, acc[ai][1][m][n] * sc, csA, csB, o1, o2); *(GAS v2u*)(dst + d) = pk4(o1); *(GAS v2u*)(dst + 128 + d) = pk4(o2); } }
                else if (pn < 32) { const int h = (pn - 16) >> 1; bf16* dst = RV + ((size_t)(b * 8 + h) * SEQ + t) * 512 + ((pn - 16) & 1) * 256 + cw;
#pragma unroll
                    for (int bj = 0; bj < 2; ++bj)
#pragma unroll
                        for (int n = 0; n < 2; ++n) *(GAS v2u*)(dst + bj * 128 + n * 16) = pk4(acc[ai][bj][m][n] * rs); }
                else { bf16* dst = RG + (size_t)row * 4096 + (pn - 32) * 256 + cw;
#pragma unroll
                    for (int bj = 0; bj < 2; ++bj)
#pragma unroll
                        for (int n = 0; n < 2; ++n) { const f32x4 v = acc[ai][bj][m][n] * rs; *(GAS v2u*)(dst + bj * 128 + n * 16) = pk4((f32x4){siluf_(v[0]), siluf_(v[1]), siluf_(v[2]), siluf_(v[3])}); } } }
    }
};

__device__ __forceinline__ void skinny_resid(Frame& F, const bf16* A, const bf16* Wt, int K, const float* Hin, float* H, bf16* XNs, const float* gnext, float* ssq_s) {
    const int lane = F.lane, r16 = lane & 15, q4 = lane >> 4;
    for (int sl = F.gw; sl < DM / 32; sl += F.NGW) { f32x4 acc[2][2]; skinny_mma(A, Wt, K, 32 * sl, lane, acc);
#pragma unroll
        for (int rh = 0; rh < 2; ++rh) { const int sr = rh * 16 + r16; float s = 0.f;
#pragma unroll
            for (int cs = 0; cs < 2; ++cs) { const int col = 32 * sl + cs * 16 + 4 * q4; const size_t off = (size_t)sr * DM + col; const f32x4 h = *(const f32x4*)(Hin + off) + acc[rh][cs]; *(f32x4*)(H + off) = h;
                s += (h[0] * h[0] + h[1] * h[1]) + (h[2] * h[2] + h[3] * h[3]); *(v2u*)(XNs + off) = pk4(h * *(const f32x4*)(gnext + col)); }
            s += __shfl_xor(s, 16); s += __shfl_xor(s, 32);
            if (q4 == 0) atomicAdd(ssq_s + sr, s); } }
}
__device__ __forceinline__ void skinny_ffn1(Frame& F, const bf16* A, const bf16* Wt, bf16* HFFs, const float* ssq_s) {
    const int lane = F.lane, r16 = lane & 15, q4 = lane >> 4;
    for (int sl = F.gw; sl < DFF / 32; sl += F.NGW) { f32x4 acc[2][2]; skinny_mma(A, Wt, DM, 32 * sl, lane, acc);
#pragma unroll
        for (int rh = 0; rh < 2; ++rh) { const int sr = rh * 16 + r16; const float rs = rstd_of(ssq_s, sr);
#pragma unroll
            for (int cs = 0; cs < 2; ++cs) { f32x4 v = acc[rh][cs] * rs;
#pragma unroll
                for (int j = 0; j < 4; ++j) { const float a = fmaxf(v[j], 0.f); v[j] = a * a; }
                *(v2u*)(HFFs + (size_t)sr * DFF + 32 * sl + cs * 16 + 4 * q4) = pk4(v); } } }
}
__device__ __forceinline__ void skinny_retin(Frame& F, const bf16* A, const bf16* Wt, const float* rope, const float* ssq_s, float* RSQ, float* RSK, float* RSV, float* RSG) {
    const int lane = F.lane, r16 = lane & 15, q4 = lane >> 4;
    for (int task = F.gw; task < 64 + 256; task += F.NGW) {
        if (task < 64) { const int hh = task >> 2, wc = task & 3; f32x4 a1[2][2], a2[2][2]; skinny_mma(A, Wt, DM, hh * 256 + wc * 32, lane, a1); skinny_mma(A, Wt, DM, hh * 256 + 128 + wc * 32, lane, a2);
#pragma unroll
            for (int rh = 0; rh < 2; ++rh) { const int sr = rh * 16 + r16, t = sr & 3; const float rs = rstd_of(ssq_s, sr) * (hh < 8 ? 1.f : 0.0625f); float* dst = (hh < 8 ? RSQ : RSK) + (size_t)sr * 2048 + (hh & 7) * 256;
#pragma unroll
                for (int cs = 0; cs < 2; ++cs) { const int d = wc * 32 + cs * 16 + 4 * q4; const f32x4 csA = *(const f32x4*)(rope + ((size_t)(4096 + t) * 128 + d) * 2), csB = *(const f32x4*)(rope + ((size_t)(4096 + t) * 128 + d) * 2 + 4);
                    f32x4 o1, o2; rope4(a1[rh][cs] * rs, a2[rh][cs] * rs, csA, csB, o1, o2); *(f32x4*)(dst + d) = o1; *(f32x4*)(dst + 128 + d) = o2; } } }
        else { const int sl = task - 64, col0 = 4096 + 32 * sl; f32x4 acc[2][2]; skinny_mma(A, Wt, DM, col0, lane, acc);
#pragma unroll
            for (int rh = 0; rh < 2; ++rh) { const int sr = rh * 16 + r16; const float rs = rstd_of(ssq_s, sr);
#pragma unroll
                for (int cs = 0; cs < 2; ++cs) { const int c = 32 * sl + cs * 16 + 4 * q4; f32x4 v = acc[rh][cs] * rs;
                    if (c < 4096) *(f32x4*)(RSV + (size_t)sr * 4096 + c) = v; else *(f32x4*)(RSG + (size_t)sr * 4096 + (c - 4096)) = (f32x4){siluf_(v[0]), siluf_(v[1]), siluf_(v[2]), siluf_(v[3])}; } } }
    }
}
namespace ret {
typedef float f32x16 __attribute__((ext_vector_type(16)));
__device__ __forceinline__ float log2_gamma(int h) { return log2f(1.0f - exp2f(-5.0f - (float)h)); }
__device__ __forceinline__ int crow(int r, int hi) { return (r & 3) + 8 * (r >> 2) + 4 * hi; }
__device__ __forceinline__ void r1_unit(int bh, int c, const bf16* RQ, const bf16* RK, bf16* RS, int wid, int lane) {
    const int r32 = lane & 31, hi = lane >> 5, h = bh & 7, ib = wid >> 1; const float l2g = log2_gamma(h);
    const bf16* qp = RQ + ((size_t)bh * SEQ + c * 128 + ib * 32 + r32) * 256 + hi * 8;
    bf16* sp = RS + ((size_t)bh * 32 + c) * 128 * 128;
#pragma unroll
    for (int jj = 0; jj < 2; ++jj) { const int jb = 2 * (wid & 1) + jj;
        if (jb > ib) {
#pragma unroll
            for (int r = 0; r < 16; ++r) sp[(size_t)(ib * 32 + crow(r, hi)) * 128 + jb * 32 + r32] = 0;
            continue; }
        const bf16* kp = RK + ((size_t)bh * SEQ + c * 128 + jb * 32 + r32) * 256 + hi * 8;
        f32x16 acc = f32x16{};
#pragma unroll
        for (int kk = 0; kk < 16; ++kk) { const bf16x8 a = *(const bf16x8*)(qp + kk * 16), b = *(const bf16x8*)(kp + kk * 16); acc = __builtin_amdgcn_mfma_f32_32x32x16_bf16(a, b, acc, 0, 0, 0); }
#pragma unroll
        for (int r = 0; r < 16; ++r) { const int i = ib * 32 + crow(r, hi), j = jb * 32 + r32; const float v = (i >= j) ? acc[r] * exp2f((float)(i - j) * l2g) : 0.f; sp[(size_t)i * 128 + j] = (bf16)f2bf(v); }
    }
}
constexpr int KT_LD = 136, VT_LD = 136, ST_LD = 264, L_KT = 0, L_VT = 69632, L_ST = 78336;
__device__ __forceinline__ void r2_unit(char* lds, int bh, int es, const bf16* RQ, const bf16* RK, const bf16* RV, const bf16* RS, bf16* RO, float* out_state) {
    int tid = threadIdx.x; asm volatile("" : "+v"(tid));
    const int wid = __builtin_amdgcn_readfirstlane(tid >> 6), lane = tid & 63, r32 = lane & 31, hi = lane >> 5, h = bh & 7, b = bh >> 3;
    const float l2g = log2_gamma(h), gC = exp2f(128.f * l2g);
    bf16* KT = (bf16*)(lds + L_KT); bf16* VT = (bf16*)(lds + L_VT); bf16* ST = (bf16*)(lds + L_ST);
    f32x16 accS = f32x16{};
    for (int i = tid; i < 32 * ST_LD / 2; i += NTHR) ((unsigned*)ST)[i] = 0u;
    const int sj = tid & 127, sg = tid >> 7;
    for (int c = 0; c < 32; ++c) {
        const size_t tok0 = (size_t)bh * SEQ + c * 128;
        { const float kd = exp2f((float)(127 - sj) * l2g); const bf16* kr = RK + (tok0 + sj) * 256;
#pragma unroll
          for (int i = 0; i < 8; ++i) { const int d0 = (sg + 4 * i) * 8; const v4u w = *(const v4u*)(kr + d0); const unsigned ww[4] = {w.x, w.y, w.z, w.w};
#pragma unroll
              for (int x = 0; x < 4; ++x) { KT[(d0 + 2 * x) * KT_LD + sj] = (bf16)f2bf(bf2f(ww[x] & 0xffff) * kd); KT[(d0 + 2 * x + 1) * KT_LD + sj] = (bf16)f2bf(bf2f(ww[x] >> 16) * kd); } }
          const v4u w = *(const v4u*)(RV + (tok0 + sj) * 512 + es * 32 + sg * 8); const unsigned ww[4] = {w.x, w.y, w.z, w.w};
#pragma unroll
          for (int x = 0; x < 4; ++x) { VT[(sg * 8 + 2 * x) * VT_LD + sj] = (bf16)(ww[x] & 0xffff); VT[(sg * 8 + 2 * x + 1) * VT_LD + sj] = (bf16)(ww[x] >> 16); } }
        __syncthreads();
        if (wid < 4) { const int ib = wid; f32x16 aI = f32x16{}, aC = f32x16{};
            const bf16* srow = RS + (((size_t)bh * 32 + c) * 128 + ib * 32 + r32) * 128 + hi * 8;
            for (int kk = 0; kk < 2 * (ib + 1); ++kk) { const bf16x8 a = *(const bf16x8*)(srow + kk * 16), bb = *(const bf16x8*)(VT + r32 * VT_LD + kk * 16 + hi * 8); aI = __builtin_amdgcn_mfma_f32_32x32x16_bf16(a, bb, aI, 0, 0, 0); }
            const bf16* qrow = RQ + (tok0 + ib * 32 + r32) * 256 + hi * 8;
#pragma unroll
            for (int kk = 0; kk < 16; ++kk) { const bf16x8 a = *(const bf16x8*)(qrow + kk * 16), bb = *(const bf16x8*)(ST + r32 * ST_LD + kk * 16 + hi * 8); aC = __builtin_amdgcn_mfma_f32_32x32x16_bf16(a, bb, aC, 0, 0, 0); }
#pragma unroll
            for (int r = 0; r < 16; ++r) { const int i = ib * 32 + crow(r, hi); const float o = aI[r] + aC[r] * exp2f((float)(i + 1) * l2g);
                RO[((size_t)b * SEQ + c * 128 + i) * 4096 + h * 512 + es * 32 + r32] = (bf16)f2bf(o); } }
#pragma unroll
        for (int r = 0; r < 16; ++r) accS[r] *= gC;
#pragma unroll
        for (int kk = 0; kk < 8; ++kk) { const bf16x8 a = *(const bf16x8*)(VT + r32 * VT_LD + kk * 16 + hi * 8), bb = *(const bf16x8*)(KT + (wid * 32 + r32) * KT_LD + kk * 16 + hi * 8); accS = __builtin_amdgcn_mfma_f32_32x32x16_bf16(a, bb, accS, 0, 0, 0); }
        __syncthreads();
#pragma unroll
        for (int r = 0; r < 16; ++r) ST[crow(r, hi) * ST_LD + wid * 32 + r32] = (bf16)f2bf(accS[r]);
    }
#pragma unroll
    for (int r = 0; r < 16; ++r) out_state[(((size_t)bh) * 256 + wid * 32 + r32) * 512 + es * 32 + crow(r, hi)] = accS[r];
    __syncthreads();
}
}
__device__ __forceinline__ void p_ret_s(Frame& F) {
    unsigned char* ws = F.ws;
    for (int it = blockIdx.x; it < 512; it += F.G) ret::r1_unit(it >> 5, it & 31, (const bf16*)(ws + WS_RQ), (const bf16*)(ws + WS_RK), (bf16*)(ws + WS_RS), F.wave, F.lane);
}
__device__ __forceinline__ void p_ret_scan(Frame& F) {
    unsigned char* ws = F.ws;
    for (int it = blockIdx.x; it < 256; it += F.G) ret::r2_unit((char*)F.lds, it >> 4, it & 15, (const bf16*)(ws + WS_RQ), (const bf16*)(ws + WS_RK), (const bf16*)(ws + WS_RV), (const bf16*)(ws + WS_RS), (bf16*)(ws + WS_RO), F.out + O_RETP);
}
__device__ __forceinline__ void p_ret_sample(Frame& F, const float* state_in, const float* RSQ, const float* RSK, const float* RSV, float* ROS) {
    LAS float* L = (LAS float*)(F.lds + RING_OFF);
    const int tid = F.tid;
    for (int it = blockIdx.x; it < 256; it += F.G) { const int bh = it >> 2, eq = it & 3, b = bh >> 3, h = bh & 7; const float l2g = ret::log2_gamma(h);
        for (int i = tid; i < 2048; i += NTHR) { const int isk = i >> 10, tk = (i >> 8) & 3, d = i & 255; L[i] = (isk ? RSK : RSQ)[(size_t)(b * 4 + tk) * 2048 + h * 256 + d]; }
        __syncthreads();
        if (tid < 16) { const int i = tid >> 2, j = tid & 3; float s = 0.f; if (i >= j) { for (int d = 0; d < 256; ++d) s += L[i * 256 + d] * L[1024 + j * 256 + d]; s *= exp2f((float)(i - j) * l2g); } L[2048 + tid] = s; }
        __syncthreads();
        const int e = eq * 128 + (tid & 127), dg = tid >> 7;
        float v[4], kd[4]; for (int j = 0; j < 4; ++j) { v[j] = RSV[(size_t)(b * 4 + j) * 4096 + h * 512 + e]; kd[j] = exp2f((float)(3 - j) * l2g); }
        const float g4 = exp2f(4.f * l2g); float cr[4] = {0.f, 0.f, 0.f, 0.f};
        for (int d = dg * 64; d < dg * 64 + 64; ++d) { const size_t si = ((size_t)bh * 256 + d) * 512 + e; const float st = state_in[si]; float ns = g4 * st;
#pragma unroll
            for (int j = 0; j < 4; ++j) { cr[j] += L[j * 256 + d] * st; ns += L[1024 + j * 256 + d] * kd[j] * v[j]; }
            F.out[O_RETS + si] = ns; }
#pragma unroll
        for (int i = 0; i < 4; ++i) L[2112 + (dg * 4 + i) * 128 + (tid & 127)] = cr[i];
        __syncthreads();
        if (tid < 128) {
#pragma unroll
            for (int i = 0; i < 4; ++i) { float c = 0.f; for (int g = 0; g < 4; ++g) c += L[2112 + (g * 4 + i) * 128 + tid]; float inner = 0.f; for (int j = 0; j <= i; ++j) inner += L[2048 + i * 4 + j] * v[j];
                ROS[(size_t)(b * 4 + i) * 4096 + h * 512 + e] = inner + c * exp2f((float)(i + 1) * l2g); } }
        __syncthreads();
    }
}
__device__ __forceinline__ void p_ret_gn(Frame& F, const float* gn, const float* ROS, const float* RSG) {
    unsigned char* ws = F.ws; const int lane = F.lane;
    for (int it = F.gw; it < (MP + NS) * 8; it += F.NGW) { const int row = it >> 3, h = it & 7; float o[8], g[8];
        if (row < MP) { const v4u wo = *(const v4u*)((const bf16*)(ws + WS_RO) + (size_t)row * 4096 + h * 512 + lane * 8), wg = *(const v4u*)((const bf16*)(ws + WS_RG) + (size_t)row * 4096 + h * 512 + lane * 8);
            const unsigned a[4] = {wo.x, wo.y, wo.z, wo.w}, c[4] = {wg.x, wg.y, wg.z, wg.w};
#pragma unroll
            for (int x = 0; x < 4; ++x) { o[2 * x] = bf2f(a[x] & 0xffff); o[2 * x + 1] = bf2f(a[x] >> 16); g[2 * x] = bf2f(c[x] & 0xffff); g[2 * x + 1] = bf2f(c[x] >> 16); } }
        else { const float* po = ROS + (size_t)(row - MP) * 4096 + h * 512 + lane * 8; const float* pg = RSG + (size_t)(row - MP) * 4096 + h * 512 + lane * 8;
#pragma unroll
            for (int x = 0; x < 8; ++x) { o[x] = po[x]; g[x] = pg[x]; } }
        float s = 0.f;
#pragma unroll
        for (int x = 0; x < 8; ++x) s += o[x];
        const float mu = wave_sum(s) * (1.f / 512.f); float q = 0.f;
#pragma unroll
        for (int x = 0; x < 8; ++x) { o[x] -= mu; q += o[x] * o[x]; }
        const float rs = 1.0f / sqrtf(wave_sum(q) * (1.f / 512.f) + 1e-5f); const float* gw = gn + h * 512 + lane * 8;
        v4u w; float y[8];
#pragma unroll
        for (int x = 0; x < 8; ++x) y[x] = g[x] * (o[x] * rs * gw[x]);
        w.x = pk2(y[0], y[1]); w.y = pk2(y[2], y[3]); w.z = pk2(y[4], y[5]); w.w = pk2(y[6], y[7]);
        bf16* dst = row < MP ? (bf16*)(ws + WS_RGA) + (size_t)row * 4096 : (bf16*)(ws + WS_XS) + (size_t)(row - MP) * 4096;
        *(v4u*)(dst + h * 512 + lane * 8) = w; }
}
__device__ __forceinline__ void p_final_norm(Frame& F, const float* H, const float* HS, const float* g) {
    const int lane = F.lane;
    for (int m = F.gw; m < MP + NS; m += F.NGW) { const float* xr = m < MP ? H + (size_t)m * DM : HS + (size_t)(m - MP) * DM; float* yr = m < MP ? F.out + O_YP + (size_t)m * DM : F.out + O_YS + (size_t)(m - MP) * DM;
        const f32x4* x4 = (const f32x4*)xr + lane; f32x4 v[8]; float s = 0.f;
#pragma unroll
        for (int j = 0; j < 8; ++j) { v[j] = x4[64 * j]; s += (v[j].x * v[j].x + v[j].y * v[j].y) + (v[j].z * v[j].z + v[j].w * v[j].w); }
        const float rstd = 1.0f / sqrtf(wave_sum(s) * (1.f / DM) + 1e-6f);
#pragma unroll
        for (int j = 0; j < 8; ++j) { const f32x4 gg = ((const f32x4*)g + lane)[64 * j]; ((f32x4*)yr + lane)[64 * j] = v[j] * rstd * gg; } }
}
#if MK_CHECK
constexpr int CW_CHK = 1024;
__device__ __forceinline__ void chk_cmp(Frame& F, int ch, float got, float want, float rtol, float atol) {
    atomicAdd((unsigned*)(F.ctl + CW_CHK + 8 + ch), 1u);
    if (!(fabsf(got - want) <= atol + rtol * fabsf(want))) atomicAdd((unsigned*)(F.ctl + CW_CHK + ch), 1u);
}
__device__ __forceinline__ int chk_row(int i) { return i == 0 ? 0 : i == 1 ? 1 : i == 2 ? 63 : i == 3 ? 64 : i == 4 ? 255 : i == 5 ? 256 : i == 6 ? 3583 : i == 7 ? 3584 : i == 8 ? 4095 : i == 9 ? 4096 : i == 10 ? 8191 : 5000; }
__device__ __forceinline__ float bfr(float x) { return bf2f((unsigned short)f2bf(x)); }
__device__ void check_p1(Frame& F, const float* x_prompt, const float* x_sample, const float* norm_mix, const float* w_in) {
    unsigned char* ws = F.ws;
    const int NR = 12 + 32;
    for (int task = F.gw; task < NR * 41; task += F.NGW) {
        const int ri = task / 41, hh = task % 41, lane = F.lane;
        const bool smp = ri >= 12; const int row = smp ? ri - 12 : chk_row(ri);
        const float* xr = smp ? x_sample + (size_t)row * DM : x_prompt + (size_t)row * DM;
        double ss = 0; for (int k = 0; k < DM; ++k) ss += (double)xr[k] * xr[k];
        const float rstd = 1.0f / sqrtf((float)(ss / DM) + 1e-6f);
        const int b = smp ? row >> 2 : row >> 12, t = smp ? row & 3 : row & 4095; const float pos = smp ? (float)(PAST + t) : (float)t;
        if (hh == 40) {
            if (lane < 48) { double a = 0; for (int k = 0; k < DM; ++k) a += (double)bfr(xr[k] * rstd * norm_mix[k]) * (double)bfr(w_in[(size_t)k * NSA_N + 5120 + lane]);
                const float want = 1.f / (1.f + expf(-(float)a)); const float got = ((const float*)(ws + WS_GATES))[(size_t)(smp ? MP + row : row) * 48 + lane]; chk_cmp(F, 0, got, want, 1e-3f, 1e-3f); }
            continue;
        }
        const int n1 = hh * 128 + lane, n2 = n1 + 64; double a1 = 0, a2 = 0;
        for (int k = 0; k < DM; ++k) { const double xv = (double)bfr(xr[k] * rstd * norm_mix[k]); a1 += xv * (double)bfr(w_in[(size_t)k * NSA_N + n1]); a2 += xv * (double)bfr(w_in[(size_t)k * NSA_N + n2]); }
        float o1 = (float)a1, o2 = (float)a2;
        const bool roped = hh < 16 || (((hh - 16) >> 2) & 1) == 0;
        if (roped) { const float inv = powf(10000.f, -(float)lane / 64.f); const float ang = pos * inv; const double c = cos((double)ang), s = sin((double)ang);
            o1 = (float)(a1 * c - a2 * s); o2 = (float)(a2 * c + a1 * s); }
        if (hh < 16) {
            if (smp) { const float* q = (const float*)(ws + WS_QS) + (size_t)row * DM + hh * 128 + lane; chk_cmp(F, 0, q[0], o1, 2e-3f, 2e-3f); chk_cmp(F, 0, q[64], o2, 2e-3f, 2e-3f); }
            else { const bf16* q = (const bf16*)(ws + WS_Q) + ((size_t)(b * 16 + hh) * SEQ + t) * 128 + lane; chk_cmp(F, 1, bf2f(q[0]), o1, 1e-2f, 1e-2f); chk_cmp(F, 1, bf2f(q[64]), o2, 1e-2f, 1e-2f); }
        } else {
            const int hk = hh - 16, br = hk >> 3, e = (hk >> 2) & 1, g = hk & 3;
            const float* o = nullptr;
            if (smp) o = (br == 0) ? F.out + O_CMPS + (size_t)row * 1024 : (br == 1) ? F.out + O_SELS + (size_t)row * 1024 : F.out + O_WINS + ((size_t)b * 512 + 508 + t) * 1024;
            else { if (br == 0) o = F.out + O_CMPP + (size_t)row * 1024; else if (br == 1) o = F.out + O_SELP + (size_t)row * 1024; else if (t >= SEQ - 512) o = F.out + O_WINP + ((size_t)b * 512 + t - (SEQ - 512)) * 1024; }
            if (o) { o += e * 512 + g * 128 + lane; chk_cmp(F, 0, o[0], o1, 2e-3f, 2e-3f); chk_cmp(F, 0, o[64], o2, 2e-3f, 2e-3f); }
            if (!smp) { const bf16* kv = (br == 0 ? (const bf16*)(ws + WS_KVC) + ((size_t)((e * 2 + b) * 4 + g) * SEQ + t) * 128 : (const bf16*)(ws + WS_KV) + ((size_t)((((br - 1) * 2 + e) * 2 + b) * 4 + g) * SEQ + t) * 128) + lane; chk_cmp(F, 1, bf2f(kv[0]), o1, 1e-2f, 1e-2f); chk_cmp(F, 1, bf2f(kv[64]), o2, 1e-2f, 1e-2f); }
        }
    }
}
__device__ void check_cmp(Frame& F, const float* cache_cmp, const int* page_table, const float* cmp_pos, const float* w1, const float* b1, const float* w2) {
    unsigned char* ws = F.ws; const int lane = F.lane;
    for (int task = F.gw; task < 64 + 8; task += F.NGW) {
        int set, e, b, g, i;
        if (task < 64) { set = task >> 5; e = (task >> 4) & 1; const int bi = (task >> 3) & 1, gi = (task >> 2) & 1, ii = task & 3;
            if (set == 0) { b = bi; g = gi ? 3 : 0; i = ii == 0 ? 0 : ii == 1 ? 1 : ii == 2 ? 127 : 254; } else { b = bi ? 7 : 0; g = gi ? 2 : 1; i = ii == 0 ? 0 : ii == 1 ? 7 : ii == 2 ? 8 : 1022; } }
        else { const int j = task - 64; set = j >> 2; e = (j >> 1) & 1; b = j & 1; g = 1; i = set ? 1023 : 255; }
        const bf16* got = set == 0 ? (const bf16*)(ws + WS_KCP) + (((size_t)e * 8 + b * 4 + g) * 256 + i) * 128 : (const bf16*)(ws + WS_KCS) + (((size_t)e * 32 + b * 4 + g) * 1024 + i) * 128;
        if (task >= 64) { chk_cmp(F, 2, bf2f(got[lane]), 0.f, 0.f, 0.f); chk_cmp(F, 2, bf2f(got[lane + 64]), 0.f, 0.f, 0.f); continue; }
        double h0 = 0, h1 = 0;
        for (int k = 0; k < 4096; ++k) { const int s = k >> 7, d = k & 127, tok = i * 16 + s; float rv;
            if (set == 0) rv = F.out[O_CMPP + ((size_t)b * SEQ + tok) * 1024 + e * 512 + g * 128 + d];
            else { const int page = page_table[b * 128 + (tok >> 7)]; rv = cache_cmp[((size_t)page * 128 + (tok & 127)) * 1024 + e * 512 + g * 128 + d]; }
            const double x = (double)bfr(rv); const float* wr = w1 + ((size_t)e * 4096 + k) * 128; const double pp = (double)cmp_pos[e * 4096 + k];
            h0 += x * (double)bfr(wr[lane]) + pp * (double)wr[lane]; h1 += x * (double)bfr(wr[lane + 64]) + pp * (double)wr[lane + 64]; }
        h0 += b1[e * 128 + lane]; h1 += b1[e * 128 + lane + 64];
        const float a0 = bfr((float)(0.5 * h0 * (1.0 + tanh(0.7978845608028654 * (h0 + 0.044715 * h0 * h0 * h0))))), a1 = bfr((float)(0.5 * h1 * (1.0 + tanh(0.7978845608028654 * (h1 + 0.044715 * h1 * h1 * h1)))));
        double o0 = 0, o1 = 0;
        for (int h = 0; h < 128; ++h) { const float av = __shfl(h < 64 ? a0 : a1, h & 63); const float* wr = w2 + ((size_t)e * 128 + h) * 128; o0 += (double)av * (double)bfr(wr[lane]); o1 += (double)av * (double)bfr(wr[lane + 64]); }
        chk_cmp(F, 2, bf2f(got[lane]), (float)o0, 2e-2f, 1e-2f); chk_cmp(F, 2, bf2f(got[lane + 64]), (float)o1, 2e-2f, 1e-2f);
    }
}
__device__ void check_attn(Frame& F) {
    unsigned char* ws = F.ws; LAS float* L = (LAS float*)(F.lds + RING_OFF);
    for (int it = blockIdx.x; it < 32; it += F.G) { const int b = it >> 4, ti = it & 15, g = (ti + b) & 3, bg = b * 4 + g;
        const int t = ti == 0 ? 0 : ti == 1 ? 5 : ti == 2 ? 30 : ti == 3 ? 31 : ti == 4 ? 63 : ti == 5 ? 64 : ti == 6 ? 100 : ti == 7 ? 511 : ti == 8 ? 512 : ti == 9 ? 1000 : ti == 10 ? 1023 : ti == 11 ? 1024 : ti == 12 ? 2047 : ti == 13 ? 2048 : ti == 14 ? 3000 : 4095;
        VAttnCtx C{}; C.smp = 0; C.b = b; C.g = g; C.t = t; C.pos = t; C.KC = (const bf16*)(ws + WS_KCP) + (size_t)(0 * 8 + bg) * 256 * 128; C.VC = (const bf16*)(ws + WS_KCP) + (size_t)(1 * 8 + bg) * 256 * 128;
        C.n_cmp = 255; C.n_blk = 64; const bf16* kv = (const bf16*)(ws + WS_KV);
        C.Ks = kv + (size_t)(((0 * 2 + 0) * 2 + b) * 4 + g) * SEQ * 128; C.Vs = kv + (size_t)(((0 * 2 + 1) * 2 + b) * 4 + g) * SEQ * 128;
        C.Kw = kv + (size_t)(((1 * 2 + 0) * 2 + b) * 4 + g) * SEQ * 128; C.Vw = kv + (size_t)(((1 * 2 + 1) * 2 + b) * 4 + g) * SEQ * 128;
        const bf16* qb = (const bf16*)(ws + WS_Q); const bf16* ao = (const bf16*)(ws + WS_AO) + (size_t)(b * SEQ + t) * DM + 4 * g * 128;
        vattn_unit(C, L, [=](int r, int d) { return bf2f(qb[((size_t)(b * 16 + 4 * g + r) * SEQ + t) * 128 + d]); }, (const float*)(ws + WS_GATES) + (size_t)(b * SEQ + t) * 48,
                   [&](int r, int d, float v) { chk_cmp(F, 3, bf2f(ao[r * 128 + d]), v, 2e-2f, 2e-3f); chk_cmp(F, 4, bf2f(ao[r * 128 + d]), v, 1e-1f, 2e-2f); }); }
}
__device__ void diag_emit(Frame& F) {
    const unsigned n0 = F.ctl[CW_CHK + 3], n1 = F.ctl[CW_CHK + 4], n2 = F.ctl[CW_CHK + 11], n3 = F.ctl[CW_CHK + 0] + F.ctl[CW_CHK + 1] + F.ctl[CW_CHK + 2];
    for (size_t i = (size_t)F.gw * 64 + F.lane; i < O_CMPP; i += (size_t)F.NGW * 64) { const bool skip = (i < O_YS) ? (i < n0) : ((i - O_YS) < n1); if (!skip) F.out[i] = 0.f; }
    for (size_t i = (size_t)F.gw * 64 + F.lane; i < (O_END - O_RETP); i += (size_t)F.NGW * 64) { const size_t j = i + O_RETP; const bool skip = (j < O_RETS) ? (i < n2) : ((j - O_RETS) < n3); if (!skip) F.out[j] = 0.f; }
}
#endif
#if MK_CHECK
constexpr int NPH = 18;
#else
constexpr int NPH = 16;
#endif
constexpr size_t SM_XS2 = WS_SMP, SM_RSQ = WS_SMP + 1 * MiB, SM_RSK = SM_RSQ + 256 * 1024, SM_RSV = SM_RSK + 256 * 1024, SM_RSG = SM_RSV + 512 * 1024, SM_ROS = SM_RSG + 512 * 1024, SM_HS = SM_ROS + 512 * 1024;
__global__ void __launch_bounds__(NTHR, 2) mk_fwd(Args args) {
    extern __shared__ __attribute__((aligned(16))) unsigned char lds[];
    Frame F;
    F.lds = (LAS unsigned char*)lds;
    F.MISC = (volatile LAS unsigned*)(F.lds + MISC_OFF);
    F.tid = threadIdx.x; F.lane = F.tid & 63; F.wave = __builtin_amdgcn_readfirstlane(F.tid >> 6);
    F.G = gridDim.x; F.gw = blockIdx.x * NWAVES + F.wave; F.NGW = F.G * NWAVES;
    F.ws = args.ws; F.out = args.out; F.ctl = (gu32*)(args.ws + WS_CTL);
    unsigned char* ws = args.ws;
    for (int u = F.tid; u < (LDS_BYTES - LDSCTL_OFF) / 4; u += NTHR) ((LAS unsigned*)(F.lds + LDSCTL_OFF))[u] = 0u;
    __syncthreads();
#if MK_ONE_LAUNCH
    XcdBarrier bar = xcd_barrier_post((unsigned*)(F.ctl + CW_BAR), F.MISC + 8);
#define GRID_BAR() xcd_barrier(bar)
#else
#define GRID_BAR() do {} while (0)
#endif
    const int lo = args.ph_lo, hi = args.ph_hi;
#define IN(k) (lo <= (k) && (k) < hi)
#define BOTH(k) (IN(k) && IN((k) + 1))
#define GEMM_LDS ((PG8_LAS unsigned char*)(F.lds + RING_OFF))
#define BF(off) ((bf16*)(ws + (off)))
#define PBF(off) ((const pg8::bf16_t*)(ws + (off)))
    const float* ropeN = (const float*)(ws + WS_ROPEN); const float* ropeR = (const float*)(ws + WS_ROPER);
    float* ssq0 = (float*)(F.ctl + CW_SSQ); float* ssq1 = ssq0 + SSQ_STRIDE; float* ssq2 = ssq1 + SSQ_STRIDE; float* ssq3 = ssq2 + SSQ_STRIDE;
    float* H = (float*)(ws + WS_H1); float* HS = (float*)(ws + SM_HS);
    const float* norm_mix = args.in[7]; const float* norm_ffn = args.in[8];

    if (IN(0)) {
        P0Args A{args.in[0], args.in[1], args.in[2], args.in[4], args.in[7], args.in[10], args.in[11], args.in[12], args.in[13], args.in[15], args.in[16], args.in[18], args.in[19], args.in[20], (const int*)args.in[6]};
        p0_prologue(F, A);
        if (BOTH(0)) GRID_BAR();
    }
    if (IN(1)) {
        pg8::Gemm g{PBF(WS_XN), PBF(WS_WIN_T), MP, NSA_NP, DM}; pg8::StaticOrder S; S.init(MP, NSA_NP, F.G, (int)blockIdx.x);
        EpiNsaIn E{BF(WS_Q), BF(WS_KV), BF(WS_KVC), (float*)(ws + WS_GATES), F.out, ropeN};
        pg8::gemm_phase<EpiNsaIn, pg8::StaticOrder, true, true>(GEMM_LDS, g, S, E);
        p1_sample(F, BF(WS_XS), BF(WS_WIN_T), ropeN, (float*)(ws + WS_QS), (float*)(ws + WS_GATES) + (size_t)MP * 48);
        if (BOTH(1)) GRID_BAR();
    }
    if (IN(2)) {
        if (blockIdx.x == 0 && F.tid < 256) { const int e = F.tid >> 7, h = F.tid & 127; float a = args.in[14][F.tid]; const float* pp = (const float*)(ws + WS_POSP) + (size_t)e * 64 * 128 + h;
            for (int sl = 0; sl < 64; ++sl) a += pp[sl * 128]; ((float*)(ws + WS_POSB))[F.tid] = a; }
        pg8::Gemm g{PBF(WS_KVC), PBF(WS_CW1_T), 272 * 256, 512, 2048}; CmpOrder S{F.G, (int)blockIdx.x};
        EpiPer E{(float*)(ws + WS_PER)};
        pg8::gemm_phase<EpiPer, CmpOrder, true, true>(GEMM_LDS, g, S, E);
        p2_prompt_per(F);
        if (BOTH(2)) GRID_BAR();
    }
    if (IN(3)) { p3_finish(F); if (BOTH(3)) GRID_BAR(); }
    if (IN(4)) { p4_attention(F); p4_sample_attention(F, args.in[3], args.in[4], (const int*)args.in[6]); if (BOTH(4)) GRID_BAR(); }
    if (IN(5)) {
        pg8::Gemm g{PBF(WS_AO), PBF(WS_WO_T), MP, DM, DM}; pg8::StaticOrder S; S.init(MP, DM, F.G, (int)blockIdx.x);
        EpiResid E{args.in[0], H, BF(WS_XN), norm_ffn, ssq0};
        pg8::gemm_phase<EpiResid, pg8::StaticOrder, true, true>(GEMM_LDS, g, S, E);
        skinny_resid(F, BF(WS_AOS), BF(WS_WO_T), DM, args.in[1], HS, BF(WS_XS), norm_ffn, ssq0 + MP);
        if (BOTH(5)) GRID_BAR();
    }
    if (IN(6)) {
        pg8::Gemm g{PBF(WS_XN), PBF(WS_W1_T), MP, DFF, DM}; pg8::StaticOrder S; S.init(MP, DFF, F.G, (int)blockIdx.x);
        EpiFfn1 E{BF(WS_HFF), ssq0};
        pg8::gemm_phase<EpiFfn1, pg8::StaticOrder, true, true>(GEMM_LDS, g, S, E);
        skinny_ffn1(F, BF(WS_XS), BF(WS_W1_T), BF(WS_HFFS), ssq0 + MP);
        if (BOTH(6)) GRID_BAR();
    }
    if (IN(7)) {
        pg8::Gemm g{PBF(WS_HFF), PBF(WS_W2_T), MP, DM, DFF}; pg8::StaticOrder S; S.init(MP, DM, F.G, (int)blockIdx.x);
        EpiResid E{H, H, BF(WS_XN), norm_mix + DM, ssq1};
        pg8::gemm_phase<EpiResid, pg8::StaticOrder, true, true>(GEMM_LDS, g, S, E);
        skinny_resid(F, BF(WS_HFFS), BF(WS_W2_T), DFF, HS, HS, BF(WS_XS), norm_mix + DM, ssq1 + MP);
        if (BOTH(7)) GRID_BAR();
    }
    if (IN(8)) {
        pg8::Gemm g{PBF(WS_XN), PBF(WS_RIN_T), MP, RET_N, DM}; pg8::StaticOrder S; S.init(MP, RET_N, F.G, (int)blockIdx.x);
        EpiRetIn E{BF(WS_RQ), BF(WS_RK), BF(WS_RV), BF(WS_RG), ropeR, ssq1};
        pg8::gemm_phase<EpiRetIn, pg8::StaticOrder, true, true>(GEMM_LDS, g, S, E);
        skinny_retin(F, BF(WS_XS), BF(WS_RIN_T), ropeR, ssq1 + MP, (float*)(ws + SM_RSQ), (float*)(ws + SM_RSK), (float*)(ws + SM_RSV), (float*)(ws + SM_RSG));
        if (BOTH(8)) GRID_BAR();
    }
    if (IN(9)) { p_ret_s(F); p_ret_sample(F, args.in[5], (const float*)(ws + SM_RSQ), (const float*)(ws + SM_RSK), (const float*)(ws + SM_RSV), (float*)(ws + SM_ROS)); if (BOTH(9)) GRID_BAR(); }
    if (IN(10)) { p_ret_scan(F); if (BOTH(10)) GRID_BAR(); }
    if (IN(11)) { p_ret_gn(F, args.in[17], (const float*)(ws + SM_ROS), (const float*)(ws + SM_RSG)); if (BOTH(11)) GRID_BAR(); }
    if (IN(12)) {
        pg8::Gemm g{PBF(WS_RGA), PBF(WS_RO_T), MP, DM, 4096}; pg8::StaticOrder S; S.init(MP, DM, F.G, (int)blockIdx.x);
        EpiResid E{H, H, BF(WS_XN), norm_ffn + DM, ssq2};
        pg8::gemm_phase<EpiResid, pg8::StaticOrder, true, true>(GEMM_LDS, g, S, E);
        skinny_resid(F, BF(WS_XS), BF(WS_RO_T), 4096, HS, HS, BF(SM_XS2), norm_ffn + DM, ssq2 + MP);
        if (BOTH(12)) GRID_BAR();
    }
    if (IN(13)) {
        pg8::Gemm g{PBF(WS_XN), PBF(WS_W1_T + (size_t)DM * DFF * 2), MP, DFF, DM}; pg8::StaticOrder S; S.init(MP, DFF, F.G, (int)blockIdx.x);
        EpiFfn1 E{BF(WS_HFF), ssq2};
        pg8::gemm_phase<EpiFfn1, pg8::StaticOrder, true, true>(GEMM_LDS, g, S, E);
        skinny_ffn1(F, BF(SM_XS2), BF(WS_W1_T + (size_t)DM * DFF * 2), BF(WS_HFFS), ssq2 + MP);
        if (BOTH(13)) GRID_BAR();
    }
    if (IN(14)) {
        pg8::Gemm g{PBF(WS_HFF), PBF(WS_W2_T + (size_t)DM * DFF * 2), MP, DM, DFF}; pg8::StaticOrder S; S.init(MP, DM, F.G, (int)blockIdx.x);
        EpiResid E{H, H, BF(WS_XN), args.in[9], ssq3};
        pg8::gemm_phase<EpiResid, pg8::StaticOrder, true, true>(GEMM_LDS, g, S, E);
        skinny_resid(F, BF(WS_HFFS), BF(WS_W2_T + (size_t)DM * DFF * 2), DFF, HS, HS, BF(WS_XS), args.in[9], ssq3 + MP);
        if (BOTH(14)) GRID_BAR();
    }
    if (IN(15)) { p_final_norm(F, H, HS, args.in[9]); if (BOTH(15)) GRID_BAR(); }
#if MK_CHECK
    if (IN(16)) { check_p1(F, args.in[0], args.in[1], args.in[7], args.in[10]); check_cmp(F, args.in[2], (const int*)args.in[6], args.in[12], args.in[13], args.in[14], args.in[15]); check_attn(F); if (BOTH(16)) GRID_BAR(); }
    if (IN(17)) { diag_emit(F); }
#endif
#undef IN
#undef BOTH
}

extern "C" void kernel_launch(void* const* d_in, const int* in_sizes, int n_in, void* d_out, int out_size, void* d_ws, size_t ws_size, hipStream_t stream) {
    static int grid = 0;
    if (grid == 0) {
        if (n_in != 21 || (size_t)out_size != O_END || ws_size < WS_END) { fprintf(stderr, "kernel_launch: unexpected shapes: n_in %d out %d ws %zu\n", n_in, out_size, ws_size); grid = -1; return; }
        int dev = 0, cus = 0, per_cu = 0;
        if (hipGetDevice(&dev) != hipSuccess || hipDeviceGetAttribute(&cus, hipDeviceAttributeMultiprocessorCount, dev) != hipSuccess) { grid = -1; return; }
        if (hipFuncSetAttribute((const void*)mk_fwd, hipFuncAttributeMaxDynamicSharedMemorySize, LDS_BYTES) != hipSuccess) { fprintf(stderr, "kernel_launch: hipFuncSetAttribute failed\n"); grid = -1; return; }
        if (hipOccupancyMaxActiveBlocksPerMultiprocessor(&per_cu, (const void*)mk_fwd, NTHR, LDS_BYTES) != hipSuccess || per_cu < 1) { fprintf(stderr, "kernel_launch: occupancy query says %d\n", per_cu); }
        (void)hipGetLastError();
        grid = cus;
    }
    if (grid < 0) return;
    if (hipMemsetAsync((char*)d_ws + WS_CTL, 0, CTL_ZERO_BYTES, stream) != hipSuccess) return;
    Args a{};
    for (int i = 0; i < 21; ++i) a.in[i] = (const float*)d_in[i];
    a.out = (float*)d_out; a.ws = (unsigned char*)d_ws;
#if MK_ONE_LAUNCH
    a.ph_lo = 0; a.ph_hi = NPH;
    hipLaunchKernelGGL(mk_fwd, dim3(grid), dim3(NTHR), LDS_BYTES, stream, a);
#else
    for (int p = 0; p < NPH; ++p) { a.ph_lo = p; a.ph_hi = p + 1; hipLaunchKernelGGL(mk_fwd, dim3(grid), dim3(NTHR), LDS_BYTES, stream, a); }
#endif
}
```

```cpp
#include <hip/hip_runtime.h>
#include <cstdio>
#include <cstdint>
#include <cmath>
#define MK_CHECK 0
#ifndef MK_PROBE
#define MK_PROBE -1
#endif
#ifndef MK_DBL
#define MK_DBL 0
#endif
namespace pg8 {
#define PG8_LAS __attribute__((address_space(3)))
typedef unsigned short bf16_t;
typedef short bf16x8 __attribute__((ext_vector_type(8)));
typedef float f32x4 __attribute__((ext_vector_type(4)));
typedef unsigned u32x4 __attribute__((ext_vector_type(4)));
constexpr int BM = 256, BK = 64, HALF = 128, HTB = HALF * BK * 2  , STAGE_BYTES = 8 * HTB, NXCD = 8, WGM = 8;

__host__ __device__ __forceinline__ int lds_byte(int r, int c) { const int st = (r >> 4) * 2 + (c >> 5), rr = r & 15, cc = c & 31, ob = rr * 64 + cc * 2; return st * 1024 + (ob ^ (((ob >> 9) & 1) << 5)); }
__host__ __device__ __forceinline__ void stage_rc(int b, int& R, int& C) { const int st = b / 1024, sb = b % 1024, swz = sb ^ (((sb >> 9) & 1) << 5); R = (st >> 1) * 16 + swz / 64; C = (st & 1) * 32 + (swz % 64) / 2; }
__host__ __device__ __forceinline__ int perm32(int rho) { const int n = rho >> 4, i = rho & 15; return 8 * (i >> 2) + 4 * n + (i & 3); }

struct Unit { int pm, pn; };
struct Gemm { const bf16_t* A; const bf16_t* Bt; int M, N, K; int lda = 0; };

struct StaticOrder {
    int nM, nN, nwg, G, c;
    __host__ __device__ void init(int M, int N, int G_, int c_) { nM = M / BM; nN = N / BM; nwg = nM * nN; G = G_; c = c_; }
    __host__ __device__ bool next(int i, Unit& u) const {
        const long L = (long)i * G + c; if (L >= nwg) return false;
        int wgid = (int)L; { const int q = nwg / NXCD, r = nwg % NXCD, xcd = wgid % NXCD, off = wgid / NXCD; wgid = (xcd < r ? xcd * (q + 1) : r * (q + 1) + (xcd - r) * q) + off; }
        const int nig = WGM * nN, gid = wgid / nig, fm = gid * WGM, gsz = (nM - fm) < WGM ? (nM - fm) : WGM;
        u.pm = fm + ((wgid % nig) % gsz); u.pn = (wgid % nig) / gsz; return true;
    }
    __device__ __forceinline__ void a_ready(const Unit&) const {}
    __device__ __forceinline__ void done(const Unit&) const {}
};

__device__ __forceinline__ unsigned cvt_pk_bf16(float lo, float hi) { unsigned r; asm volatile("v_cvt_pk_bf16_f32 %0, %1, %2" : "=v"(r) : "v"(lo), "v"(hi)); return r; }
typedef float f32x2 __attribute__((ext_vector_type(2)));
__device__ __forceinline__ f32x2 gelu_pk(f32x2 v) {
    const f32x2 av = __builtin_elementwise_abs(v), d = av * 0.2316418882f + 1.0f;
    f32x2 t; t.x = __builtin_amdgcn_rcpf(d.x); t.y = __builtin_amdgcn_rcpf(d.y);
    f32x2 q = t * 0.5307027145f + (-0.7265760135f); q = q * t + 0.7107068705f; q = q * t + (-0.142248368f); q = q * t + 0.127414796f; q = q * t;
    const f32x2 s = (v * v) * (-0.72134752044f);
    f32x2 e; e.x = __builtin_amdgcn_exp2f(s.x); e.y = __builtin_amdgcn_exp2f(s.y);
    const f32x2 m = v * (q * e), r = v - m;
    f32x2 o; o.x = v.x < 0.f ? m.x : r.x; o.y = v.y < 0.f ? m.y : r.y; return o;
}

template <int ACT  > struct EpiBf16 {
    static constexpr bool PERM = true, AFTER_DRAIN = false; static_assert(ACT == 0 || ACT == 1, "EpiBf16: ACT is 0 (none) or 1 (gelu_pk)");
    bf16_t* O; int ldc; const float* bias; int split_cols; size_t split_stride; float scale0;
    __device__ __forceinline__ void operator()(const f32x4 (&acc)[2][2][4][2], const Unit& u, int wr, int wc, int fr, int fq) const {
        const int row0 = u.pm * BM + wr * 64 + fr; int colt = u.pn * BM; bf16_t* base = O;
        float sc = 1.f; if (split_cols) { const int t = colt / split_cols; base += (size_t)t * split_stride; colt -= t * split_cols; if (t == 0) sc = scale0; }
        const int col0 = colt + wc * 32 + 8 * fq, bcol0 = u.pn * BM + wc * 32 + 8 * fq;
        f32x4 bv[2][2];
#pragma unroll
        for (int bj = 0; bj < 2; ++bj)
#pragma unroll
            for (int n = 0; n < 2; ++n) bv[bj][n] = bias ? *(const f32x4*)(bias + bcol0 + bj * HALF + 4 * n) : (f32x4){0.f, 0.f, 0.f, 0.f};
#pragma unroll
        for (int ai = 0; ai < 2; ++ai)
#pragma unroll
            for (int m = 0; m < 4; ++m) { bf16_t* rowp = base + (size_t)(row0 + ai * HALF + m * 16) * ldc + col0;
#pragma unroll
                for (int bj = 0; bj < 2; ++bj) { f32x4 v0 = acc[ai][bj][m][0] + bv[bj][0], v1 = acc[ai][bj][m][1] + bv[bj][1];
                    if (ACT == 1) { f32x2 a = gelu_pk((f32x2){v0[0], v0[1]}), b = gelu_pk((f32x2){v0[2], v0[3]}), c = gelu_pk((f32x2){v1[0], v1[1]}), d = gelu_pk((f32x2){v1[2], v1[3]});
                        v0 = (f32x4){a.x, a.y, b.x, b.y}; v1 = (f32x4){c.x, c.y, d.x, d.y}; }
                    v0 = v0 * sc; v1 = v1 * sc; u32x4 w; w.x = cvt_pk_bf16(v0[0], v0[1]); w.y = cvt_pk_bf16(v0[2], v0[3]); w.z = cvt_pk_bf16(v1[0], v1[1]); w.w = cvt_pk_bf16(v1[2], v1[3]);
                    *(u32x4*)(rowp + bj * HALF) = w; } }
    }
};
template <class Epi, class Sched, bool ALIGN_EPI = false, bool SP2 = false>
__device__ __forceinline__ void gemm_phase(PG8_LAS unsigned char* lds, const Gemm g, const Sched& S, const Epi& E) {
    const int tid = threadIdx.x, wid = __builtin_amdgcn_readfirstlane(tid >> 6), lane = tid & 63, wr = wid >> 2, wc = wid & 3, fr = lane & 15, fq = lane >> 4;
    const int K = g.K, nt = K / BK, LA = g.lda ? g.lda : K;
    unsigned voffA[2], voffB[2];
#pragma unroll
    for (int i = 0; i < 2; ++i) { int R, C; stage_rc(tid * 16 + i * 8192, R, C); const int Rb = Epi::PERM ? ((R & ~31) + perm32(R & 31)) : R;
        voffA[i] = (unsigned)(R * LA + C) * 2u; voffB[i] = (unsigned)(Rb * K + C) * 2u; }
    const size_t kstep = (size_t)(BK * 2);
    const size_t hstepB = (size_t)HALF * K * 2, hstepA = (size_t)HALF * LA * 2;
    const size_t tstepB = 2 * hstepB, tstepA = 2 * hstepA;
    const unsigned ldsw = (unsigned)wid * 1024u;
    const int aoff = lds_byte(wr * 64 + fr, fq * 8), boff = lds_byte(wc * 32 + fr, fq * 8);
#define PG8_SA(b, h) (((b) * 2 + (h)) * HTB)
#define PG8_SB(b, h) ((4 + (b) * 2 + (h)) * HTB)
#define PG8_STAGE(bufoff, gbase, voff) do { _Pragma("unroll") for (int _i = 0; _i < 2; ++_i) \
        __builtin_amdgcn_global_load_lds((const unsigned*)((const char*)(gbase) + (voff)[_i]), (PG8_LAS unsigned*)(lds + (bufoff) + ldsw + _i * 8192), 16, 0, 0); } while (0)
#define PG8_LDA(dst, b, h) do { _Pragma("unroll") for (int m = 0; m < 4; ++m) _Pragma("unroll") for (int k = 0; k < 2; ++k) dst[m][k] = *(const PG8_LAS bf16x8*)(lds + PG8_SA(b, h) + aoff + m * 2048 + k * 1024); } while (0)
#define PG8_LDB(dst, b, h) do { _Pragma("unroll") for (int n = 0; n < 2; ++n) _Pragma("unroll") for (int k = 0; k < 2; ++k) dst[n][k] = *(const PG8_LAS bf16x8*)(lds + PG8_SB(b, h) + boff + n * 2048 + k * 1024); } while (0)
#define PG8_MMA(ai, bj, At, Bt) do { __builtin_amdgcn_s_setprio(1); _Pragma("unroll") for (int m = 0; m < 4; ++m) _Pragma("unroll") for (int n = 0; n < 2; ++n) _Pragma("unroll") for (int k = 0; k < 2; ++k) \
        acc[ai][bj][m][n] = __builtin_amdgcn_mfma_f32_16x16x32_bf16(Bt[n][k], At[m][k], acc[ai][bj][m][n], 0, 0, 0); __builtin_amdgcn_s_setprio(0); } while (0)
#define PG8_WAIT_V(n) asm volatile("s_waitcnt vmcnt(" #n ")" ::: "memory")
#define PG8_WAIT_L(n) asm volatile("s_waitcnt lgkmcnt(" #n ")" ::: "memory")
#define PG8_BAR __builtin_amdgcn_s_barrier()
#define PG8_SCHED __builtin_amdgcn_sched_barrier(0)
    Unit cur, nxt; int ui = 0;
    if (!S.next(0, cur)) return;
    f32x4 acc[2][2][4][2];
#pragma unroll
    for (int a = 0; a < 2; ++a)
#pragma unroll
        for (int b = 0; b < 2; ++b)
#pragma unroll
            for (int m = 0; m < 4; ++m)
#pragma unroll
                for (int n = 0; n < 2; ++n) acc[a][b][m][n] = (f32x4){0.f, 0.f, 0.f, 0.f};
    bf16x8 At[4][2], B0[2][2], B1[2][2];
    const char* cA = (const char*)g.A + (size_t)cur.pm * tstepA; const char* cB = (const char*)g.Bt + (size_t)cur.pn * tstepB;
    S.a_ready(cur);
    if constexpr (SP2) {
        PG8_STAGE(PG8_SB(0, 0), cB, voffB); PG8_STAGE(PG8_SB(0, 1), cB + hstepB, voffB); PG8_STAGE(PG8_SA(0, 0), cA, voffA); PG8_STAGE(PG8_SA(0, 1), cA + hstepA, voffA);
        if (wr == 1) PG8_BAR;
        PG8_WAIT_V(2); PG8_BAR;
        PG8_STAGE(PG8_SB(1, 0), cB + kstep, voffB); PG8_STAGE(PG8_SA(1, 0), cA + kstep, voffA); PG8_STAGE(PG8_SB(1, 1), cB + hstepB + kstep, voffB);
        PG8_WAIT_V(6); PG8_BAR;
    } else {
        PG8_STAGE(PG8_SB(0, 0), cB, voffB); PG8_STAGE(PG8_SA(0, 0), cA, voffA); PG8_STAGE(PG8_SB(0, 1), cB + hstepB, voffB); PG8_STAGE(PG8_SA(0, 1), cA + hstepA, voffA);
        if (wr == 1) PG8_BAR;
        PG8_WAIT_V(4); PG8_BAR;
        PG8_STAGE(PG8_SB(1, 0), cB + kstep, voffB); PG8_STAGE(PG8_SA(1, 0), cA + kstep, voffA); PG8_STAGE(PG8_SB(1, 1), cB + hstepB + kstep, voffB);
        PG8_WAIT_V(6); PG8_BAR;
    }
    for (;;) {
        const bool has_next = S.next(ui + 1, nxt);
        const char* nA = has_next ? (const char*)g.A + (size_t)nxt.pm * tstepA : cA; const char* nB = has_next ? (const char*)g.Bt + (size_t)nxt.pn * tstepB : cB;
        for (int t = 0; t < nt; t += 2) {
            const bool last = (t == nt - 2);
            const char* a1 = cA + (size_t)(t + 1) * kstep;
            const char* a2 = last ? nA : cA + (size_t)(t + 2) * kstep; const char* b2 = last ? nB : cB + (size_t)(t + 2) * kstep;
            const char* a3 = a2 + kstep; const char* b3 = b2 + kstep;
            if (last && has_next) S.a_ready(nxt);
            if constexpr (SP2) {
            PG8_LDB(B0, 0, 0); PG8_LDB(B1, 0, 1); PG8_SCHED; PG8_LDA(At, 0, 0); PG8_STAGE(PG8_SA(1, 1), a1 + hstepA, voffA);
            PG8_WAIT_V(8); PG8_WAIT_L(0); PG8_BAR; PG8_MMA(0, 0, At, B0); PG8_MMA(0, 1, At, B1); PG8_BAR; PG8_SCHED;
            PG8_LDA(At, 0, 1); PG8_STAGE(PG8_SB(0, 0), b2, voffB); PG8_STAGE(PG8_SB(0, 1), b2 + hstepB, voffB); PG8_STAGE(PG8_SA(0, 0), a2, voffA);
            PG8_WAIT_V(8); PG8_WAIT_L(0); PG8_BAR; PG8_MMA(1, 0, At, B0); PG8_MMA(1, 1, At, B1); PG8_BAR; PG8_SCHED;
            PG8_LDB(B0, 1, 0); PG8_LDB(B1, 1, 1); PG8_SCHED; PG8_LDA(At, 1, 0); PG8_STAGE(PG8_SA(0, 1), a2 + hstepA, voffA);
            PG8_WAIT_V(8); PG8_WAIT_L(0); PG8_BAR; PG8_MMA(0, 0, At, B0); PG8_MMA(0, 1, At, B1); PG8_BAR; PG8_SCHED;
            PG8_LDA(At, 1, 1); PG8_STAGE(PG8_SB(1, 0), b3, voffB); PG8_STAGE(PG8_SB(1, 1), b3 + hstepB, voffB); PG8_STAGE(PG8_SA(1, 0), a3, voffA);
            PG8_WAIT_V(8); PG8_WAIT_L(0); PG8_BAR; PG8_MMA(1, 0, At, B0); PG8_MMA(1, 1, At, B1); PG8_BAR; PG8_SCHED;
            } else {
            PG8_LDB(B0, 0, 0); PG8_SCHED; PG8_LDA(At, 0, 0); PG8_STAGE(PG8_SA(1, 1), a1 + hstepA, voffA);
            PG8_WAIT_L(8); PG8_BAR; PG8_WAIT_L(0); PG8_MMA(0, 0, At, B0); PG8_BAR; PG8_SCHED;
            PG8_LDB(B1, 0, 1); PG8_STAGE(PG8_SB(0, 0), b2, voffB);
            PG8_BAR; PG8_WAIT_L(0); PG8_MMA(0, 1, At, B1); PG8_BAR;
            PG8_LDA(At, 0, 1); PG8_STAGE(PG8_SA(0, 0), a2, voffA);
            PG8_BAR; PG8_WAIT_L(0); PG8_MMA(1, 0, At, B0); PG8_BAR; PG8_SCHED;
            PG8_STAGE(PG8_SB(0, 1), b2 + hstepB, voffB);
            PG8_WAIT_V(6); PG8_BAR; PG8_MMA(1, 1, At, B1); PG8_BAR;
            PG8_LDB(B0, 1, 0); PG8_SCHED; PG8_LDA(At, 1, 0); PG8_STAGE(PG8_SA(0, 1), a2 + hstepA, voffA);
            PG8_WAIT_L(8); PG8_BAR; PG8_WAIT_L(0); PG8_MMA(0, 0, At, B0); PG8_BAR; PG8_SCHED;
            PG8_LDB(B1, 1, 1); PG8_STAGE(PG8_SB(1, 0), b3, voffB);
            PG8_BAR; PG8_WAIT_L(0); PG8_MMA(0, 1, At, B1); PG8_BAR;
            PG8_LDA(At, 1, 1); PG8_STAGE(PG8_SA(1, 0), a3, voffA);
            PG8_BAR; PG8_WAIT_L(0); PG8_MMA(1, 0, At, B0); PG8_BAR; PG8_SCHED;
            PG8_STAGE(PG8_SB(1, 1), b3 + hstepB, voffB);
            PG8_WAIT_V(6); PG8_BAR; PG8_MMA(1, 1, At, B1); PG8_BAR;
            }
        }
        if constexpr (ALIGN_EPI) { if (wr == 0) PG8_BAR; }
        if constexpr (!Epi::AFTER_DRAIN) { E(acc, cur, wr, wc, fr, fq); S.done(cur); }
        if (!has_next) break;
#pragma unroll
        for (int a = 0; a < 2; ++a)
#pragma unroll
            for (int b = 0; b < 2; ++b)
#pragma unroll
                for (int m = 0; m < 4; ++m)
#pragma unroll
                    for (int n = 0; n < 2; ++n) acc[a][b][m][n] = (f32x4){0.f, 0.f, 0.f, 0.f};
        cur = nxt; cA = nA; cB = nB; ++ui;
        if constexpr (ALIGN_EPI) { if (wr == 1) PG8_BAR; }
    }
    PG8_WAIT_V(0);
    if constexpr (!ALIGN_EPI) { if (wr == 0) PG8_BAR; }
    PG8_BAR;
    if constexpr (Epi::AFTER_DRAIN) { E.fused(acc, cur, wr, wc, fr, fq, lds, wid, lane); S.done(cur); }
#undef PG8_SA
#undef PG8_SB
#undef PG8_STAGE
#undef PG8_LDA
#undef PG8_LDB
#undef PG8_MMA
#undef PG8_WAIT_V
#undef PG8_WAIT_L
#undef PG8_BAR
#undef PG8_SCHED
}
}
#ifndef MK_ONE_LAUNCH
#define MK_ONE_LAUNCH 1
#endif
constexpr int NWAVES = 8, NTHR = 512;
constexpr int DM = 2048, SEQ = 4096, MP = 8192  , NS = 32  ;
constexpr int NSA_N = 5168, NSA_NP = 5376, DFF = 8192, RET_N = 12288;
constexpr int PAST = 16384;
constexpr int NPOSE = 4100;
constexpr size_t O_YP = 0, O_YS = 16777216, O_CMPP = O_YS + 65536, O_CMPS = O_CMPP + 8388608, O_SELP = O_CMPS + 32768, O_SELS = O_SELP + 8388608,
                 O_WINP = O_SELS + 32768, O_WINS = O_WINP + 1048576, O_RETP = O_WINS + 4194304, O_RETS = O_RETP + 2097152, O_END = O_RETS + 8388608;
constexpr size_t MiB = 1u << 20;
constexpr size_t WS_CTL = 0, CTL_ZERO_BYTES = 2 * MiB;
constexpr size_t WS_WIN_T = 2 * MiB, WS_WO_T = 24 * MiB, WS_RIN_T = 32 * MiB, WS_RO_T = 80 * MiB, WS_W1_T = 96 * MiB, WS_W2_T = 160 * MiB;
constexpr size_t WS_CW1_T = 224 * MiB, WS_CW2_T = 226 * MiB, WS_POSP = 226 * MiB + 65536, WS_POSB = WS_POSP + 65536;
constexpr size_t WS_ROPEN = 227 * MiB, WS_ROPER = 230 * MiB;
constexpr size_t WS_XN = 236 * MiB, WS_XS = 268 * MiB, WS_HFFS = 269 * MiB, WS_Q = 270 * MiB, WS_KV = 302 * MiB  , WS_GATES = 350 * MiB, WS_QS = 352 * MiB;
constexpr size_t WS_KCP = 357 * MiB, WS_KCS = 358 * MiB, WS_AO = 374 * MiB, WS_AOS = 406 * MiB;
constexpr size_t WS_H1 = 408 * MiB, WS_H2 = 474 * MiB, WS_HFF = 540 * MiB;
constexpr size_t WS_KVC = 670 * MiB  , WS_CC = 686 * MiB  ;
constexpr size_t WS_PER = 942 * MiB  , WS_PERS = WS_PER + 4 * MiB;
constexpr size_t WS_RQ = 1010 * MiB, WS_RK = 1042 * MiB, WS_RV = 1074 * MiB, WS_RG = 1138 * MiB, WS_RS = 1202 * MiB, WS_RO = 1218 * MiB, WS_RGA = 1282 * MiB;
constexpr size_t WS_RKT = 686 * MiB;
constexpr size_t WS_SMP = 1346 * MiB;
constexpr size_t WS_END = 1354 * MiB;
constexpr int CW_TMO = 0;
constexpr int CW_BAR = 4096;
constexpr int CW_SSQ = 65536;
constexpr int SSQ_STRIDE = 8448;
constexpr int RING_OFF = 0, RING_BYTES = 131072;
constexpr int LDSCTL_OFF = RING_BYTES, MISC_OFF = LDSCTL_OFF + 320;
constexpr int LDS_BYTES = 147456;

#define GAS __attribute__((address_space(1)))
#define LAS __attribute__((address_space(3)))
typedef unsigned short bf16;
typedef unsigned v4u __attribute__((ext_vector_type(4)));
typedef unsigned v2u __attribute__((ext_vector_type(2)));
typedef float f32x4 __attribute__((ext_vector_type(4)));
typedef float f32x2 __attribute__((ext_vector_type(2)));
typedef short bf16x8 __attribute__((ext_vector_type(8)));
typedef GAS unsigned gu32;
#define RLX_AGENT __ATOMIC_RELAXED, __HIP_MEMORY_SCOPE_AGENT
#define LDS_WAIT() asm volatile("s_waitcnt lgkmcnt(0)" ::: "memory")
#define VM_WAIT() asm volatile("s_waitcnt vmcnt(0)" ::: "memory")
typedef float pkf2_t __attribute__((ext_vector_type(2))); typedef __bf16 pkb2_t __attribute__((ext_vector_type(2)));
__device__ __forceinline__ unsigned pk2(float lo, float hi) { const pkf2_t v = {lo, hi}; const pkb2_t b = __builtin_convertvector(v, pkb2_t); return __builtin_bit_cast(unsigned, b); }
__device__ __forceinline__ unsigned f2bf(float f) { return pk2(f, f) & 0xffffu; }
__device__ __forceinline__ float bf2f(unsigned short h) { return __builtin_bit_cast(float, (unsigned)h << 16); }
__device__ __forceinline__ float wave_sum(float v) {
#pragma unroll
    for (int o = 1; o < 64; o <<= 1) v += __shfl_xor(v, o);
    return v;
}
__device__ __forceinline__ float wave_max(float v) {
#pragma unroll
    for (int o = 1; o < 64; o <<= 1) v = fmaxf(v, __shfl_xor(v, o));
    return v;
}

#define XB_TMO      128
#define XB_XCNT(j)  (256  + 64 * (j))
#define XB_XSUB(j)  (1280 + 64 * (j))
#define XB_XGEN(j)  (2304 + 64 * (j))
#define XB_TOP      3328
#define XB_TOPGEN   3392
#define XCD_BAR_WORDS 3456
#define XB_SPIN_CAP (1u << 18)

__device__ __forceinline__ unsigned xb_ld(unsigned* p)              { return __hip_atomic_load(p, __ATOMIC_RELAXED, __HIP_MEMORY_SCOPE_AGENT); }
__device__ __forceinline__ unsigned xb_add(unsigned* p, unsigned v) { return __hip_atomic_fetch_add(p, v, __ATOMIC_RELAXED, __HIP_MEMORY_SCOPE_AGENT); }
__device__ __forceinline__ unsigned xb_xcc_id() { return (unsigned)__builtin_amdgcn_s_getreg((3 << 11) | 20) & 0xFu; }
#define XB_SPIN(cond, bar) do { unsigned _sp = 0; while (cond) { __builtin_amdgcn_s_sleep(1); \
    if ((++_sp & 255u) == 0u) { if (xb_ld(&(bar)[XB_TMO])) break; if (_sp > XB_SPIN_CAP) { atomicAdd(&(bar)[XB_TMO], 1u); break; } } } } while (0)

struct XcdBarrier {
    unsigned* bar; unsigned x;
    volatile LAS unsigned* st;
};
__device__ __forceinline__ XcdBarrier xcd_barrier_post(unsigned* bar, volatile LAS unsigned* st) {
    XcdBarrier b; b.bar = bar; b.x = xb_xcc_id(); b.st = st;
    if (threadIdx.x == 0) (void)xb_add(&bar[XB_XCNT(b.x)], 1u);
    return b;
}
__device__ __forceinline__ void xcd_barrier_complete(unsigned* bar, unsigned x, unsigned& nloc, unsigned& nx) {
    const unsigned G = gridDim.x * gridDim.y * gridDim.z;
    unsigned sum, cnt, mine, sp = 0u;
    for (;;) {
        sum = 0u; cnt = 0u; mine = 0u;
#pragma unroll
        for (unsigned j = 0; j < 16; ++j) { const unsigned c = xb_ld(&bar[XB_XCNT(j)]); sum += c; cnt += (c > 0u) ? 1u : 0u; mine = (j == x) ? c : mine; }
        if (sum == G) break;
        __builtin_amdgcn_s_sleep(1);
        if ((++sp & 255u) == 0u) { if (xb_ld(&bar[XB_TMO])) break; if (sp > XB_SPIN_CAP) { atomicAdd(&bar[XB_TMO], 1u); break; } }
    }
    nloc = mine > 0u ? mine : 1u; nx = cnt > 0u ? cnt : 1u;
}
__device__ __forceinline__ void xcd_barrier(const XcdBarrier& b) {
    asm volatile("s_waitcnt vmcnt(0)" ::: "memory");
    __syncthreads();
    if (threadIdx.x == 0) {
        unsigned* bar = b.bar;
        __builtin_amdgcn_s_waitcnt(0);
        unsigned nloc = b.st[0], nx = b.st[1];
        if (nloc == 0u) { xcd_barrier_complete(bar, b.x, nloc, nx); b.st[0] = nloc; b.st[1] = nx; }
        const unsigned old = xb_add(&bar[XB_XSUB(b.x)], 1u);
        const unsigned gen = old / nloc;
        if (old + 1u == (gen + 1u) * nloc) {
            __builtin_amdgcn_fence(__ATOMIC_RELEASE, "agent");
            asm volatile("s_waitcnt vmcnt(0)" ::: "memory");
            const unsigned og = xb_add(&bar[XB_TOP], 1u);
            const unsigned tg = og / nx;
            if (og + 1u == (tg + 1u) * nx) xb_add(&bar[XB_TOPGEN], 1u);
            else XB_SPIN(xb_ld(&bar[XB_TOPGEN]) == tg, bar);
            __builtin_amdgcn_fence(__ATOMIC_ACQUIRE, "agent");
            xb_add(&bar[XB_XGEN(b.x)], 1u);
            asm volatile("s_waitcnt vmcnt(0)" ::: "memory");
        } else {
            XB_SPIN(xb_ld(&bar[XB_XGEN(b.x)]) == gen, bar);
            __builtin_amdgcn_fence(__ATOMIC_ACQUIRE, "agent");
            asm volatile("s_waitcnt vmcnt(0)" ::: "memory");
        }
    }
    __syncthreads();
}

struct Args { const float* in[21]; float* out; unsigned char* ws; int ph_lo, ph_hi; };
struct Frame {
    LAS unsigned char* lds;
    volatile LAS unsigned* MISC;
    gu32* ctl;
    int tid, lane, wave, G;
    int gw, NGW;
    unsigned char* ws; float* out;
};
__host__ __device__ __forceinline__ int head_col_of_d(int d) { return ((d & 63) >> 4) * 32 + (d >> 6) * 16 + (d & 15); }
__host__ __device__ __forceinline__ int inproj_dest(int n) { if (n >= 5120) return n; return (n & ~127) + head_col_of_d(n & 127); }

struct TItem { const float* W; const float* gk; bf16* WT; int N, k0, n0, kind, K; };
__device__ __forceinline__ void t_load(const TItem& I, int lane, f32x4 (&v)[8], f32x4 (&g)[2]) {
    const int nc = min(I.n0 + (lane & 7) * 4, I.N - 4);
#pragma unroll
    for (int i = 0; i < 8; ++i) { const int kk = 8 * i + (lane >> 3); v[i] = __builtin_nontemporal_load((const f32x4*)(I.W + (size_t)(I.k0 + kk) * I.N + nc)); }
    { const f32x4* gp = (const f32x4*)(I.gk ? I.gk + I.k0 + 8 * (lane & 7) : I.W); g[0] = gp[0]; g[1] = gp[1]; }
}
__device__ __forceinline__ void t_store(const TItem& I, int lane, LAS float* scr, const f32x4 (&v)[8], const f32x4 (&g)[2], bool valid, bf16* dump) {
    const int n4 = (lane & 7) * 4;
#pragma unroll
    for (int i = 0; i < 8; ++i) { const int kk = 8 * i + (lane >> 3); LAS float* d = scr + kk * 33 + n4; d[0] = v[i][0]; d[1] = v[i][1]; d[2] = v[i][2]; d[3] = v[i][3]; }
    LDS_WAIT(); asm volatile("" ::: "memory");
    const int c = lane & 7; const bool hg = I.gk != nullptr; const f32x4 one = (f32x4){1.f, 1.f, 1.f, 1.f}; const f32x4 g0 = hg ? g[0] : one, g1 = hg ? g[1] : one;
#pragma unroll
    for (int j = 0; j < 4; ++j) { const int nl = (lane >> 3) + 8 * j; const LAS float* s = scr + (8 * c) * 33 + nl;
        v4u o; o.x = pk2(s[0 * 33] * g0[0], s[1 * 33] * g0[1]); o.y = pk2(s[2 * 33] * g0[2], s[3 * 33] * g0[3]); o.z = pk2(s[4 * 33] * g1[0], s[5 * 33] * g1[1]); o.w = pk2(s[6 * 33] * g1[2], s[7 * 33] * g1[3]);
        const int n = I.n0 + nl;
        bf16* d = (I.kind == 0) ? I.WT + (size_t)n * I.K + I.k0 : (I.kind == 1) ? I.WT + (size_t)inproj_dest(n) * DM + I.k0 : I.WT + ((size_t)((I.k0 >> 11) * 128 + n)) * 2048 + (I.k0 & 2047);
        d = (valid && n < I.N) ? d + 8 * c : dump + lane * 8;
        *(GAS v4u*)d = o; }
    LDS_WAIT(); asm volatile("" ::: "memory");
}
__device__ __forceinline__ void rms_load(const float* xrow, int lane, f32x4 (&v)[8]) {
    const GAS f32x4* xr = (const GAS f32x4*)xrow + lane;
#pragma unroll
    for (int j = 0; j < 8; ++j) v[j] = __builtin_nontemporal_load(xr + 64 * j);
}
__device__ __forceinline__ void rms_finish(const f32x4 (&v)[8], const float* g, bf16* orow, int lane) {
    float s = 0.f;
#pragma unroll
    for (int j = 0; j < 8; ++j) s += (v[j].x * v[j].x + v[j].y * v[j].y) + (v[j].z * v[j].z + v[j].w * v[j].w);
    const float rstd = 1.0f / sqrtf(wave_sum(s) * (1.f / DM) + 1e-6f);
    const GAS f32x4* gr = (const GAS f32x4*)g + lane; GAS v2u* o8 = (GAS v2u*)orow + lane;
#pragma unroll
    for (int j = 0; j < 8; ++j) { const f32x4 gg = gr[64 * j]; v2u o; o.x = pk2(v[j].x * rstd * gg.x, v[j].y * rstd * gg.y); o.y = pk2(v[j].z * rstd * gg.z, v[j].w * rstd * gg.w); o8[64 * j] = o; }
}
__device__ __forceinline__ void cossin_acc(float ang, float& c, float& s) {
    const double x = (double)ang; const double n = __builtin_rint(x * 0.15915494309189535); const double r = x - n * 6.283185307179586476925;
    const double qd = __builtin_rint(r * 0.63661977236758134); const double y = r - qd * 1.5707963267948966192; const int q = ((int)qd) & 3;
    const double y2 = y * y;
    const double sp = y * (1.0 + y2 * (-1.6666666666666666e-1 + y2 * (8.3333333333333332e-3 + y2 * (-1.9841269841269841e-4 + y2 * (2.7557319223985893e-6 + y2 * (-2.5052108385441720e-8))))));
    const double cp = 1.0 + y2 * (-0.5 + y2 * (4.1666666666666664e-2 + y2 * (-1.3888888888888889e-3 + y2 * (2.4801587301587302e-5 + y2 * (-2.7557319223985888e-7 + y2 * 2.0876756987868099e-9)))));
    const double sv = (q == 0) ? sp : (q == 1) ? cp : (q == 2) ? -sp : -cp;
    const double cv = (q == 0) ? cp : (q == 1) ? -sp : (q == 2) ? -cp : sp;
    c = (float)cv; s = (float)sv;
}
struct P0Args { const float *norm_ffn; const float *x_prompt, *x_sample, *cache_cmp, *state_win, *norm_mix, *nsa_w_in, *nsa_w_out, *cmp_pos, *cmp_w1, *cmp_w2, *ret_w_in, *ret_w_out, *ffn_w1, *ffn_w2; const int* page_table; };
constexpr int I_IN = 32 * 162, I_WO = 32 * 64, I_RIN = 32 * 384, I_RO = 64 * 64, I_W1 = 32 * 256, I_W2 = 128 * 64, I_CW1 = 64 * 4, I_CW2 = 2 * 4;
constexpr int N_EARLY = I_IN + 2 * I_CW1 + 2 * I_CW2, N_LATE = I_WO + I_RIN + I_RO + 2 * I_W1 + 2 * I_W2, NITEMS = N_EARLY + N_LATE;
constexpr int CONV_CHUNK = 128, N_CONV_CHUNKS = N_LATE / CONV_CHUNK;
static_assert(N_LATE % CONV_CHUNK == 0, "late items split evenly");
__device__ __forceinline__ TItem p0_item(const P0Args& A, unsigned char* ws, int it) {
    int r = it;
    if (r < I_IN) { const int kb = r / 162, nb = r % 162; return TItem{A.nsa_w_in, nullptr, (bf16*)(ws + WS_WIN_T), NSA_N, 64 * kb, 32 * nb, 1, DM}; } r -= I_IN;
    if (r < 2 * I_CW1) { const int e = r / I_CW1; r %= I_CW1; const int kb = r / 4, nb = r % 4;
        return TItem{A.cmp_w1 + (size_t)e * 4096 * 128, nullptr, (bf16*)(ws + WS_CW1_T) + (size_t)e * 256 * 2048, 128, 64 * kb, 32 * nb, 2, 0}; } r -= 2 * I_CW1;
    if (r < 2 * I_CW2) { const int e = r / I_CW2; r %= I_CW2; const int kb = r / 4, nb = r % 4;
        return TItem{A.cmp_w2 + (size_t)e * 128 * 128, nullptr, (bf16*)(ws + WS_CW2_T) + (size_t)e * 128 * 128, 128, 64 * kb, 32 * nb, 0, 128}; } r -= 2 * I_CW2;
    if (r < I_WO) { const int kb = r / 64, nb = r % 64; return TItem{A.nsa_w_out, nullptr, (bf16*)(ws + WS_WO_T), DM, 64 * kb, 32 * nb, 0, DM}; } r -= I_WO;
    if (r < I_RIN) { const int kb = r / 384, nb = r % 384; return TItem{A.ret_w_in, A.norm_mix + DM, (bf16*)(ws + WS_RIN_T), RET_N, 64 * kb, 32 * nb, 0, DM}; } r -= I_RIN;
    if (r < I_RO) { const int kb = r / 64, nb = r % 64; return TItem{A.ret_w_out, nullptr, (bf16*)(ws + WS_RO_T), DM, 64 * kb, 32 * nb, 0, 4096}; } r -= I_RO;
    if (r < 2 * I_W1) { const int l = r / I_W1; r %= I_W1; const int kb = r / 256, nb = r % 256;
        return TItem{A.ffn_w1 + (size_t)l * DM * DFF, A.norm_ffn + l * DM, (bf16*)(ws + WS_W1_T) + (size_t)l * DM * DFF, DFF, 64 * kb, 32 * nb, 0, DM}; } r -= 2 * I_W1;
    { const int l = r / I_W2; r %= I_W2; const int kb = r / 64, nb = r % 64;
        return TItem{A.ffn_w2 + (size_t)l * DM * DFF, nullptr, (bf16*)(ws + WS_W2_T) + (size_t)l * DM * DFF, DM, 64 * kb, 32 * nb, 0, DFF}; }
}
template <int DEPTH>
__device__ __forceinline__ void convert_items(const P0Args& A, unsigned char* ws, LAS float* scr, int lane, bf16* dump, int i0, int last, int step) {
    f32x4 v[DEPTH][8], g[DEPTH][2]; TItem I[DEPTH]; int idx[DEPTH]; const int lc = last - 1;
#pragma unroll
    for (int s = 0; s < DEPTH; ++s) { idx[s] = i0 + s * step; I[s] = p0_item(A, ws, min(idx[s], lc)); t_load(I[s], lane, v[s], g[s]); }
    while (idx[0] < last) {
#pragma unroll
        for (int s = 0; s < DEPTH; ++s) {
            t_store(I[s], lane, scr, v[s], g[s], idx[s] < last, dump);
            idx[s] += DEPTH * step; I[s] = p0_item(A, ws, min(idx[s], lc)); t_load(I[s], lane, v[s], g[s]);
        }
    }
}
struct CMat { const float* W; const float* gk; bf16* WT; int N, K, NB; };
__device__ __forceinline__ void cm_load(const CMat& M, int k0, int n0, int lane, f32x4 (&v)[8], f32x4 (&g)[2]) {
    const float* p = M.W + (size_t)(k0 + (lane >> 3)) * M.N + n0 + (lane & 7) * 4; const size_t st = (size_t)8 * M.N;
#pragma unroll
    for (int i = 0; i < 8; ++i) v[i] = __builtin_nontemporal_load((const f32x4*)(p + i * st));
    const f32x4* gp = (const f32x4*)(M.gk ? M.gk + k0 + 8 * (lane & 7) : M.W); g[0] = gp[0]; g[1] = gp[1];
}
__device__ __forceinline__ void cm_store(const CMat& M, int k0, int n0, int lane, LAS float* scr, const f32x4 (&v)[8], const f32x4 (&g)[2]) {
    const int n4 = (lane & 7) * 4;
#pragma unroll
    for (int i = 0; i < 8; ++i) { const int kk = 8 * i + (lane >> 3); LAS float* d = scr + kk * 33 + n4; d[0] = v[i][0]; d[1] = v[i][1]; d[2] = v[i][2]; d[3] = v[i][3]; }
    LDS_WAIT(); asm volatile("" ::: "memory");
    const int c = lane & 7; const bool hg = M.gk != nullptr; const f32x4 one = (f32x4){1.f, 1.f, 1.f, 1.f}; const f32x4 g0 = hg ? g[0] : one, g1 = hg ? g[1] : one;
    bf16* d = M.WT + (size_t)(n0 + (lane >> 3)) * M.K + k0 + 8 * c; const size_t st = (size_t)8 * M.K;
#pragma unroll
    for (int j = 0; j < 4; ++j) { const LAS float* s = scr + (8 * c) * 33 + (lane >> 3) + 8 * j;
        v4u o; o.x = pk2(s[0 * 33] * g0[0], s[1 * 33] * g0[1]); o.y = pk2(s[2 * 33] * g0[2], s[3 * 33] * g0[3]); o.z = pk2(s[4 * 33] * g1[0], s[5 * 33] * g1[1]); o.w = pk2(s[6 * 33] * g1[2], s[7 * 33] * g1[3]);
        *(GAS v4u*)(d + j * st) = o; }
    LDS_WAIT(); asm volatile("" ::: "memory");
}
__device__ __forceinline__ void convert_chunk(Frame& F, const P0Args& A, int c) {
    int tid = threadIdx.x; asm volatile("" : "+v"(tid));
    const int wave = __builtin_amdgcn_readfirstlane(tid >> 6), lane = tid & 63;
    LAS float* scr = (LAS float*)(F.lds + RING_OFF + wave * 16384); unsigned char* ws = F.ws;
    int r = c * CONV_CHUNK; CMat M;
    if (r < I_WO) M = CMat{A.nsa_w_out, nullptr, (bf16*)(ws + WS_WO_T), DM, DM, 64};
    else if ((r -= I_WO) < I_RIN) M = CMat{A.ret_w_in, A.norm_mix + DM, (bf16*)(ws + WS_RIN_T), RET_N, DM, 384};
    else if ((r -= I_RIN) < I_RO) M = CMat{A.ret_w_out, nullptr, (bf16*)(ws + WS_RO_T), DM, 4096, 64};
    else if ((r -= I_RO) < 2 * I_W1) { const int l = r / I_W1; r %= I_W1; M = CMat{A.ffn_w1 + (size_t)l * DM * DFF, A.norm_ffn + l * DM, (bf16*)(ws + WS_W1_T) + (size_t)l * DM * DFF, DFF, DM, 256}; }
    else { r -= 2 * I_W1; const int l = r / I_W2; r %= I_W2; M = CMat{A.ffn_w2 + (size_t)l * DM * DFF, nullptr, (bf16*)(ws + WS_W2_T) + (size_t)l * DM * DFF, DM, DFF, 64}; }
    const int kb0 = r / M.NB, nb0 = r % M.NB; const bool wrap = M.NB == 64;
    auto k0_of = [&](int i) { return 64 * (kb0 + (wrap ? (i >> 6) : 0)); };
    auto n0_of = [&](int i) { return 32 * (wrap ? (i & 63) : nb0 + i); };
    f32x4 v[4][8], g[4][2];
#pragma unroll
    for (int s = 0; s < 4; ++s) { const int i = wave + 8 * s; cm_load(M, k0_of(i), n0_of(i), lane, v[s], g[s]); }
    for (int rr = 0; rr < 3; ++rr) {
#pragma unroll
        for (int s = 0; s < 4; ++s) { const int i = wave + 8 * (4 * rr + s); cm_store(M, k0_of(i), n0_of(i), lane, scr, v[s], g[s]); const int i2 = i + 32; cm_load(M, k0_of(i2), n0_of(i2), lane, v[s], g[s]); }
    }
#pragma unroll
    for (int s = 0; s < 4; ++s) { const int i = wave + 8 * (12 + s); cm_store(M, k0_of(i), n0_of(i), lane, scr, v[s], g[s]); }
}
constexpr int N_WIN_PIECES = 16;
__device__ __forceinline__ void win_copy_piece(Frame& F, const P0Args& A, int p) {
    int tid = threadIdx.x; asm volatile("" : "+v"(tid));
    constexpr int PB = 508 * 256, HP = PB / 2;
    const int b = p >> 1, o0 = (p & 1) * HP;
    const GAS f32x4* src = (const GAS f32x4*)(A.state_win + ((size_t)b * 512 + 4) * 1024) + o0; GAS f32x4* dst = (GAS f32x4*)(F.out + O_WINS + (size_t)b * 512 * 1024) + o0;
    for (int i0 = tid; i0 < HP; i0 += NTHR * 8) { f32x4 t[8];
#pragma unroll
        for (int j = 0; j < 8; ++j) { const int i = i0 + j * NTHR; if (i < HP) t[j] = __builtin_nontemporal_load(src + i); }
#pragma unroll
        for (int j = 0; j < 8; ++j) { const int i = i0 + j * NTHR; if (i < HP) __builtin_nontemporal_store(t[j], dst + i); } }
}
__device__ __forceinline__ void posp_items(const P0Args& A, unsigned char* ws, int lane, int w0, int nw) {
    for (int it = w0; it < 256; it += nw) { const int e = it >> 7, hg = (it >> 6) & 1, sl = it & 63, h = hg * 64 + lane;
        const float* pp = A.cmp_pos + (size_t)e * 4096 + sl * 64; const float* ww = A.cmp_w1 + ((size_t)e * 4096 + sl * 64) * 128 + h; float a = 0.f;
#pragma unroll 16
        for (int k = 0; k < 64; ++k) a += pp[k] * ww[(size_t)k * 128];
        ((float*)(ws + WS_POSP))[(e * 64 + sl) * 128 + h] = a; }
}
__device__ __forceinline__ void p0_prologue(Frame& F, const P0Args& A) {
    unsigned char* ws = F.ws;
    LAS float* scr = (LAS float*)(F.lds + RING_OFF + F.wave * 16384);
    const int lane = F.lane, gw = F.gw, NGW = F.NGW;
    for (int pass = 0; pass < 2; ++pass) {
      if ((pass == 0) != (bool)(blockIdx.x & 1)) {
    convert_items<2>(A, ws, scr, lane, (bf16*)(ws + WS_H1) + (size_t)gw * 512, gw, N_EARLY, NGW);
    { GAS v4u* z = (GAS v4u*)((bf16*)(ws + WS_WIN_T) + (size_t)NSA_N * DM); const int n16 = (NSA_NP - NSA_N) * DM / 8;
      for (int i = gw * 64 + lane; i < n16; i += NGW * 64) z[i] = (v4u){0u, 0u, 0u, 0u}; }
    { auto xrow = [&](int m) -> const float* { return m < MP ? A.x_prompt + (size_t)m * DM : A.x_sample + (size_t)(m - MP) * DM; };
      auto orow = [&](int m) -> bf16* { return m < MP ? (bf16*)(ws + WS_XN) + (size_t)m * DM : (bf16*)(ws + WS_XS) + (size_t)(m - MP) * DM; };
      f32x4 va[8], vb[8]; int ma = gw; constexpr int ML = MP + NS - 1; rms_load(xrow(min(ma, ML)), lane, va);
      while (ma < MP + NS) {
          const int mb = ma + NGW; rms_load(xrow(min(mb, ML)), lane, vb);
          rms_finish(va, A.norm_mix, orow(ma), lane);
          ma = mb + NGW; rms_load(xrow(min(ma, ML)), lane, va);
          if (mb < MP + NS) rms_finish(vb, A.norm_mix, orow(mb), lane);
      } }
      } else {
    { f32x2* tn = (f32x2*)(ws + WS_ROPEN); f32x2* tr = (f32x2*)(ws + WS_ROPER); const int NT1 = NPOSE * 64, NT2 = NPOSE * 128;
      for (int i = gw * 64 + lane; i < NT1 + NT2; i += NGW * 64) {
          int p, k, half; if (i < NT1) { p = i >> 6; k = i & 63; half = 64; } else { const int j = i - NT1; p = j >> 7; k = j & 127; half = 128; }
          const float pos = (float)(p < 4096 ? p : PAST + (p - 4096));
          const float inv = (float)exp2(-(double)k / (double)half * 13.287712379549449);
          const float ang = pos * inv; float c, s; cossin_acc(ang, c, s);
          if (i < NT1) tn[i] = (f32x2){c, s}; else tr[i - NT1] = (f32x2){c, s}; } }
      }
    }
    if (F.G != 256) posp_items(A, ws, lane, gw, NGW);
}
__device__ __forceinline__ void skinny_mma(const bf16* A, const bf16* Wt, int K, int col0, int lane, f32x4 (&acc)[2][2]) {
    const int r = lane & 15, q = lane >> 4;
    const bf16* a0 = A + (size_t)r * K + q * 8; const bf16* a1 = a0 + (size_t)16 * K;
    const bf16* w0 = Wt + (size_t)(col0 + r) * K + q * 8; const bf16* w1 = w0 + (size_t)16 * K;
#pragma unroll
    for (int i = 0; i < 2; ++i)
#pragma unroll
        for (int j = 0; j < 2; ++j) acc[i][j] = (f32x4){0.f, 0.f, 0.f, 0.f};
#pragma unroll 4
    for (int k0 = 0; k0 < K; k0 += 32) {
        const bf16x8 fa0 = *(const bf16x8*)(a0 + k0), fa1 = *(const bf16x8*)(a1 + k0), fw0 = *(const bf16x8*)(w0 + k0), fw1 = *(const bf16x8*)(w1 + k0);
        acc[0][0] = __builtin_amdgcn_mfma_f32_16x16x32_bf16(fw0, fa0, acc[0][0], 0, 0, 0);
        acc[0][1] = __builtin_amdgcn_mfma_f32_16x16x32_bf16(fw1, fa0, acc[0][1], 0, 0, 0);
        acc[1][0] = __builtin_amdgcn_mfma_f32_16x16x32_bf16(fw0, fa1, acc[1][0], 0, 0, 0);
        acc[1][1] = __builtin_amdgcn_mfma_f32_16x16x32_bf16(fw1, fa1, acc[1][1], 0, 0, 0);
    }
}
__device__ __forceinline__ void skinny_mma_part(const bf16* A, const bf16* Wt, int ld, int kbeg, int klen, int col0, int lane, f32x4 (&acc)[2][2]) {
    const int r = lane & 15, q = lane >> 4;
    const bf16* a0 = A + (size_t)r * ld + kbeg + q * 8; const bf16* a1 = a0 + (size_t)16 * ld;
    const bf16* w0 = Wt + (size_t)(col0 + r) * ld + kbeg + q * 8; const bf16* w1 = w0 + (size_t)16 * ld;
#pragma unroll
    for (int i = 0; i < 2; ++i)
#pragma unroll
        for (int j = 0; j < 2; ++j) acc[i][j] = (f32x4){0.f, 0.f, 0.f, 0.f};
#pragma unroll 8
    for (int k0 = 0; k0 < klen; k0 += 32) {
        const bf16x8 fa0 = *(const bf16x8*)(a0 + k0), fa1 = *(const bf16x8*)(a1 + k0), fw0 = *(const bf16x8*)(w0 + k0), fw1 = *(const bf16x8*)(w1 + k0);
        acc[0][0] = __builtin_amdgcn_mfma_f32_16x16x32_bf16(fw0, fa0, acc[0][0], 0, 0, 0);
        acc[0][1] = __builtin_amdgcn_mfma_f32_16x16x32_bf16(fw1, fa0, acc[0][1], 0, 0, 0);
        acc[1][0] = __builtin_amdgcn_mfma_f32_16x16x32_bf16(fw0, fa1, acc[1][0], 0, 0, 0);
        acc[1][1] = __builtin_amdgcn_mfma_f32_16x16x32_bf16(fw1, fa1, acc[1][1], 0, 0, 0);
    }
}
__device__ __forceinline__ void skinny_mma_wg(LAS float* red, const bf16* A, const bf16* Wt, int K, int col0, int wave, int lane, f32x4 (&acc)[2][2]) {
    const int r = lane & 15, q = lane >> 4, kw = K >> 3;
    const bf16* a0 = A + (size_t)r * K + wave * kw + q * 8; const bf16* a1 = a0 + (size_t)16 * K;
    const bf16* w0 = Wt + (size_t)(col0 + r) * K + wave * kw + q * 8; const bf16* w1 = w0 + (size_t)16 * K;
#pragma unroll
    for (int i = 0; i < 2; ++i)
#pragma unroll
        for (int j = 0; j < 2; ++j) acc[i][j] = (f32x4){0.f, 0.f, 0.f, 0.f};
#pragma unroll 8
    for (int k0 = 0; k0 < kw; k0 += 32) {
        const bf16x8 fa0 = *(const bf16x8*)(a0 + k0), fa1 = *(const bf16x8*)(a1 + k0), fw0 = *(const bf16x8*)(w0 + k0), fw1 = *(const bf16x8*)(w1 + k0);
        acc[0][0] = __builtin_amdgcn_mfma_f32_16x16x32_bf16(fw0, fa0, acc[0][0], 0, 0, 0);
        acc[0][1] = __builtin_amdgcn_mfma_f32_16x16x32_bf16(fw1, fa0, acc[0][1], 0, 0, 0);
        acc[1][0] = __builtin_amdgcn_mfma_f32_16x16x32_bf16(fw0, fa1, acc[1][0], 0, 0, 0);
        acc[1][1] = __builtin_amdgcn_mfma_f32_16x16x32_bf16(fw1, fa1, acc[1][1], 0, 0, 0);
    }
    LAS f32x4* rp = (LAS f32x4*)red + (wave * 64 + lane) * 4;
    rp[0] = acc[0][0]; rp[1] = acc[0][1]; rp[2] = acc[1][0]; rp[3] = acc[1][1];
    __syncthreads();
    if (wave == 0) {
#pragma unroll
        for (int w = 1; w < 8; ++w) { const LAS f32x4* sp = (const LAS f32x4*)red + (w * 64 + lane) * 4; acc[0][0] += sp[0]; acc[0][1] += sp[1]; acc[1][0] += sp[2]; acc[1][1] += sp[3]; } }
    __syncthreads();
}
__device__ __forceinline__ float sigmoidf_(float x) { return __builtin_amdgcn_rcpf(1.0f + __expf(-x)); }
__device__ __forceinline__ void rope4(const f32x4 x1, const f32x4 x2, const f32x4 csA, const f32x4 csB, f32x4& o1, f32x4& o2) {
    o1 = (f32x4){x1[0] * csA[0] - x2[0] * csA[1], x1[1] * csA[2] - x2[1] * csA[3], x1[2] * csB[0] - x2[2] * csB[1], x1[3] * csB[2] - x2[3] * csB[3]};
    o2 = (f32x4){x2[0] * csA[0] + x1[0] * csA[1], x2[1] * csA[2] + x1[1] * csA[3], x2[2] * csB[0] + x1[2] * csB[1], x2[3] * csB[2] + x1[3] * csB[3]};
}
__device__ __forceinline__ v2u pk4(const f32x4 v) { v2u o; o.x = pk2(v[0], v[1]); o.y = pk2(v[2], v[3]); return o; }

struct EpiNsaIn {
    static constexpr bool PERM = false, AFTER_DRAIN = false;
    bf16* Q; bf16* KV; bf16* KVC; float* gates; float* out; const float* rope;
    __device__ __forceinline__ void operator()(const pg8::f32x4 (&acc)[2][2][4][2], const pg8::Unit& u, int wr, int wc, int fr, int fq) const {
        const int pn = u.pn;
        if (pn == 20) {
            if (wc < 2) {
#pragma unroll
                for (int ai = 0; ai < 2; ++ai)
#pragma unroll
                    for (int m = 0; m < 4; ++m) { const int row = u.pm * 256 + ai * 128 + wr * 64 + m * 16 + fr;
#pragma unroll
                        for (int n = 0; n < 2; ++n) { const int c = 32 * wc + 16 * n + 4 * fq;
                            if (c < 48) { const f32x4 v = acc[ai][0][m][n]; *(GAS f32x4*)(gates + (size_t)row * 48 + c) = (f32x4){sigmoidf_(v[0]), sigmoidf_(v[1]), sigmoidf_(v[2]), sigmoidf_(v[3])}; } } }
            }
            return;
        }
        if (pn < 8) { tile<true, 0>(acc, u, wr, wc, fr, fq, 0, 0); return; }
        const int hk0 = 2 * (pn - 8), br = hk0 >> 3, e = (hk0 >> 2) & 1, g0 = hk0 & 3; const bool wout = ((u.pm * 256) & 4095) >= SEQ - 512;
        if (br == 0) { if (e == 0) tile<true, 1>(acc, u, wr, wc, fr, fq, e, g0); else tile<false, 1>(acc, u, wr, wc, fr, fq, e, g0); }
        else if (br == 1) { if (e == 0) tile<true, 2>(acc, u, wr, wc, fr, fq, e, g0); else tile<false, 2>(acc, u, wr, wc, fr, fq, e, g0); }
        else if (wout) { if (e == 0) tile<true, 3>(acc, u, wr, wc, fr, fq, e, g0); else tile<false, 3>(acc, u, wr, wc, fr, fq, e, g0); }
        else { if (e == 0) tile<true, 4>(acc, u, wr, wc, fr, fq, e, g0); else tile<false, 4>(acc, u, wr, wc, fr, fq, e, g0); }
    }
    template <bool ROPE, int KIND>
    __device__ __forceinline__ void tile(const pg8::f32x4 (&acc)[2][2][4][2], const pg8::Unit& u, int wr, int wc, int fr, int fq, int e, int g0) const {
        const int pn = u.pn, d = wc * 16 + 4 * fq, row0 = u.pm * 256 + wr * 64 + fr;
        f32x4 cs[2][2];
        auto ldr = [&](int it, int sset) { const int t = (row0 + (it >> 2) * 128 + (it & 3) * 16) & 4095; const float* rp = rope + ((size_t)t * 64 + d) * 2;
            cs[sset][0] = *(const GAS f32x4*)rp; cs[sset][1] = *(const GAS f32x4*)(rp + 4); };
        if constexpr (ROPE) ldr(0, 0);
#pragma unroll
        for (int it = 0; it < 8; ++it) { if constexpr (ROPE) { if (it + 1 < 8) ldr(it + 1, (it + 1) & 1); }
            const int ai = it >> 2, m = it & 3, row = row0 + ai * 128 + m * 16, b = row >> 12, t = row & 4095;
#pragma unroll
            for (int bj = 0; bj < 2; ++bj) { const f32x4 x1 = acc[ai][bj][m][0], x2 = acc[ai][bj][m][1]; f32x4 o1 = x1, o2 = x2;
                if constexpr (ROPE) rope4(x1, x2, cs[it & 1][0], cs[it & 1][1], o1, o2);
                if constexpr (KIND == 0) { const int hh = 2 * pn + bj; bf16* q = Q + ((size_t)(b * 16 + hh) * SEQ + t) * 128 + d; *(GAS v2u*)q = pk4(o1); *(GAS v2u*)(q + 64) = pk4(o2); }
                else { const int g = g0 + bj;
                    bf16* kv = (KIND == 1 ? KVC + ((size_t)((e * 2 + b) * 4 + g) * SEQ + t) * 128 : KV + ((size_t)(((((KIND == 2) ? 0 : 1) * 2 + e) * 2 + b) * 4 + g) * SEQ + t) * 128) + d; *(GAS v2u*)kv = pk4(o1); *(GAS v2u*)(kv + 64) = pk4(o2);
                    if constexpr (KIND != 4) { float* o = (KIND == 1) ? out + O_CMPP + (size_t)row * 1024 : (KIND == 2) ? out + O_SELP + (size_t)row * 1024 : out + O_WINP + ((size_t)b * 512 + (t - (SEQ - 512))) * 1024;
                        o += e * 512 + g * 128 + d; __builtin_nontemporal_store(o1, (GAS f32x4*)o); __builtin_nontemporal_store(o2, (GAS f32x4*)(o + 64)); } } } }
    }
};
__device__ __forceinline__ void p1_sample(Frame& F, const bf16* XS, const bf16* WinT, const float* rope, float* QS, float* GS) {
    const int lane = F.lane, r16 = lane & 15, q4 = lane >> 4;
    LAS float* red = (LAS float*)(F.lds + RING_OFF);
    const bool alt = (F.G == 256);
    for (int sl = alt ? (int)blockIdx.x - 160 : (int)blockIdx.x; sl >= 0 && sl < 162; sl += alt ? 96 : F.G) {
        f32x4 acc[2][2]; const int col0 = 32 * sl; skinny_mma_wg(red, XS, WinT, DM, col0, F.wave, lane, acc);
        if (F.wave != 0) continue;
#pragma unroll
        for (int rh = 0; rh < 2; ++rh) { const int sr = rh * 16 + r16, b = sr >> 2, t = sr & 3;
            if (col0 >= 5120) {
#pragma unroll
                for (int cs = 0; cs < 2; ++cs) { const int c = col0 - 5120 + cs * 16 + 4 * q4;
                    if (c < 48) { const f32x4 v = acc[rh][cs]; *(f32x4*)(GS + sr * 48 + c) = (f32x4){sigmoidf_(v[0]), sigmoidf_(v[1]), sigmoidf_(v[2]), sigmoidf_(v[3])}; } }
            } else {
                const int hh = col0 >> 7, wc = (col0 & 127) >> 5, d = wc * 16 + 4 * q4;
                const f32x4 csA = *(const f32x4*)(rope + ((size_t)(4096 + t) * 64 + d) * 2), csB = *(const f32x4*)(rope + ((size_t)(4096 + t) * 64 + d) * 2 + 4);
                const f32x4 x1 = acc[rh][0], x2 = acc[rh][1]; f32x4 o1 = x1, o2 = x2;
                if (hh < 16) { rope4(x1, x2, csA, csB, o1, o2); float* q = QS + (size_t)sr * DM + hh * 128 + d; *(f32x4*)q = o1; *(f32x4*)(q + 64) = o2; }
                else { const int hk = hh - 16, br = hk >> 3, e = (hk >> 2) & 1, g = hk & 3;
                    if (e == 0) rope4(x1, x2, csA, csB, o1, o2);
                    float* o = (br == 0) ? F.out + O_CMPS + (size_t)sr * 1024 : (br == 1) ? F.out + O_SELS + (size_t)sr * 1024 : F.out + O_WINS + ((size_t)b * 512 + 508 + t) * 1024;
                    o += e * 512 + g * 128 + d; *(f32x4*)o = o1; *(f32x4*)(o + 64) = o2; }
            }
        }
    }
}
struct CmpOrder {
    int G, c;
    __device__ bool next(int i, pg8::Unit& u) const { const int L = i * G + c; if (L >= 256) return false; u.pm = 16 + L; u.pn = L >> 7; return true; }
    __device__ __forceinline__ void a_ready(const pg8::Unit&) const {}
    __device__ __forceinline__ void done(const pg8::Unit&) const {}
};
struct EpiPer {
    static constexpr bool PERM = false, AFTER_DRAIN = false;
    bf16* PER;
    __device__ __forceinline__ void operator()(const pg8::f32x4 (&acc)[2][2][4][2], const pg8::Unit& u, int wr, int wc, int fr, int fq) const {
#pragma unroll
        for (int ai = 0; ai < 2; ++ai)
#pragma unroll
            for (int m = 0; m < 4; ++m) { bf16* rowp = PER + (size_t)(u.pm * 256 + ai * 128 + wr * 64 + m * 16 + fr) * 256 + wc * 32 + 4 * fq;
#pragma unroll
                for (int bj = 0; bj < 2; ++bj)
#pragma unroll
                    for (int n = 0; n < 2; ++n) *(GAS v2u*)(rowp + bj * 128 + n * 16) = pk4(acc[ai][bj][m][n]); }
    }
};
__device__ __forceinline__ void p2_prompt_per(Frame& F) {
    unsigned char* ws = F.ws; const int lane = F.lane, r16 = lane & 15, q4 = lane >> 4, wave = F.wave, tq = wave >> 1, kh = wave & 1;
    LAS float* red = (LAS float*)(F.lds + RING_OFF);
    for (int base = blockIdx.x * 4; base < 1024; base += F.G * 4) { const int it = base + tq, e = it >> 9, rg = (it >> 3) & 63, cg = it & 7;
        f32x4 acc[2][2]; skinny_mma_part((const bf16*)(ws + WS_KVC) + ((size_t)e * 2048 + rg * 32) * 2048, (const bf16*)(ws + WS_CW1_T) + (size_t)e * 256 * 2048, 2048, kh * 1024, 1024, cg * 32, lane, acc);
        LAS f32x4* rp = (LAS f32x4*)red + (wave * 64 + lane) * 4;
        if (kh) { rp[0] = acc[0][0]; rp[1] = acc[0][1]; rp[2] = acc[1][0]; rp[3] = acc[1][1]; }
        __syncthreads();
        if (!kh) { const LAS f32x4* sp = (const LAS f32x4*)red + ((wave + 1) * 64 + lane) * 4; acc[0][0] += sp[0]; acc[0][1] += sp[1]; acc[1][0] += sp[2]; acc[1][1] += sp[3];
            bf16* per = (bf16*)(ws + WS_PER);
#pragma unroll
            for (int rh = 0; rh < 2; ++rh)
#pragma unroll
                for (int cs = 0; cs < 2; ++cs) *(v2u*)(per + ((size_t)e * 2048 + rg * 32 + rh * 16 + r16) * 256 + cg * 32 + cs * 16 + 4 * q4) = pk4(acc[rh][cs]); }
        __syncthreads(); }
}
__device__ __forceinline__ float gelu_tanh(float x) { const float u = 0.7978845608028654f * (x + 0.044715f * x * x * x); const float t = 1.0f - 2.0f / (__expf(2.0f * u) + 1.0f); return 0.5f * x * (1.0f + t); }
__device__ __forceinline__ void p3_finish(Frame& F) {
    unsigned char* ws = F.ws; const int lane = F.lane, r16 = lane & 15, q4 = lane >> 4;
    const bf16* per = (const bf16*)(ws + WS_PER); const float* posb = (const float*)(ws + WS_POSB);
    LAS bf16* w2l = (LAS bf16*)(F.lds + RING_OFF);
    for (int i = F.tid; i < 2 * 128 * 128 / 8; i += NTHR) *(LAS v4u*)(w2l + (i >> 4) * 136 + (i & 15) * 8) = *((const v4u*)(ws + WS_CW2_T) + i);
    __syncthreads();
    for (int it = F.gw; it < 2 * (128 + 2048); it += F.NGW) {
        int e, R0, NCH; size_t perbase; bf16* dst;
        if (it < 256) { e = it >> 7; R0 = (it & 127) * 16; NCH = 256; perbase = (size_t)e * 2048; dst = (bf16*)(ws + WS_KCP) + (size_t)e * 2048 * 128; }
        else { const int j = it - 256; e = j >> 11; R0 = (j & 2047) * 16; NCH = 1024; perbase = 4096 + (size_t)e * 32768; dst = (bf16*)(ws + WS_KCS) + (size_t)e * 32768 * 128; }
        const int R = R0 + r16, i = R & (NCH - 1); const bool valid = i < NCH - 1;
        bf16x8 af[4];
#pragma unroll
        for (int kk = 0; kk < 4; ++kk) { const int h0 = kk * 32 + q4 * 8; f32x4 a0 = {0.f, 0.f, 0.f, 0.f}, a1 = a0;
            if (valid) { const v4u u0 = *(const v4u*)(per + (perbase + R) * 256 + h0), u1 = *(const v4u*)(per + (perbase + R + 1) * 256 + 128 + h0); const float* pb = posb + e * 128 + h0;
                a0 = (f32x4){bf2f(u0.x & 0xffff) + bf2f(u1.x & 0xffff), bf2f(u0.x >> 16) + bf2f(u1.x >> 16), bf2f(u0.y & 0xffff) + bf2f(u1.y & 0xffff), bf2f(u0.y >> 16) + bf2f(u1.y >> 16)} + *(const f32x4*)pb;
                a1 = (f32x4){bf2f(u0.z & 0xffff) + bf2f(u1.z & 0xffff), bf2f(u0.z >> 16) + bf2f(u1.z >> 16), bf2f(u0.w & 0xffff) + bf2f(u1.w & 0xffff), bf2f(u0.w >> 16) + bf2f(u1.w >> 16)} + *(const f32x4*)(pb + 4);
#pragma unroll
                for (int j = 0; j < 4; ++j) { a0[j] = gelu_tanh(a0[j]); a1[j] = gelu_tanh(a1[j]); } }
            v4u w; w.x = pk2(a0[0], a0[1]); w.y = pk2(a0[2], a0[3]); w.z = pk2(a1[0], a1[1]); w.w = pk2(a1[2], a1[3]); af[kk] = __builtin_bit_cast(bf16x8, w); }
        const LAS bf16* w2t = w2l + e * 128 * 136;
#pragma unroll
        for (int nt = 0; nt < 8; ++nt) { f32x4 acc = {0.f, 0.f, 0.f, 0.f};
#pragma unroll
            for (int kk = 0; kk < 4; ++kk) { const bf16x8 wf = *(const LAS bf16x8*)(w2t + (nt * 16 + r16) * 136 + kk * 32 + q4 * 8); acc = __builtin_amdgcn_mfma_f32_16x16x32_bf16(wf, af[kk], acc, 0, 0, 0); }
            *(v2u*)(dst + (size_t)R * 128 + nt * 16 + 4 * q4) = pk4(acc); }
    }
    __syncthreads();
}
__device__ __forceinline__ void cmp_fused_unit(PG8_LAS unsigned char* lds, int L, const float* cache, const int* page_table, const bf16* CW1T, bf16* PER) {
    using namespace pg8;
    int tid = threadIdx.x; asm volatile("" : "+v"(tid));
    const int wid = __builtin_amdgcn_readfirstlane(tid >> 6), lane = tid & 63, wr = wid >> 2, wc = wid & 3, fr = lane & 15, fq = lane >> 4;
    const int e = L >> 7, bg = (L >> 2) & 31, qt = L & 3, b = bg >> 2, g = bg & 3, c0 = qt * 256;
    const float* asrc[2][2];
#pragma unroll
    for (int h = 0; h < 2; ++h)
#pragma unroll
        for (int i = 0; i < 2; ++i) { int R, C; stage_rc(tid * 16 + i * 8192, R, C); const int c = c0 + h * 128 + R; const int page = page_table[b * 128 + (c >> 3)];
            asrc[h][i] = cache + ((size_t)page * 128 + ((c * 16) & 127)) * 1024 + e * 512 + g * 128 + C; }
    unsigned voffB[2];
#pragma unroll
    for (int i = 0; i < 2; ++i) { int R, C; stage_rc(tid * 16 + i * 8192, R, C); voffB[i] = (unsigned)(R * 2048 + C) * 2u; }
    const char* Bg = (const char*)(CW1T + (size_t)e * 256 * 2048);
    const unsigned ldsw = (unsigned)wid * 1024u;
    const int aoff = lds_byte(wr * 64 + fr, fq * 8), boff = lds_byte(wc * 32 + fr, fq * 8);
#define CF_SA(bf, h) (((bf) * 2 + (h)) * HTB)
#define CF_SB(bf, h) ((4 + (bf) * 2 + (h)) * HTB)
#define CF_LOADA(kt, ST) do { const int ko_ = ((kt) >> 1) * 1024 + ((kt) & 1) * 64; _Pragma("unroll") for (int h = 0; h < 2; ++h) _Pragma("unroll") for (int i = 0; i < 2; ++i) { \
        ar[ST][h][i][0] = __builtin_nontemporal_load((const f32x4*)(asrc[h][i] + ko_)); ar[ST][h][i][1] = __builtin_nontemporal_load((const f32x4*)(asrc[h][i] + ko_ + 4)); } } while (0)
#define CF_DMAB(kt, bf) do { _Pragma("unroll") for (int h = 0; h < 2; ++h) _Pragma("unroll") for (int i = 0; i < 2; ++i) \
        __builtin_amdgcn_global_load_lds((const unsigned*)(Bg + (size_t)h * 128 * 2048 * 2 + (size_t)(kt) * 128 + voffB[i]), (PG8_LAS unsigned*)(lds + CF_SB(bf, h) + ldsw + i * 8192), 16, 0, 0); } while (0)
#define CF_WRITEA(bf) do { _Pragma("unroll") for (int h = 0; h < 2; ++h) _Pragma("unroll") for (int i = 0; i < 2; ++i) { v4u w; w.x = pk2(ar[bf][h][i][0][0], ar[bf][h][i][0][1]); w.y = pk2(ar[bf][h][i][0][2], ar[bf][h][i][0][3]); \
        w.z = pk2(ar[bf][h][i][1][0], ar[bf][h][i][1][1]); w.w = pk2(ar[bf][h][i][1][2], ar[bf][h][i][1][3]); *(PG8_LAS v4u*)(lds + CF_SA(bf, h) + tid * 16 + i * 8192) = w; } } while (0)
    f32x4 ar[2][2][2][2];
    pg8::f32x4 acc[2][2][4][2];
#pragma unroll
    for (int a = 0; a < 2; ++a)
#pragma unroll
        for (int bb = 0; bb < 2; ++bb)
#pragma unroll
            for (int m = 0; m < 4; ++m)
#pragma unroll
                for (int n = 0; n < 2; ++n) acc[a][bb][m][n] = (pg8::f32x4){0.f, 0.f, 0.f, 0.f};
    CF_LOADA(0, 0); CF_DMAB(0, 0);
    asm volatile("s_waitcnt vmcnt(0)" ::: "memory");
    CF_WRITEA(0);
    CF_LOADA(1, 1); CF_DMAB(1, 1); CF_LOADA(2, 0);
    asm volatile("s_waitcnt lgkmcnt(0)" ::: "memory"); __builtin_amdgcn_s_barrier(); asm volatile("" ::: "memory");
#define CF_STEP(kt, BF) do { \
        __builtin_amdgcn_sched_barrier(0); \
        _Pragma("unroll") for (int bj = 0; bj < 2; ++bj) { bf16x8 Bx[2][2]; \
            _Pragma("unroll") for (int n = 0; n < 2; ++n) _Pragma("unroll") for (int k = 0; k < 2; ++k) Bx[n][k] = *(const PG8_LAS bf16x8*)(lds + CF_SB(BF, bj) + boff + n * 2048 + k * 1024); \
            _Pragma("unroll") for (int ai = 0; ai < 2; ++ai) _Pragma("unroll") for (int mp = 0; mp < 2; ++mp) { bf16x8 At[2][2]; \
                _Pragma("unroll") for (int m = 0; m < 2; ++m) _Pragma("unroll") for (int k = 0; k < 2; ++k) At[m][k] = *(const PG8_LAS bf16x8*)(lds + CF_SA(BF, ai) + aoff + (2 * mp + m) * 2048 + k * 1024); \
                _Pragma("unroll") for (int m = 0; m < 2; ++m) _Pragma("unroll") for (int n = 0; n < 2; ++n) _Pragma("unroll") for (int k = 0; k < 2; ++k) \
                    acc[ai][bj][2 * mp + m][n] = __builtin_amdgcn_mfma_f32_16x16x32_bf16(Bx[n][k], At[m][k], acc[ai][bj][2 * mp + m][n], 0, 0, 0); \
                __builtin_amdgcn_sched_barrier(0); } } \
        if ((kt) + 1 < 32) { CF_WRITEA(1 - (BF)); } \
        if ((kt) + 3 < 32) asm volatile("s_waitcnt vmcnt(8) lgkmcnt(0)" ::: "memory"); else asm volatile("s_waitcnt vmcnt(0) lgkmcnt(0)" ::: "memory"); \
        __builtin_amdgcn_s_barrier(); asm volatile("" ::: "memory"); \
        if ((kt) + 2 < 32) CF_DMAB((kt) + 2, BF); \
        if ((kt) + 3 < 32) CF_LOADA((kt) + 3, 1 - (BF)); } while (0)
    for (int kt = 0; kt < 32; kt += 2) { CF_STEP(kt, 0); CF_STEP(kt + 1, 1); }
#undef CF_STEP
    EpiPer E{PER}; Unit u; u.pm = 16 + L; u.pn = e;
    E(acc, u, wr, wc, fr, fq);
    asm volatile("s_waitcnt vmcnt(0) lgkmcnt(0)" ::: "memory"); __builtin_amdgcn_s_barrier();
#undef CF_SA
#undef CF_SB
#undef CF_LOADA
#undef CF_DMAB
#undef CF_WRITEA
}
__device__ __forceinline__ void p2_sample_fused(Frame& F, const float* cache, const int* page_table) {
    for (int i = blockIdx.x; i < 256; i += F.G) { const int xcd = i & 7, slot = i >> 3, eg = slot & 7, bq = (slot >> 3) * 8 + xcd, L = (eg >> 2) * 128 + ((bq >> 2) * 4 + (eg & 3)) * 4 + (bq & 3);
        cmp_fused_unit((PG8_LAS unsigned char*)(F.lds + RING_OFF), L, cache, page_table, (const bf16*)(F.ws + WS_CW1_T), (bf16*)(F.ws + WS_PER)); }
}
namespace att {
typedef short s16x4 __attribute__((ext_vector_type(4)));
typedef float f32x16 __attribute__((ext_vector_type(16)));
typedef unsigned u32x4 __attribute__((ext_vector_type(4)));
constexpr float SCALE = 0.08838834764831845f;
constexpr float THR = 8.f;
constexpr int SHM_V = 64 * 128 * 2, SHM_K = 64 * 128 * 2;
constexpr int L_V = 0, L_K = 2 * SHM_V, L_ACC = 65536, L_WS = 131072 + 1024, L_SELM = L_WS + 8 * 512;
#define KSWZ(row, colB) ((row) * 256 + ((colB) ^ (((row) & 7) << 4)))
#define SBAR() __builtin_amdgcn_sched_barrier(0)
__device__ __forceinline__ int v_st(int k, int c) { const int kk = (k & ~0xC) | ((k & 4) << 1) | ((k & 8) >> 1); return ((kk >> 3) * 4 + (c >> 5)) * 512 + ((kk & 7) * 32 + (c & 31)) * 2; }
__device__ __forceinline__ int v_rd_base(int lane) { return ((lane & 3) << 3) | (((lane >> 2) & 3) << 6) | (((lane >> 4) & 1) << 5) | (((lane >> 5) & 1) << 8); }
constexpr int v_rd_off(int d0, int ks, int half) { return d0 * 512 + ks * 4096 + half * 2048; }
__device__ __forceinline__ int crow(int r, int hi) { return (r & 3) + 8 * (r >> 2) + 4 * hi; }
__device__ __forceinline__ unsigned cvtpk(float lo, float hi) { unsigned r; asm volatile("v_cvt_pk_bf16_f32 %0, %1, %2" : "=v"(r) : "v"(lo), "v"(hi)); return r; }
__device__ __forceinline__ void mask_lohi(f32x16& p0, f32x16& p1, int lo, int lim, int hi) {
    const float NEG = -__builtin_inff();
#pragma unroll
    for (int r = 0; r < 16; ++r) { const int c = (r & 3) + 8 * (r >> 2) + 4 * hi;
        if (c < lo || c > lim) p0[r] = NEG;
        if (c + 32 < lo || c + 32 > lim) p1[r] = NEG; }
}
__device__ __forceinline__ void partialSM(f32x16& p0, f32x16& p1, float& m_reg, float& mn, float& alpha, bool rv) {
    float pmax = p0[0];
#pragma unroll
    for (int r = 1; r < 16; ++r) pmax = fmaxf(pmax, p0[r]);
#pragma unroll
    for (int r = 0; r < 16; ++r) pmax = fmaxf(pmax, p1[r]);
    { auto rr = __builtin_amdgcn_permlane32_swap(__float_as_uint(pmax), __float_as_uint(pmax), false, false);
      pmax = fmaxf(__uint_as_float(rr[0]), __uint_as_float(rr[1])); }
    if (!rv) pmax = -__builtin_inff();
    constexpr float C2 = 1.4426950408889634f * SCALE;
    if (__builtin_expect(__all((pmax - m_reg) * SCALE <= THR), 1)) { mn = m_reg; alpha = 1.f; }
    else { mn = fmaxf(m_reg, pmax); alpha = __builtin_amdgcn_exp2f((m_reg - mn) * C2); m_reg = mn; }
    const float mnL = -mn * C2;
#pragma unroll
    for (int r = 0; r < 16; ++r) p0[r] = fmaf(p0[r], C2, mnL);
#pragma unroll
    for (int r = 0; r < 16; ++r) p1[r] = fmaf(p1[r], C2, mnL);
#pragma unroll
    for (int r = 0; r < 16; ++r) p0[r] = __builtin_amdgcn_exp2f(p0[r]);
}
__device__ __forceinline__ void finishSM(f32x16& p0, f32x16& p1, float alpha, float& l_reg, bf16x8& pa0, bf16x8& pa1, bf16x8& pa2, bf16x8& pa3, bool rv) {
#pragma unroll
    for (int r = 0; r < 16; ++r) p1[r] = __builtin_amdgcn_exp2f(p1[r]);
    float ps = 0;
#pragma unroll
    for (int r = 0; r < 16; ++r) ps += p0[r];
#pragma unroll
    for (int r = 0; r < 16; ++r) ps += p1[r];
    { auto rr = __builtin_amdgcn_permlane32_swap(__float_as_uint(ps), __float_as_uint(ps), false, false);
      ps = __uint_as_float(rr[0]) + __uint_as_float(rr[1]); }
    ps = rv ? ps : 0.f;
    l_reg = l_reg * alpha + ps;
#define PK4(P, B_, OUT) do { unsigned a0 = cvtpk(P[B_+0], P[B_+1]), a1 = cvtpk(P[B_+2], P[B_+3]);                          \
        unsigned b0 = cvtpk(P[B_+4], P[B_+5]), b1 = cvtpk(P[B_+6], P[B_+7]);                                             \
        auto r0 = __builtin_amdgcn_permlane32_swap(a0, b0, false, false); auto r1 = __builtin_amdgcn_permlane32_swap(a1, b1, false, false); \
        u32x4 w = {r0[0], r1[0], r0[1], r1[1]}; OUT = *reinterpret_cast<bf16x8*>(&w); } while (0)
    PK4(p0, 0, pa0); PK4(p0, 8, pa1); PK4(p1, 0, pa2); PK4(p1, 8, pa3);
#undef PK4
    if (!rv) { pa0 = bf16x8{}; pa1 = bf16x8{}; pa2 = bf16x8{}; pa3 = bf16x8{}; }
}
template <int KB>
__device__ __forceinline__ void qkt(f32x16& p0, f32x16& p1, const char* K_lds, int r32, int hi, const bf16x8* qr) {
    p0 = f32x16{}; p1 = f32x16{};
    __builtin_amdgcn_s_setprio(1);
    const char* kb[4];
#pragma unroll
    for (int dd = 0; dd < 4; ++dd) kb[dd] = K_lds + KB * SHM_K + KSWZ(r32, (dd * 16 + hi * 8) * 2);
#pragma unroll
    for (int d0 = 0; d0 < 8; ++d0) { const char* a = kb[d0 & 3] + (d0 >> 2) * 128;
        bf16x8 b0 = *reinterpret_cast<const bf16x8*>(a);
        bf16x8 b1 = *reinterpret_cast<const bf16x8*>(a + 32 * 256);
        p0 = __builtin_amdgcn_mfma_f32_32x32x16_bf16(b0, qr[d0], p0, 0, 0, 0);
        p1 = __builtin_amdgcn_mfma_f32_32x32x16_bf16(b1, qr[d0], p1, 0, 0, 0);
        if (d0 == 3) SBAR(); }
    __builtin_amdgcn_s_setprio(0);
}
template <int VB>
__device__ __forceinline__ void pv_tile(f32x16* o, int vb0, bf16x8 pa0, bf16x8 pa1, bf16x8 pa2, bf16x8 pa3) {
#define TRRD(dst, off) asm volatile("ds_read_b64_tr_b16 %0, %1 offset:%2" : "=&v"(dst) : "v"(vb0), "i"(off) : "memory")
#define PV_D0(d0) do { s16x4 l0, l1, l2, l3, h0, h1, h2, h3; constexpr int b_ = VB * SHM_V + v_rd_off(d0, 0, 0); \
        TRRD(l0, b_); TRRD(h0, b_ + 2048); TRRD(l1, b_ + 4096); TRRD(h1, b_ + 6144); TRRD(l2, b_ + 8192); TRRD(h2, b_ + 10240); TRRD(l3, b_ + 12288); TRRD(h3, b_ + 14336); \
        asm volatile("s_waitcnt lgkmcnt(0)" ::: "memory"); SBAR();   \
        o[d0] = __builtin_amdgcn_mfma_f32_32x32x16_bf16(pa0, (bf16x8){l0[0], l0[1], l0[2], l0[3], h0[0], h0[1], h0[2], h0[3]}, o[d0], 0, 0, 0);   \
        o[d0] = __builtin_amdgcn_mfma_f32_32x32x16_bf16(pa1, (bf16x8){l1[0], l1[1], l1[2], l1[3], h1[0], h1[1], h1[2], h1[3]}, o[d0], 0, 0, 0);   \
        o[d0] = __builtin_amdgcn_mfma_f32_32x32x16_bf16(pa2, (bf16x8){l2[0], l2[1], l2[2], l2[3], h2[0], h2[1], h2[2], h2[3]}, o[d0], 0, 0, 0);   \
        o[d0] = __builtin_amdgcn_mfma_f32_32x32x16_bf16(pa3, (bf16x8){l3[0], l3[1], l3[2], l3[3], h3[0], h3[1], h3[2], h3[3]}, o[d0], 0, 0, 0); } while (0)
    __builtin_amdgcn_s_setprio(1);
    PV_D0(0); PV_D0(1); PV_D0(2); PV_D0(3);
    __builtin_amdgcn_s_setprio(0);
#undef PV_D0
#undef TRRD
}
struct St { f32x16 o[4]; float m, l; };
struct MaskCmp { int t; __device__ __forceinline__ void operator()(f32x16& p0, f32x16& p1, int tile, int hi) const { const int lim = ((t - 31) >> 4) - 64 * tile; if (!__all(lim >= 63)) mask_lohi(p0, p1, 0, lim, hi); }
    __device__ __forceinline__ bool rowvalid(int) const { return true; } };
struct MaskSel { int tl, qb; unsigned long long sel; __device__ __forceinline__ void operator()(f32x16& p0, f32x16& p1, int tile, int hi) const { if (tile == qb) mask_lohi(p0, p1, 0, tl, hi); }
    __device__ __forceinline__ bool rowvalid(int tile) const { return (sel >> tile) & 1ull; } };
struct MaskWin { int t; __device__ __forceinline__ void operator()(f32x16& p0, f32x16& p1, int tile, int hi) const {
    const int lo = t - 511 - 64 * tile, lim = t - 64 * tile; if (!__all(lo <= 0 && lim >= 63)) mask_lohi(p0, p1, lo, lim, hi); }
    __device__ __forceinline__ bool rowvalid(int) const { return true; } };

template <int BUF, class MaskF>
__device__ __forceinline__ void flash_tile(char* lds, const bf16x8* qr, St& S, int vb0, int r32, int hi, float* al_l, const MaskF& mk, int tile) {
    f32x16 p0, p1; qkt<BUF>(p0, p1, lds + L_K, r32, hi, qr);
    mk(p0, p1, tile, hi);
    const bool rv = mk.rowvalid(tile);
    float mn, alpha; partialSM(p0, p1, S.m, mn, alpha, rv);
    if (__any(alpha < 1.f)) { if (hi == 0) al_l[r32] = alpha; asm volatile("s_waitcnt lgkmcnt(0)" ::: "memory");
#pragma unroll
        for (int d_ = 0; d_ < 4; ++d_)
#pragma unroll
            for (int r = 0; r < 16; ++r) S.o[d_][r] *= al_l[crow(r, hi)]; }
    bf16x8 pa0, pa1, pa2, pa3; finishSM(p0, p1, alpha, S.l, pa0, pa1, pa2, pa3, rv); SBAR();
    pv_tile<BUF>(S.o, vb0, pa0, pa1, pa2, pa3);
}
template <int BUF>
__device__ __forceinline__ void imp_tile(char* lds, const bf16x8* qr, float m, float rl, int r32, int hi, const MaskCmp& mk, int tt, float& carry, float* imp_row) {
    f32x16 p0, p1; qkt<BUF>(p0, p1, lds + L_K, r32, hi, qr);
    mk(p0, p1, tt, hi);
    constexpr float C2 = 1.4426950408889634f * SCALE; const float mnL = -m * C2;
#pragma unroll
    for (int r = 0; r < 16; ++r) { p0[r] = __builtin_amdgcn_exp2f(fmaf(p0[r], C2, mnL)) * rl; p1[r] = __builtin_amdgcn_exp2f(fmaf(p1[r], C2, mnL)) * rl; }
    float G[8], PL[8];
#pragma unroll
    for (int kk = 0; kk < 4; ++kk) { G[kk] = (p0[4 * kk] + p0[4 * kk + 1]) + (p0[4 * kk + 2] + p0[4 * kk + 3]); G[4 + kk] = (p1[4 * kk] + p1[4 * kk + 1]) + (p1[4 * kk + 2] + p1[4 * kk + 3]);
        PL[kk] = __shfl_xor(p0[4 * kk + 3], 32); PL[4 + kk] = __shfl_xor(p1[4 * kk + 3], 32); }
#pragma unroll
    for (int kk = 0; kk < 8; ++kk) { const float prev = hi ? PL[kk] : (kk ? PL[kk > 0 ? kk - 1 : 0] : carry); imp_row[16 * tt + 2 * kk + hi] = G[kk] + prev; }
    carry = PL[7];
}

struct Stage { bf16x8 k0, k1, v0, v1; };
#define ATT_LOAD(St_, Kg_, Vg_, tile_) do { const size_t ro_ = ((size_t)(tile_) * 64 + sr) * 128 + sc; St_.k0 = *(const bf16x8*)((Kg_) + ro_); St_.k1 = *(const bf16x8*)((Kg_) + ro_ + 32 * 128); \
        if (Vg_) { St_.v0 = *(const bf16x8*)((Vg_) + ro_); St_.v1 = *(const bf16x8*)((Vg_) + ro_ + 32 * 128); } } while (0)
#define ATT_WRITE(St_, buf_, hasv_) do { *(bf16x8*)(lds + L_K + (buf_) * SHM_K + kws) = St_.k0; *(bf16x8*)(lds + L_K + (buf_) * SHM_K + kws + 32 * 256) = St_.k1; \
        if (hasv_) { *(bf16x8*)(lds + L_V + (buf_) * SHM_V + vst0) = St_.v0; *(bf16x8*)(lds + L_V + (buf_) * SHM_V + vst1) = St_.v1; } } while (0)

template <class MaskF>
__device__ __forceinline__ void flash_branch(char* lds, const bf16* Kg, const bf16* Vg, int j_lo, int j_hi, const MaskF& mk, const bf16x8* qr, St& S, int vb0, int r32, int hi, float* al_l, int sr, int sc, int kws, int vst0, int vst1) {
    const int n = j_hi - j_lo; Stage sg;
    ATT_LOAD(sg, Kg, Vg, j_lo); ATT_WRITE(sg, 0, true); if (n > 1) ATT_LOAD(sg, Kg, Vg, j_lo + 1);
    __syncthreads();
    for (int t = 0; t < n; t += 2) {
        flash_tile<0>(lds, qr, S, vb0, r32, hi, al_l, mk, j_lo + t);
        if (t + 1 < n) { ATT_WRITE(sg, 1, true); if (t + 2 < n) ATT_LOAD(sg, Kg, Vg, j_lo + t + 2); }
        __syncthreads();
        if (t + 1 < n) {
            flash_tile<1>(lds, qr, S, vb0, r32, hi, al_l, mk, j_lo + t + 1);
            if (t + 2 < n) { ATT_WRITE(sg, 0, true); if (t + 3 < n) ATT_LOAD(sg, Kg, Vg, j_lo + t + 3); }
            __syncthreads();
        }
    }
}
__device__ __forceinline__ void merge_branch(St& S, bf16* accw, float* sc_l, float gate, int r32, int hi, bool first) {
    if (hi == 0) sc_l[r32] = S.l > 0.f ? gate / S.l : 0.f;
    asm volatile("s_waitcnt lgkmcnt(0)" ::: "memory");
#pragma unroll
    for (int r = 0; r < 16; ++r) { const int row = crow(r, hi); const float s = sc_l[row];
#pragma unroll
        for (int d0 = 0; d0 < 4; ++d0) { bf16* a = accw + row * 128 + d0 * 32 + r32; const float v = S.o[d0][r] * s; *a = (bf16)f2bf(first ? v : bf2f(*a) + v); } }
    asm volatile("s_waitcnt lgkmcnt(0)" ::: "memory");
}

__device__ __forceinline__ void attn_unit(char* lds, int b, int g, int qb, const bf16* Qb, const bf16* KCP, const bf16* KV, const float* gates, bf16* AO) {
    int tid = threadIdx.x; asm volatile("" : "+v"(tid));
    const int wid = __builtin_amdgcn_readfirstlane(tid >> 6), lane = tid & 63, r32 = lane & 31, hi = lane >> 5;
    const int hr = wid & 3, qh = wid >> 2, h = 4 * g + hr, ql = qh * 32 + r32, t = 64 * qb + ql;
    const int sr = tid >> 4, sc = (tid & 15) * 8, vst0 = v_st(sr, sc), vst1 = v_st(32 + sr, sc), kws = KSWZ(sr, sc * 2);
    const int vb0 = (int)(uintptr_t)(lds + L_V) + v_rd_base(lane);
    float* wsf = (float*)(lds + L_WS) + wid * 128; float* al_l = wsf; float* sc_l = wsf + 32;
    bf16* accw = (bf16*)(lds + L_ACC) + wid * 32 * 128;
    float* imp4 = (float*)(lds + L_ACC);
    unsigned long long* selm = (unsigned long long*)(lds + L_SELM);
    bf16x8 qr[8];
    { const bf16* qp = Qb + ((size_t)(b * 16 + h) * SEQ + t) * 128 + hi * 8;
#pragma unroll
      for (int d0 = 0; d0 < 8; ++d0) qr[d0] = *(const bf16x8*)(qp + d0 * 16); }
    const float* grow = gates + (size_t)(b * SEQ + t) * 48 + h;
    const float g_cmp = grow[0], g_sel = grow[16], g_win = grow[32];
    const int bg = b * 4 + g;
    St S;
    const bf16* Kc = KCP + (size_t)(0 * 8 + bg) * 256 * 128; const bf16* Vc = KCP + (size_t)(1 * 8 + bg) * 256 * 128;
    const int nt_cmp = (4 * qb + 2) / 64 + 1;
    const MaskCmp mc{t};
#pragma unroll
    for (int d_ = 0; d_ < 4; ++d_) S.o[d_] = f32x16{};
    S.m = -1e30f; S.l = 0.f;
    flash_branch(lds, Kc, Vc, 0, nt_cmp, mc, qr, S, vb0, r32, hi, al_l, sr, sc, kws, vst0, vst1);
    { const float rl = S.l > 0.f ? 1.0f / S.l : 0.f; float carry = 0.f; float* imp_row = imp4 + ((size_t)hr * 64 + ql) * 64; Stage sg; const bf16* nov = nullptr;
      ATT_LOAD(sg, Kc, nov, 0); ATT_WRITE(sg, 0, false); if (nt_cmp > 1) ATT_LOAD(sg, Kc, nov, 1);
      __syncthreads();
      for (int tt = 0; tt < 4; tt += 2) {
          if (tt < nt_cmp) imp_tile<0>(lds, qr, S.m, rl, r32, hi, mc, tt, carry, imp_row);
          else {
#pragma unroll
              for (int kk = 0; kk < 8; ++kk) imp_row[16 * tt + 2 * kk + hi] = 0.f; }
          if (tt + 1 < nt_cmp) { ATT_WRITE(sg, 1, false); if (tt + 2 < nt_cmp) ATT_LOAD(sg, Kc, nov, tt + 2); }
          __syncthreads();
          if (tt + 1 < nt_cmp) imp_tile<1>(lds, qr, S.m, rl, r32, hi, mc, tt + 1, carry, imp_row);
          else {
#pragma unroll
              for (int kk = 0; kk < 8; ++kk) imp_row[16 * (tt + 1) + 2 * kk + hi] = 0.f; }
          if (tt + 2 < nt_cmp) { ATT_WRITE(sg, 0, false); if (tt + 3 < nt_cmp) ATT_LOAD(sg, Kc, nov, tt + 3); }
          __syncthreads();
      } }
    { int j = lane; asm volatile("" : "+v"(j));
      for (int qi = 0; qi < 8; ++qi) { const int q = wid * 8 + qi;
        const float v = ((imp4[(0 * 64 + q) * 64 + j] + imp4[(1 * 64 + q) * 64 + j]) + imp4[(2 * 64 + q) * 64 + j]) + imp4[(3 * 64 + q) * 64 + j];
        const bool visible = j <= qb, forced = (j == 0) || (visible && j > qb - 2);
        unsigned long long sel = __ballot(forced), cand = __ballot(visible && !forced); int need = 16 - __popcll(sel);
        if (__popcll(cand) <= need) sel |= cand;
        else { const unsigned long long key = ((unsigned long long)__float_as_uint(v) << 6) | (unsigned)(63 - j);
            for (int bit = 37; bit >= 0; --bit) { const unsigned long long ones = __ballot(((key >> bit) & 1ull) != 0ull) & cand; const int c = __popcll(ones);
                if (c >= need) cand = ones; else { sel |= ones; need -= c; cand &= ~ones; } }
            sel |= cand; }
        if (lane == 0) selm[q] = sel; } }
    __syncthreads();
    const unsigned long long mysel = selm[ql];
    __syncthreads();
    merge_branch(S, accw, sc_l, g_cmp, r32, hi, true);
    { const bf16* Ks = KV + (size_t)(((0 * 2 + 0) * 2 + b) * 4 + g) * SEQ * 128; const bf16* Vs = KV + (size_t)(((0 * 2 + 1) * 2 + b) * 4 + g) * SEQ * 128;
#pragma unroll
      for (int d_ = 0; d_ < 4; ++d_) S.o[d_] = f32x16{};
      S.m = -1e30f; S.l = 0.f;
      const MaskSel ms{ql, qb, mysel};
      flash_branch(lds, Ks, Vs, 0, qb + 1, ms, qr, S, vb0, r32, hi, al_l, sr, sc, kws, vst0, vst1);
      merge_branch(S, accw, sc_l, g_sel, r32, hi, false); }
    { const bf16* Kw = KV + (size_t)(((1 * 2 + 0) * 2 + b) * 4 + g) * SEQ * 128; const bf16* Vw = KV + (size_t)(((1 * 2 + 1) * 2 + b) * 4 + g) * SEQ * 128;
#pragma unroll
      for (int d_ = 0; d_ < 4; ++d_) S.o[d_] = f32x16{};
      S.m = -1e30f; S.l = 0.f;
      const MaskWin mw{t};
      flash_branch(lds, Kw, Vw, qb >= 8 ? qb - 8 : 0, qb + 1, mw, qr, S, vb0, r32, hi, al_l, sr, sc, kws, vst0, vst1);
      merge_branch(S, accw, sc_l, g_win, r32, hi, false); }
    int lane2 = lane; asm volatile("" : "+v"(lane2));
#pragma unroll
    for (int i = 0; i < 8; ++i) { const int row = i * 4 + (lane2 >> 4), ch = lane2 & 15; const v4u w = *(const v4u*)(accw + row * 128 + ch * 8);
        *(GAS v4u*)(AO + (size_t)(b * SEQ + 64 * qb + qh * 32 + row) * DM + h * 128 + ch * 8) = w; }
    __syncthreads();
}
#undef KSWZ
#undef SBAR
}
__device__ __forceinline__ int next_work(Frame& F, unsigned* counter) {
    volatile LAS int* slot = (volatile LAS int*)(F.lds + LDSCTL_OFF + 64);
    if (F.tid == 0) *slot = (int)__hip_atomic_fetch_add(counter, 1u, __ATOMIC_RELAXED, __HIP_MEMORY_SCOPE_AGENT);
    __syncthreads();
    const int idx = *slot;
    __syncthreads();
    return idx;
}
__device__ __forceinline__ void p4_attention(Frame& F, const P0Args& A) {
    unsigned char* ws = F.ws; unsigned* counter = (unsigned*)(F.ctl + CW_TMO + 32); unsigned* conv = (unsigned*)(F.ctl + CW_TMO + 48); bool conv_left = true;
    for (;;) { const int u = next_work(F, counter); if (u >= 512) break; const int qb = 63 - (u >> 3), b = (u >> 2) & 1, g = u & 3;
        att::attn_unit((char*)F.lds, b, g, qb, (const bf16*)(ws + WS_Q), (const bf16*)(ws + WS_KCP), (const bf16*)(ws + WS_KV), (const float*)(ws + WS_GATES), (bf16*)(ws + WS_AO));
        if (conv_left) { const int c = next_work(F, conv); if (c < N_CONV_CHUNKS) convert_chunk(F, A, c); else if (c < N_CONV_CHUNKS + N_WIN_PIECES) win_copy_piece(F, A, c - N_CONV_CHUNKS); else conv_left = false; } }
    while (conv_left) { const int c = next_work(F, conv); if (c < N_CONV_CHUNKS) convert_chunk(F, A, c); else if (c < N_CONV_CHUNKS + N_WIN_PIECES) win_copy_piece(F, A, c - N_CONV_CHUNKS); else conv_left = false; }
}
struct KRow { const void* p; int f32; };
__device__ __forceinline__ void krow_load8(const KRow& r, int d8, float (&v)[8]) {
    if (r.f32) { const f32x4 a = *((const f32x4*)r.p + 2 * d8), b = *((const f32x4*)r.p + 2 * d8 + 1); v[0] = a[0]; v[1] = a[1]; v[2] = a[2]; v[3] = a[3]; v[4] = b[0]; v[5] = b[1]; v[6] = b[2]; v[7] = b[3]; }
    else { const v4u w = *((const v4u*)r.p + d8); v[0] = bf2f(w.x & 0xffff); v[1] = bf2f(w.x >> 16); v[2] = bf2f(w.y & 0xffff); v[3] = bf2f(w.y >> 16); v[4] = bf2f(w.z & 0xffff); v[5] = bf2f(w.z >> 16); v[6] = bf2f(w.w & 0xffff); v[7] = bf2f(w.w >> 16); }
}
__device__ __forceinline__ f32x2 krow_load2(const KRow& r, int d2) {
    if (r.f32) return *((const f32x2*)r.p + d2);
    const unsigned w = *((const unsigned*)r.p + d2); return (f32x2){bf2f(w & 0xffff), bf2f(w >> 16)};
}
struct VAttnCtx {
    int smp;
    int b, g, t, pos;
    const bf16 *KC, *VC;
    int n_cmp, n_blk;
    const bf16 *Ks, *Vs, *Kw, *Vw;
    const float *cache_sel, *state_win, *out; const int* page_table;
};
__device__ __forceinline__ bool sel_key(const VAttnCtx& C, int blk, int kin, KRow& kr, KRow& vr) {
    const int kpos = blk * 64 + kin; if (kpos > C.pos) return false;
    if (!C.smp) { kr = KRow{C.Ks + (size_t)kpos * 128, 0}; vr = KRow{C.Vs + (size_t)kpos * 128, 0}; return true; }
    if (kpos >= PAST) { const float* r = C.out + O_SELS + (size_t)(C.b * 4 + (kpos - PAST)) * 1024 + C.g * 128; kr = KRow{r, 1}; vr = KRow{r + 512, 1}; return true; }
    const int page = C.page_table[C.b * 128 + (kpos >> 7)]; const float* r = C.cache_sel + ((size_t)page * 128 + (kpos & 127)) * 1024 + C.g * 128; kr = KRow{r, 1}; vr = KRow{r + 512, 1}; return true;
}
__device__ __forceinline__ bool win_key(const VAttnCtx& C, int i, KRow& kr, KRow& vr) {
    if (!C.smp) { const int kpos = C.pos - 511 + i; if (kpos < 0 || kpos > C.pos) return false; kr = KRow{C.Kw + (size_t)kpos * 128, 0}; vr = KRow{C.Vw + (size_t)kpos * 128, 0}; return true; }
    const int kpos = PAST - 512 + i, dlt = C.pos - kpos; if (dlt < 0 || dlt >= 512) return false;
    const float* r = (i < 512) ? C.state_win + ((size_t)C.b * 512 + i) * 1024 + C.g * 128 : C.out + O_WINS + ((size_t)C.b * 512 + 508 + (i - 512)) * 1024 + C.g * 128;
    kr = KRow{r, 1}; vr = KRow{r + 512, 1}; return true;
}
template <int BR>
__device__ __forceinline__ void vattn_branch(const VAttnCtx& C, LAS float* L, int nkeys, const LAS int* sel_idx, float (&oacc)[4][2], float (&lsum)[4]) {
    int tid = threadIdx.x; asm volatile("" : "+v"(tid)); const int lane = tid & 63, wave = tid >> 6;
    LAS float* q = L; LAS float* sc = L + 512; LAS float* red = L + 4864; LAS float* opart = L + 5120;
    float lmax[4] = {-__builtin_inff(), -__builtin_inff(), -__builtin_inff(), -__builtin_inff()};
    for (int k = tid; k < nkeys; k += NTHR) { KRow kr{nullptr, 0}, vr{nullptr, 0}; bool ok;
        if (BR == 0) { ok = (16 * k + 31) <= C.pos; kr = KRow{C.KC + (size_t)k * 128, 0}; }
        else if (BR == 1) ok = sel_key(C, sel_idx[k >> 6], k & 63, kr, vr);
        else ok = win_key(C, k, kr, vr);
        float s[4] = {0.f, 0.f, 0.f, 0.f};
        if (ok) {
            if (kr.f32) { for (int c = 0; c < 2; ++c) { f32x4 v[16];
#pragma unroll
                    for (int u = 0; u < 16; ++u) v[u] = *((const f32x4*)kr.p + c * 16 + u);
#pragma unroll
                    for (int u = 0; u < 16; ++u)
#pragma unroll
                        for (int r = 0; r < 4; ++r) { const f32x4 qq = *(const LAS f32x4*)(q + r * 128 + c * 64 + u * 4); s[r] += (qq[0] * v[u][0] + qq[1] * v[u][1]) + (qq[2] * v[u][2] + qq[3] * v[u][3]); } } }
            else { v4u w[16];
#pragma unroll
                    for (int u = 0; u < 16; ++u) w[u] = *((const v4u*)kr.p + u);
#pragma unroll
                    for (int u = 0; u < 16; ++u) { const float kv[8] = {bf2f(w[u].x & 0xffff), bf2f(w[u].x >> 16), bf2f(w[u].y & 0xffff), bf2f(w[u].y >> 16), bf2f(w[u].z & 0xffff), bf2f(w[u].z >> 16), bf2f(w[u].w & 0xffff), bf2f(w[u].w >> 16)};
#pragma unroll
                        for (int r = 0; r < 4; ++r) { const LAS float* qq = q + r * 128 + u * 8;
#pragma unroll
                            for (int j = 0; j < 8; ++j) s[r] += qq[j] * kv[j]; } } } }
#pragma unroll
        for (int r = 0; r < 4; ++r) { s[r] = ok ? s[r] * 0.08838834764831845f : -__builtin_inff(); sc[k * 4 + r] = s[r]; lmax[r] = fmaxf(lmax[r], s[r]); } }
#pragma unroll
    for (int r = 0; r < 4; ++r) { lmax[r] = wave_max(lmax[r]); if (lane == 0) red[wave * 4 + r] = lmax[r]; }
    __syncthreads();
    float m[4];
#pragma unroll
    for (int r = 0; r < 4; ++r) { float v = red[r]; for (int w = 1; w < 8; ++w) v = fmaxf(v, red[w * 4 + r]); m[r] = v; }
    __syncthreads();
    float ls[4] = {0.f, 0.f, 0.f, 0.f};
    for (int k = tid; k < nkeys; k += NTHR) {
#pragma unroll
        for (int r = 0; r < 4; ++r) { const float s = sc[k * 4 + r]; const float p = (s == -__builtin_inff()) ? 0.f : __expf(s - m[r]); sc[k * 4 + r] = p; ls[r] += p; } }
#pragma unroll
    for (int r = 0; r < 4; ++r) { ls[r] = wave_sum(ls[r]); if (lane == 0) red[wave * 4 + r] = ls[r]; }
    __syncthreads();
#pragma unroll
    for (int r = 0; r < 4; ++r) { float v = 0.f; for (int w = 0; w < 8; ++w) v += red[w * 4 + r]; lsum[r] = v; }
    float o[4][2] = {{0.f, 0.f}, {0.f, 0.f}, {0.f, 0.f}, {0.f, 0.f}};
    for (int k0 = wave; k0 < nkeys; k0 += 256) { f32x2 vv[32];
#pragma unroll
        for (int u = 0; u < 32; ++u) { const int k = k0 + 8 * u; KRow kr{nullptr, 0}, vr{nullptr, 0}; bool ok = k < nkeys; vv[u] = (f32x2){0.f, 0.f};
            if (ok) { if (BR == 0) { ok = (16 * k + 31) <= C.pos; vr = KRow{C.VC + (size_t)k * 128, 0}; } else if (BR == 1) ok = sel_key(C, sel_idx[k >> 6], k & 63, kr, vr); else ok = win_key(C, k, kr, vr); }
            if (ok) vv[u] = krow_load2(vr, lane); }
#pragma unroll
        for (int u = 0; u < 32; ++u) { const int k = k0 + 8 * u; if (k < nkeys) { const f32x4 p = *(const LAS f32x4*)(sc + k * 4);
#pragma unroll
                for (int r = 0; r < 4; ++r) { o[r][0] += p[r] * vv[u][0]; o[r][1] += p[r] * vv[u][1]; } } } }
#pragma unroll
    for (int r = 0; r < 4; ++r) { opart[(wave * 4 + r) * 128 + 2 * lane] = o[r][0]; opart[(wave * 4 + r) * 128 + 2 * lane + 1] = o[r][1]; }
    __syncthreads();
    if (wave == 0) {
#pragma unroll
        for (int r = 0; r < 4; ++r) { float a0 = 0.f, a1 = 0.f; for (int w = 0; w < 8; ++w) { a0 += opart[(w * 4 + r) * 128 + 2 * lane]; a1 += opart[(w * 4 + r) * 128 + 2 * lane + 1]; } oacc[r][0] = a0; oacc[r][1] = a1; } }
    __syncthreads();
}
template <class QF, class EmitF>
__device__ __forceinline__ void vattn_unit(const VAttnCtx& C, LAS float* L, const QF& qf, const float* gates_row, const EmitF& emit) {
    int tid = threadIdx.x; asm volatile("" : "+v"(tid)); const int lane = tid & 63, wave = tid >> 6;
    LAS float* sc = L + 512; LAS float* imp = L + 9216; LAS float* score = L + 10240; LAS int* idx = (LAS int*)(L + 10512);
    L[tid] = qf(tid >> 7, tid & 127);
    __syncthreads();
    float ocmp[4][2], osel[4][2], owin[4][2], lc[4], lsl[4], lw[4];
    vattn_branch<0>(C, L, C.n_cmp, nullptr, ocmp, lc);
    for (int c = tid; c < 1024; c += NTHR) { float v = 0.f; if (c < C.n_cmp) {
#pragma unroll
            for (int r = 0; r < 4; ++r) v += lc[r] > 0.f ? sc[c * 4 + r] / lc[r] : 0.f; } imp[c] = v; }
    __syncthreads();
    const int cur = C.pos >> 6;
    if (tid < C.n_blk) { float v = 0.f; for (int c = 4 * tid - 1; c <= 4 * tid + 3; ++c) if (c >= 0 && c < C.n_cmp) v += imp[c];
        const bool visible = tid <= cur, forced = (tid == 0) || (visible && tid > cur - 2); score[tid] = forced ? 1e9f : (visible ? v : -1e9f); }
    __syncthreads();
    if (tid < C.n_blk) { const float s = score[tid]; int rank = 0; for (int j = 0; j < C.n_blk; ++j) { const float o = score[j]; rank += (o > s || (o == s && j < tid)) ? 1 : 0; } if (rank < 16) idx[rank] = tid; }
    __syncthreads();
    vattn_branch<1>(C, L, 16 * 64, idx, osel, lsl);
    vattn_branch<2>(C, L, C.smp ? 516 : 512, nullptr, owin, lw);
    if (wave == 0) {
#pragma unroll
        for (int r = 0; r < 4; ++r) { const int h = 4 * C.g + r; const float g0 = gates_row[h], g1 = gates_row[16 + h], g2 = gates_row[32 + h];
            const float s0 = lc[r] > 0.f ? g0 / lc[r] : 0.f, s1 = lsl[r] > 0.f ? g1 / lsl[r] : 0.f, s2 = lw[r] > 0.f ? g2 / lw[r] : 0.f;
            emit(r, 2 * lane, ocmp[r][0] * s0 + osel[r][0] * s1 + owin[r][0] * s2); emit(r, 2 * lane + 1, ocmp[r][1] * s0 + osel[r][1] * s1 + owin[r][1] * s2); } }
    __syncthreads();
}

__device__ __forceinline__ void p4_sample_attention(Frame& F, const float* cache_sel, const float* state_win, const int* page_table) {
    unsigned char* ws = F.ws;
    unsigned* counter = (unsigned*)(F.ctl + CW_TMO + 16);
    for (;;) { const int it = next_work(F, counter); if (it >= 128) break; unsigned lb_ = 0; asm volatile("" : "+s"(lb_)); LAS float* L = (LAS float*)(F.lds + RING_OFF + lb_);
        const int b = it >> 4, g = (it >> 2) & 3, t = it & 3, bg = b * 4 + g, sr = b * 4 + t;
        VAttnCtx C{}; C.smp = 1; C.b = b; C.g = g; C.t = t; C.pos = PAST + t; C.KC = (const bf16*)(ws + WS_KCS) + (size_t)(0 * 32 + bg) * 1024 * 128; C.VC = (const bf16*)(ws + WS_KCS) + (size_t)(1 * 32 + bg) * 1024 * 128;
        C.n_cmp = 1023; C.n_blk = 257; C.cache_sel = cache_sel; C.state_win = state_win; C.out = F.out; C.page_table = page_table;
        const float* qs = (const float*)(ws + WS_QS) + (size_t)sr * DM + 4 * g * 128; bf16* ao = (bf16*)(ws + WS_AOS) + (size_t)sr * DM + 4 * g * 128;
        vattn_unit(C, L, [=](int r, int d) { return qs[r * 128 + d]; }, (const float*)(ws + WS_GATES) + (size_t)(MP + sr) * 48, [=](int r, int d, float v) { ao[r * 128 + d] = (bf16)f2bf(v); }); }
}
__device__ __forceinline__ float rstd_of(const float* ssq, int row) { return 1.0f / sqrtf(ssq[row] * (1.f / DM) + 1e-6f); }

template <bool FIRST> struct EpiResid {
    static constexpr bool PERM = false, AFTER_DRAIN = false;
    const float* X; bf16* HB; float* ssq;
    __device__ __forceinline__ void operator()(const pg8::f32x4 (&acc)[2][2][4][2], const pg8::Unit& u, int wr, int wc, int fr_, int fq_) const {
        int fr = fr_, fq = fq_; asm volatile("" : "+v"(fr), "+v"(fq));
        const int col0 = u.pn * 256 + wc * 32 + 4 * fq, row0 = u.pm * 256 + wr * 64 + fr;
        f32x4 xb[2][4]; v2u hb[2][4];
        auto ld = [&](int it, int sset) { const size_t off = (size_t)(row0 + (it >> 2) * 128 + (it & 3) * 16) * DM + col0;
#pragma unroll
            for (int q = 0; q < 4; ++q) { const size_t o = off + (q >> 1) * 128 + (q & 1) * 16;
                if (FIRST) xb[sset][q] = __builtin_nontemporal_load((const GAS f32x4*)(X + o)); else hb[sset][q] = *(const GAS v2u*)(HB + o); } };
        ld(0, 0);
#pragma unroll
        for (int it = 0; it < 8; ++it) { if (it + 1 < 8) ld(it + 1, (it + 1) & 1);
            const int ai = it >> 2, m = it & 3, row = row0 + ai * 128 + m * 16; const size_t off = (size_t)row * DM + col0; float sum = 0.f;
#pragma unroll
            for (int q = 0; q < 4; ++q) { const int bj = q >> 1, n = q & 1; f32x4 h;
                if (FIRST) h = xb[it & 1][q]; else { const v2u w = hb[it & 1][q]; h = (f32x4){bf2f(w.x & 0xffff), bf2f(w.x >> 16), bf2f(w.y & 0xffff), bf2f(w.y >> 16)}; }
                h += acc[ai][bj][m][n]; sum += (h[0] * h[0] + h[1] * h[1]) + (h[2] * h[2] + h[3] * h[3]); *(GAS v2u*)(HB + off + bj * 128 + n * 16) = pk4(h); }
            sum += __shfl_xor(sum, 16); sum += __shfl_xor(sum, 32);
            if (fq == 0) atomicAdd(ssq + row, sum); }
    }
};
constexpr int LDH = DFF + 64;
struct EpiFfn1 {
    static constexpr bool PERM = true, AFTER_DRAIN = false;
    bf16* O; const float* ssq;
    __device__ __forceinline__ void operator()(const pg8::f32x4 (&acc)[2][2][4][2], const pg8::Unit& u, int wr, int wc, int fr, int fq) const {
        const int col0 = u.pn * 256 + wc * 32 + 8 * fq;
        float rs8[8];
#pragma unroll
        for (int it = 0; it < 8; ++it) rs8[it] = rstd_of(ssq, u.pm * 256 + (it >> 2) * 128 + wr * 64 + (it & 3) * 16 + fr);
#pragma unroll
        for (int ai = 0; ai < 2; ++ai)
#pragma unroll
            for (int m = 0; m < 4; ++m) { const int row = u.pm * 256 + ai * 128 + wr * 64 + m * 16 + fr; const float rs = rs8[ai * 4 + m]; bf16* rowp = O + (size_t)row * LDH + col0;
#pragma unroll
                for (int bj = 0; bj < 2; ++bj) { f32x4 v0 = acc[ai][bj][m][0] * rs, v1 = acc[ai][bj][m][1] * rs;
#pragma unroll
                    for (int j = 0; j < 4; ++j) { const float a = fmaxf(v0[j], 0.f), b = fmaxf(v1[j], 0.f); v0[j] = a * a; v1[j] = b * b; }
                    v4u w; w.x = pk2(v0[0], v0[1]); w.y = pk2(v0[2], v0[3]); w.z = pk2(v1[0], v1[1]); w.w = pk2(v1[2], v1[3]); *(GAS v4u*)(rowp + bj * 128) = w; } }
    }
};
__device__ __forceinline__ size_t ft_off(int t, int d) { return ((size_t)(((t >> 5) * 16 + (d >> 4)) * 64 + ((d >> 3) & 1) * 32 + (t & 31))) * 8 + (d & 7); }
__device__ __forceinline__ float siluf_(float x) { return x * __builtin_amdgcn_rcpf(1.0f + __expf(-x)); }
struct EpiRetIn {
    static constexpr bool PERM = true, AFTER_DRAIN = false;
    bf16 *RQ, *RK, *RV, *RG, *RKT; const float* rope; const float* ssq;
    __device__ __forceinline__ void operator()(const pg8::f32x4 (&acc)[2][2][4][2], const pg8::Unit& u, int wr, int wc, int fr_, int fq_) const {
        int fr = fr_, fq = fq_; asm volatile("" : "+v"(fr), "+v"(fq));
        const int pn = u.pn, cw = wc * 32 + 8 * fq;
        float rs8[8];
#pragma unroll
        for (int it = 0; it < 8; ++it) rs8[it] = rstd_of(ssq, u.pm * 256 + (it >> 2) * 128 + wr * 64 + (it & 3) * 16 + fr);
        if (pn < 16) {
            const int h = pn & 7; const float scq = pn < 8 ? 1.0f : 0.0625f; bf16* base = (pn < 8 ? RQ : RK);
            f32x4 cs[2][4];
            auto ldr = [&](int it, int sset) { const int t = (u.pm * 256 + (it >> 2) * 128 + wr * 64 + (it & 3) * 16 + fr) & 4095; const float* rp = rope + ((size_t)t * 128 + cw) * 2;
#pragma unroll
                for (int q = 0; q < 4; ++q) cs[sset][q] = *(const GAS f32x4*)(rp + 4 * q); };
            ldr(0, 0);
#pragma unroll
            for (int it = 0; it < 8; ++it) { if (it + 1 < 8) ldr(it + 1, (it + 1) & 1);
                const int ai = it >> 2, m = it & 3, row = u.pm * 256 + ai * 128 + wr * 64 + m * 16 + fr, b = row >> 12, t = row & 4095; const float sc = rs8[it] * scq;
                bf16* dst = base + (size_t)(b * 8 + h) * SEQ * 256; v4u w1, w2;
#pragma unroll
                for (int n = 0; n < 2; ++n) { const f32x4 csA = cs[it & 1][2 * n], csB = cs[it & 1][2 * n + 1];
                    f32x4 o1, o2; rope4(acc[ai][0][m][n] * sc, acc[ai][1][m][n] * sc, csA, csB, o1, o2);
                    if (n == 0) { w1.x = pk2(o1[0], o1[1]); w1.y = pk2(o1[2], o1[3]); w2.x = pk2(o2[0], o2[1]); w2.y = pk2(o2[2], o2[3]); } else { w1.z = pk2(o1[0], o1[1]); w1.w = pk2(o1[2], o1[3]); w2.z = pk2(o2[0], o2[1]); w2.w = pk2(o2[2], o2[3]); } }
                *(GAS v4u*)(dst + ft_off(t, cw)) = w1; *(GAS v4u*)(dst + ft_off(t, cw + 128)) = w2; }
        } else if (pn < 32) {
            const int h = (pn - 16) >> 1, c0 = ((pn - 16) & 1) * 256 + cw;
#pragma unroll
            for (int ai = 0; ai < 2; ++ai)
#pragma unroll
                for (int m = 0; m < 4; ++m) { const int row = u.pm * 256 + ai * 128 + wr * 64 + m * 16 + fr, b = row >> 12, t = row & 4095; const float rs = rs8[ai * 4 + m];
                    bf16* dst = RV + ((size_t)(b * 8 + h) * SEQ + t) * 512 + c0;
#pragma unroll
                    for (int bj = 0; bj < 2; ++bj) { const f32x4 v0 = acc[ai][bj][m][0] * rs, v1 = acc[ai][bj][m][1] * rs; v4u w; w.x = pk2(v0[0], v0[1]); w.y = pk2(v0[2], v0[3]); w.z = pk2(v1[0], v1[1]); w.w = pk2(v1[2], v1[3]); *(GAS v4u*)(dst + bj * 128) = w; } }
        } else {
#pragma unroll
            for (int ai = 0; ai < 2; ++ai)
#pragma unroll
                for (int m = 0; m < 4; ++m) { const int row = u.pm * 256 + ai * 128 + wr * 64 + m * 16 + fr; const float rs = rs8[ai * 4 + m];
                    bf16* dst = RG + (size_t)row * 4096 + (pn - 32) * 256 + cw;
#pragma unroll
                    for (int bj = 0; bj < 2; ++bj) { const f32x4 v0 = acc[ai][bj][m][0] * rs, v1 = acc[ai][bj][m][1] * rs; v4u w; w.x = pk2(siluf_(v0[0]), siluf_(v0[1])); w.y = pk2(siluf_(v0[2]), siluf_(v0[3])); w.z = pk2(siluf_(v1[0]), siluf_(v1[1])); w.w = pk2(siluf_(v1[2]), siluf_(v1[3])); *(GAS v4u*)(dst + bj * 128) = w; } }
        }
    }
};

constexpr int CW_PANEL = 8192;
__device__ __forceinline__ float ld_ssq(const float* p) { return __uint_as_float(__hip_atomic_load((const unsigned*)p, __ATOMIC_RELAXED, __HIP_MEMORY_SCOPE_AGENT)); }
struct EpiFinal {
    static constexpr bool PERM = false, AFTER_DRAIN = true;
    const bf16* HB; float* ssq; unsigned* cnt; const float* gfin; float* y;
    __device__ __forceinline__ void fused(pg8::f32x4 (&acc)[2][2][4][2], const pg8::Unit& u, int wr, int wc, int fr_, int fq_, PG8_LAS unsigned char* lds, int wid, int lane) const {
        int fr = fr_, fq = fq_; asm volatile("" : "+v"(fr), "+v"(fq));
        const int col0 = u.pn * 256 + wc * 32 + 4 * fq, row0 = u.pm * 256 + wr * 64 + fr;
        { v2u hb[2][4];
          auto ld = [&](int it, int sset) { const size_t off = (size_t)(row0 + (it >> 2) * 128 + (it & 3) * 16) * DM + col0;
#pragma unroll
              for (int q = 0; q < 4; ++q) hb[sset][q] = *(const GAS v2u*)(HB + off + (q >> 1) * 128 + (q & 1) * 16); };
          ld(0, 0);
#pragma unroll
          for (int it = 0; it < 8; ++it) { if (it + 1 < 8) ld(it + 1, (it + 1) & 1);
              const int ai = it >> 2, m = it & 3, row = row0 + ai * 128 + m * 16; float sum = 0.f;
#pragma unroll
              for (int q = 0; q < 4; ++q) { const int bj = q >> 1, n = q & 1; const v2u w = hb[it & 1][q]; f32x4 h = (f32x4){bf2f(w.x & 0xffff), bf2f(w.x >> 16), bf2f(w.y & 0xffff), bf2f(w.y >> 16)};
                  h += acc[ai][bj][m][n]; acc[ai][bj][m][n] = h; sum += (h[0] * h[0] + h[1] * h[1]) + (h[2] * h[2] + h[3] * h[3]); }
              sum += __shfl_xor(sum, 16); sum += __shfl_xor(sum, 32);
              if (fq == 0) atomicAdd(ssq + row, sum); } }
        asm volatile("s_waitcnt vmcnt(0)" ::: "memory");
        __syncthreads();
        unsigned* c = cnt + 64 * u.pm;
        if (wid == 0) { if (lane == 0) __hip_atomic_fetch_add(c, 1u, __ATOMIC_RELAXED, __HIP_MEMORY_SCOPE_AGENT);
            unsigned sp = 0; while ((unsigned)__builtin_amdgcn_readfirstlane((int)__hip_atomic_load(c, __ATOMIC_RELAXED, __HIP_MEMORY_SCOPE_AGENT)) < 8u) { __builtin_amdgcn_s_sleep(2); if (++sp > (1u << 20)) break; }
            __builtin_amdgcn_fence(__ATOMIC_ACQUIRE, "agent"); }
        asm volatile("s_waitcnt vmcnt(0) lgkmcnt(0)" ::: "memory");
        __syncthreads();
        float rs8[8]; f32x4 g4[4];
#pragma unroll
        for (int it = 0; it < 8; ++it) rs8[it] = ld_ssq(ssq + row0 + (it >> 2) * 128 + (it & 3) * 16);
#pragma unroll
        for (int q = 0; q < 4; ++q) g4[q] = *(const GAS f32x4*)(gfin + col0 + (q >> 1) * 128 + (q & 1) * 16);
#pragma unroll
        for (int it = 0; it < 8; ++it) rs8[it] = 1.0f / sqrtf(rs8[it] * (1.f / DM) + 1e-6f);
#pragma unroll
        for (int ai = 0; ai < 2; ++ai)
#pragma unroll
            for (int m = 0; m < 4; ++m) { const int row = row0 + ai * 128 + m * 16; const size_t off = (size_t)row * DM + col0; const float rs = rs8[ai * 4 + m];
#pragma unroll
                for (int q = 0; q < 4; ++q) { const int bj = q >> 1, n = q & 1; __builtin_nontemporal_store(acc[ai][bj][m][n] * rs * g4[q], (GAS f32x4*)(y + off + bj * 128 + n * 16)); } }
    }
};
__device__ __forceinline__ void skinny_final(Frame& F, const bf16* A, const bf16* Wt, int K, const float* Hin, float* ssq_s, unsigned* cnt, const float* gfin, float* ys) {
    const int lane = F.lane, r16 = lane & 15, q4 = lane >> 4;
    LAS float* red = (LAS float*)(F.lds + RING_OFF);
    for (int sl = blockIdx.x; sl < DM / 32; sl += F.G) { f32x4 acc[2][2]; skinny_mma_wg(red, A, Wt, K, 32 * sl, F.wave, lane, acc);
        if (F.wave != 0) continue;
#pragma unroll
        for (int rh = 0; rh < 2; ++rh) { const int sr = rh * 16 + r16; float s = 0.f;
#pragma unroll
            for (int cs = 0; cs < 2; ++cs) { const int col = 32 * sl + cs * 16 + 4 * q4; const f32x4 h = *(const f32x4*)(Hin + (size_t)sr * DM + col) + acc[rh][cs]; acc[rh][cs] = h; s += (h[0] * h[0] + h[1] * h[1]) + (h[2] * h[2] + h[3] * h[3]); }
            s += __shfl_xor(s, 16); s += __shfl_xor(s, 32);
            if (q4 == 0) atomicAdd(ssq_s + sr, s); }
        asm volatile("s_waitcnt vmcnt(0)" ::: "memory");
        if (lane == 0) __hip_atomic_fetch_add(cnt, 1u, __ATOMIC_RELAXED, __HIP_MEMORY_SCOPE_AGENT);
        { unsigned sp = 0; while ((unsigned)__builtin_amdgcn_readfirstlane((int)__hip_atomic_load(cnt, __ATOMIC_RELAXED, __HIP_MEMORY_SCOPE_AGENT)) < (unsigned)(DM / 32)) { __builtin_amdgcn_s_sleep(2); if (++sp > (1u << 20)) break; } }
        __builtin_amdgcn_fence(__ATOMIC_ACQUIRE, "agent");
#pragma unroll
        for (int rh = 0; rh < 2; ++rh) { const int sr = rh * 16 + r16; const float rs = 1.0f / sqrtf(ld_ssq(ssq_s + sr) * (1.f / DM) + 1e-6f);
#pragma unroll
            for (int cs = 0; cs < 2; ++cs) { const int col = 32 * sl + cs * 16 + 4 * q4; *(f32x4*)(ys + (size_t)sr * DM + col) = acc[rh][cs] * rs * *(const f32x4*)(gfin + col); } } }
}
__device__ __forceinline__ void skinny_resid(Frame& F, const bf16* A, const bf16* Wt, int K, const float* Hin, float* H, bf16* XNs, float* ssq_s) {
    const int lane = F.lane, r16 = lane & 15, q4 = lane >> 4;
    LAS float* red = (LAS float*)(F.lds + RING_OFF);
    for (int sl = blockIdx.x; sl < DM / 32; sl += F.G) { f32x4 acc[2][2]; skinny_mma_wg(red, A, Wt, K, 32 * sl, F.wave, lane, acc);
        if (F.wave != 0) continue;
#pragma unroll
        for (int rh = 0; rh < 2; ++rh) { const int sr = rh * 16 + r16; float s = 0.f;
#pragma unroll
            for (int cs = 0; cs < 2; ++cs) { const int col = 32 * sl + cs * 16 + 4 * q4; const size_t off = (size_t)sr * DM + col; const f32x4 h = *(const f32x4*)(Hin + off) + acc[rh][cs]; *(f32x4*)(H + off) = h;
                s += (h[0] * h[0] + h[1] * h[1]) + (h[2] * h[2] + h[3] * h[3]); *(v2u*)(XNs + off) = pk4(h); }
            s += __shfl_xor(s, 16); s += __shfl_xor(s, 32);
            if (q4 == 0) atomicAdd(ssq_s + sr, s); } }
}
__device__ __forceinline__ void skinny_ffn1(Frame& F, const bf16* A, const bf16* Wt, bf16* HFFs, const float* ssq_s) {
    const int lane = F.lane, r16 = lane & 15, q4 = lane >> 4;
    LAS float* red = (LAS float*)(F.lds + RING_OFF);
    for (int sl = blockIdx.x; sl < DFF / 32; sl += F.G) { f32x4 acc[2][2]; skinny_mma_wg(red, A, Wt, DM, 32 * sl, F.wave, lane, acc);
        if (F.wave != 0) continue;
#pragma unroll
        for (int rh = 0; rh < 2; ++rh) { const int sr = rh * 16 + r16; const float rs = rstd_of(ssq_s, sr);
#pragma unroll
            for (int cs = 0; cs < 2; ++cs) { f32x4 v = acc[rh][cs] * rs;
#pragma unroll
                for (int j = 0; j < 4; ++j) { const float a = fmaxf(v[j], 0.f); v[j] = a * a; }
                *(v2u*)(HFFs + (size_t)sr * DFF + 32 * sl + cs * 16 + 4 * q4) = pk4(v); } } }
}
__device__ __forceinline__ void skinny_retin(Frame& F, const bf16* A, const bf16* Wt, const float* rope, const float* ssq_s, float* RSQ, float* RSK, float* RSV, float* RSG) {
    const int lane = F.lane, r16 = lane & 15, q4 = lane >> 4;
    LAS float* red = (LAS float*)(F.lds + RING_OFF);
    const int nsl = (F.G == 256) ? (((int)blockIdx.x < 64) ? 1 : (((int)blockIdx.x < 128) ? 2 : 1)) : 0;
    for (int k = 0; (F.G == 256) ? (k < nsl) : ((int)blockIdx.x + k * F.G < 64 + 256); ++k) {
        const int task = (F.G == 256) ? (((int)blockIdx.x < 64) ? (int)blockIdx.x : 64 + ((int)blockIdx.x - 64) + 192 * k) : (int)blockIdx.x + k * F.G;
        if (task < 64) { const int hh = task >> 2, wc = task & 3; f32x4 a1[2][2], a2[2][2]; skinny_mma_wg(red, A, Wt, DM, hh * 256 + wc * 32, F.wave, lane, a1); skinny_mma_wg(red, A, Wt, DM, hh * 256 + 128 + wc * 32, F.wave, lane, a2);
            if (F.wave != 0) continue;
#pragma unroll
            for (int rh = 0; rh < 2; ++rh) { const int sr = rh * 16 + r16, t = sr & 3; const float rs = rstd_of(ssq_s, sr) * (hh < 8 ? 1.f : 0.0625f); float* dst = (hh < 8 ? RSQ : RSK) + (size_t)sr * 2048 + (hh & 7) * 256;
#pragma unroll
                for (int cs = 0; cs < 2; ++cs) { const int d = wc * 32 + cs * 16 + 4 * q4; const f32x4 csA = *(const f32x4*)(rope + ((size_t)(4096 + t) * 128 + d) * 2), csB = *(const f32x4*)(rope + ((size_t)(4096 + t) * 128 + d) * 2 + 4);
                    f32x4 o1, o2; rope4(a1[rh][cs] * rs, a2[rh][cs] * rs, csA, csB, o1, o2); *(f32x4*)(dst + d) = o1; *(f32x4*)(dst + 128 + d) = o2; } } }
        else { const int sl = task - 64, col0 = 4096 + 32 * sl; f32x4 acc[2][2]; skinny_mma_wg(red, A, Wt, DM, col0, F.wave, lane, acc);
            if (F.wave != 0) continue;
#pragma unroll
            for (int rh = 0; rh < 2; ++rh) { const int sr = rh * 16 + r16; const float rs = rstd_of(ssq_s, sr);
#pragma unroll
                for (int cs = 0; cs < 2; ++cs) { const int c = 32 * sl + cs * 16 + 4 * q4; f32x4 v = acc[rh][cs] * rs;
                    if (c < 4096) *(f32x4*)(RSV + (size_t)sr * 4096 + c) = v; else *(f32x4*)(RSG + (size_t)sr * 4096 + (c - 4096)) = (f32x4){siluf_(v[0]), siluf_(v[1]), siluf_(v[2]), siluf_(v[3])}; } } }
    }
}
namespace ret {
typedef float f32x16 __attribute__((ext_vector_type(16)));
__device__ __forceinline__ float log2_gamma(int h) { return log2f(1.0f - exp2f(-5.0f - (float)h)); }
__device__ __forceinline__ int crow(int r, int hi) { return (r & 3) + 8 * (r >> 2) + 4 * hi; }
__device__ __forceinline__ void r1_unit(int bh, int c, const bf16* RQ, const bf16* RK, bf16* RS, bf16* RKT, int wid, int lane) {
    const int r32 = lane & 31, hi = lane >> 5, h = bh & 7, ib = wid >> 1; const float l2g = log2_gamma(h);
    { const int jb = wid >> 1, j = jb * 32 + r32; const float kdf = exp2f((float)(127 - j) * l2g); bf16* img = RKT + ((size_t)bh * 32 + c) * 256 * 128;
      const bf16* kf = RK + (size_t)bh * SEQ * 256 + ((size_t)((c * 4 + jb) * 16 + (wid & 1) * 8) * 64 + lane) * 8; bf16x8 fr8[8];
#pragma unroll
      for (int kq = 0; kq < 8; ++kq) fr8[kq] = *(const bf16x8*)(kf + kq * 512);
#pragma unroll
      for (int kq = 0; kq < 8; ++kq)
#pragma unroll
          for (int x = 0; x < 8; ++x) { const int d = ((wid & 1) * 8 + kq) * 16 + hi * 8 + x; img[d * 128 + (j ^ (x << 3))] = (bf16)f2bf(bf2f((unsigned short)fr8[kq][x]) * kdf); } }
    const bf16* qp = RQ + (size_t)bh * SEQ * 256 + ((size_t)((c * 4 + ib) * 16) * 64 + lane) * 8;
    bf16* sp = RS + ((size_t)bh * 32 + c) * 128 * 128;
#pragma unroll
    for (int jj = 0; jj < 2; ++jj) { const int jb = 2 * (wid & 1) + jj;
        if (jb > ib) {
#pragma unroll
            for (int r = 0; r < 16; ++r) { const int j = jb * 32 + r32; sp[((ib * 8 + (j >> 4)) * 64 + ((j >> 3) & 1) * 32 + crow(r, hi)) * 8 + (j & 7)] = 0; }
            continue; }
        const bf16* kp = RK + (size_t)bh * SEQ * 256 + ((size_t)((c * 4 + jb) * 16) * 64 + lane) * 8;
        f32x16 acc = f32x16{};
#pragma unroll
        for (int kk = 0; kk < 16; ++kk) { const bf16x8 a = *(const bf16x8*)(qp + kk * 512), b = *(const bf16x8*)(kp + kk * 512); acc = __builtin_amdgcn_mfma_f32_32x32x16_bf16(a, b, acc, 0, 0, 0); }
#pragma unroll
        for (int r = 0; r < 16; ++r) { const int i = ib * 32 + crow(r, hi), j = jb * 32 + r32; const float v = (i >= j) ? acc[r] * exp2f((float)(i - j) * l2g) : 0.f; sp[((ib * 8 + (j >> 4)) * 64 + ((j >> 3) & 1) * 32 + crow(r, hi)) * 8 + (j & 7)] = (bf16)f2bf(v); }
    }
}
constexpr int VT_LD = 136, ST_LD = 264, L_KT = 0  , L_VT = 65536, L_ST = 74240, L_XC = 91136;
__device__ __forceinline__ void r2_unit(char* lds, int bh, int es, const bf16* RQ, const bf16* RKT, const bf16* RV, const bf16* RS, bf16* RO, float* out_state) {
    int tid = threadIdx.x; asm volatile("" : "+v"(tid));
    const int wid = __builtin_amdgcn_readfirstlane(tid >> 6), lane = tid & 63, r32 = lane & 31, hi = lane >> 5, h = bh & 7, b = bh >> 3;
    const float l2g = log2_gamma(h), gC = exp2f(128.f * l2g);
    char* KT = lds + L_KT; bf16* VT = (bf16*)(lds + L_VT); bf16* ST = (bf16*)(lds + L_ST); float* XC = (float*)(lds + L_XC);
    f32x16 accS = f32x16{};
    for (int i = tid; i < 32 * ST_LD / 2; i += NTHR) ((unsigned*)ST)[i] = 0u;
    const int jq = tid & 31, dg = tid >> 5;
    const int ib = wid & 3;
    v4u kreg[8], vreg[4]; bf16x8 pf[16];
#define R2_LOADKV(c_) do { const bf16* ki_ = RKT + ((size_t)bh * 32 + (c_)) * 256 * 128; const size_t t0_ = (size_t)bh * SEQ + (c_) * 128 + 4 * jq; \
        _Pragma("unroll") for (int i = 0; i < 8; ++i) kreg[i] = *(const v4u*)(ki_ + (size_t)(tid + 512 * i) * 8); \
        if (tid < 128) { _Pragma("unroll") for (int tk = 0; tk < 4; ++tk) vreg[tk] = *(const v4u*)(RV + (t0_ + tk) * 512 + es * 32 + dg * 8); } } while (0)
#define R2_LOADPF(c_) do { if (wid < 4) { const bf16* sr_ = RS + ((size_t)bh * 32 + (c_)) * 128 * 128 + ((size_t)(ib * 8) * 64 + lane) * 8; _Pragma("unroll") for (int kk = 0; kk < 8; ++kk) pf[kk] = *(const bf16x8*)(sr_ + kk * 512); } \
        else { const bf16* qr_ = RQ + (size_t)bh * SEQ * 256 + ((size_t)(((c_) * 4 + ib) * 16) * 64 + lane) * 8; _Pragma("unroll") for (int kk = 0; kk < 16; ++kk) pf[kk] = *(const bf16x8*)(qr_ + kk * 512); } } while (0)
    R2_LOADKV(0); R2_LOADPF(0);
    for (int c = 0; c < 32; ++c) {
#pragma unroll
        for (int i = 0; i < 8; ++i) *(v4u*)(KT + (size_t)(tid + 512 * i) * 16) = kreg[i];
        if (tid < 128) {
#pragma unroll
            for (int x2 = 0; x2 < 4; ++x2) { const unsigned w0 = ((const unsigned*)&vreg[0])[x2], w1 = ((const unsigned*)&vreg[1])[x2], w2 = ((const unsigned*)&vreg[2])[x2], w3 = ((const unsigned*)&vreg[3])[x2];
                v2u lo, hh; lo.x = (w0 & 0xffff) | (w1 << 16); lo.y = (w2 & 0xffff) | (w3 << 16); hh.x = (w0 >> 16) | (w1 & 0xffff0000u); hh.y = (w2 >> 16) | (w3 & 0xffff0000u);
                *(v2u*)(VT + (dg * 8 + 2 * x2) * VT_LD + 4 * jq) = lo; *(v2u*)(VT + (dg * 8 + 2 * x2 + 1) * VT_LD + 4 * jq) = hh; } }
        __syncthreads();
        const int cn = c < 31 ? c + 1 : 31;
        f32x16 aO = f32x16{};
        if (wid < 4) {
#pragma unroll
            for (int kk = 0; kk < 8; ++kk) if (kk < 2 * (ib + 1)) { const bf16x8 bb = *(const bf16x8*)(VT + r32 * VT_LD + kk * 16 + hi * 8); aO = __builtin_amdgcn_mfma_f32_32x32x16_bf16(pf[kk], bb, aO, 0, 0, 0); }
        } else {
#pragma unroll
            for (int kk = 0; kk < 16; ++kk) { const bf16x8 bb = *(const bf16x8*)(ST + r32 * ST_LD + kk * 16 + hi * 8); aO = __builtin_amdgcn_mfma_f32_32x32x16_bf16(pf[kk], bb, aO, 0, 0, 0); }
#pragma unroll
            for (int r = 0; r < 16; ++r) aO[r] *= exp2f((float)(ib * 32 + crow(r, hi) + 1) * l2g);
            f32x4* xp = (f32x4*)(XC + (ib * 64 + lane) * 16);
            xp[0] = (f32x4){aO[0], aO[1], aO[2], aO[3]}; xp[1] = (f32x4){aO[4], aO[5], aO[6], aO[7]}; xp[2] = (f32x4){aO[8], aO[9], aO[10], aO[11]}; xp[3] = (f32x4){aO[12], aO[13], aO[14], aO[15]};
        }
        R2_LOADPF(cn);
        R2_LOADKV(cn);
#pragma unroll
        for (int r = 0; r < 16; ++r) accS[r] *= gC;
#pragma unroll
        for (int kk = 0; kk < 8; ++kk) { const bf16x8 a = *(const bf16x8*)(VT + r32 * VT_LD + kk * 16 + hi * 8), bb = *(const bf16x8*)(KT + (wid * 32 + r32) * 256 + (((kk * 16 + hi * 8) * 2) ^ ((r32 & 7) << 4))); accS = __builtin_amdgcn_mfma_f32_32x32x16_bf16(a, bb, accS, 0, 0, 0); }
        __syncthreads();
#pragma unroll
        for (int r = 0; r < 16; ++r) ST[crow(r, hi) * ST_LD + wid * 32 + r32] = (bf16)f2bf(accS[r]);
        if (wid < 4) { const f32x4* xp = (const f32x4*)(XC + (ib * 64 + lane) * 16); const f32x4 x0 = xp[0], x1 = xp[1], x2 = xp[2], x3 = xp[3];
            const float xc[16] = {x0[0], x0[1], x0[2], x0[3], x1[0], x1[1], x1[2], x1[3], x2[0], x2[1], x2[2], x2[3], x3[0], x3[1], x3[2], x3[3]};
#pragma unroll
            for (int r = 0; r < 16; ++r) RO[((size_t)b * SEQ + c * 128 + ib * 32 + crow(r, hi)) * 4096 + h * 512 + es * 32 + r32] = (bf16)f2bf(aO[r] + xc[r]); }
    }
#undef R2_LOADKV
#undef R2_LOADPF
#pragma unroll
    for (int r = 0; r < 16; ++r) out_state[(((size_t)bh) * 256 + wid * 32 + r32) * 512 + es * 32 + crow(r, hi)] = accS[r];
    __syncthreads();
}
}
__device__ __forceinline__ void p_ret_s(Frame& F) {
    unsigned char* ws = F.ws;
    for (int it = blockIdx.x; it < 512; it += F.G) ret::r1_unit(it >> 5, it & 31, (const bf16*)(ws + WS_RQ), (const bf16*)(ws + WS_RK), (bf16*)(ws + WS_RS), (bf16*)(ws + WS_RKT), F.wave, F.lane);
}
__device__ __forceinline__ void p_ret_scan(Frame& F) {
    unsigned char* ws = F.ws;
    for (int i = blockIdx.x; i < 256; i += F.G) { const int it = ((i & 7) + 8 * (i >> 7)) * 16 + ((i >> 3) & 15); ret::r2_unit((char*)F.lds, it >> 4, it & 15, (const bf16*)(ws + WS_RQ), (const bf16*)(ws + WS_RKT), (const bf16*)(ws + WS_RV), (const bf16*)(ws + WS_RS), (bf16*)(ws + WS_RO), F.out + O_RETP); }
}
__device__ __forceinline__ void p_ret_sample(Frame& F, const float* state_in, const float* RSQ, const float* RSK, const float* RSV, float* ROS) {
    LAS float* L = (LAS float*)(F.lds + RING_OFF);
    const int tid = F.tid;
    for (int it = blockIdx.x; it < 256; it += F.G) { const int bh = it >> 2, eq = it & 3, b = bh >> 3, h = bh & 7; const float l2g = ret::log2_gamma(h);
        for (int i = tid; i < 2048; i += NTHR) { const int isk = i >> 10, tk = (i >> 8) & 3, d = i & 255; L[i] = (isk ? RSK : RSQ)[(size_t)(b * 4 + tk) * 2048 + h * 256 + d]; }
        __syncthreads();
        if (tid < 16) { const int i = tid >> 2, j = tid & 3; float s = 0.f; if (i >= j) { for (int d = 0; d < 256; ++d) s += L[i * 256 + d] * L[1024 + j * 256 + d]; s *= exp2f((float)(i - j) * l2g); } L[2048 + tid] = s; }
        __syncthreads();
        const int e = eq * 128 + (tid & 127), dg = tid >> 7;
        float v[4], kd[4]; for (int j = 0; j < 4; ++j) { v[j] = RSV[(size_t)(b * 4 + j) * 4096 + h * 512 + e]; kd[j] = exp2f((float)(3 - j) * l2g); }
        const float g4 = exp2f(4.f * l2g); float cr[4] = {0.f, 0.f, 0.f, 0.f};
        for (int d0 = dg * 64; d0 < dg * 64 + 64; d0 += 16) { float stv[16];
#pragma unroll
            for (int u = 0; u < 16; ++u) stv[u] = __builtin_nontemporal_load(state_in + ((size_t)bh * 256 + d0 + u) * 512 + e);
#pragma unroll
            for (int u = 0; u < 16; ++u) { const int d = d0 + u; const float st = stv[u]; float ns = g4 * st;
#pragma unroll
                for (int j = 0; j < 4; ++j) { cr[j] += L[j * 256 + d] * st; ns += L[1024 + j * 256 + d] * kd[j] * v[j]; }
                F.out[O_RETS + ((size_t)bh * 256 + d) * 512 + e] = ns; } }
#pragma unroll
        for (int i = 0; i < 4; ++i) L[2112 + (dg * 4 + i) * 128 + (tid & 127)] = cr[i];
        __syncthreads();
        if (tid < 128) {
#pragma unroll
            for (int i = 0; i < 4; ++i) { float c = 0.f; for (int g = 0; g < 4; ++g) c += L[2112 + (g * 4 + i) * 128 + tid]; float inner = 0.f; for (int j = 0; j <= i; ++j) inner += L[2048 + i * 4 + j] * v[j];
                ROS[(size_t)(b * 4 + i) * 4096 + h * 512 + e] = inner + c * exp2f((float)(i + 1) * l2g); } }
        __syncthreads();
    }
}
__device__ __forceinline__ void p_ret_gn(Frame& F, const float* gn, const float* ROS, const float* RSG) {
    unsigned char* ws = F.ws; const int lane = F.lane;
    for (int it4 = F.gw; it4 < MP * 2; it4 += F.NGW) { v4u wo[4], wg[4];
#pragma unroll
        for (int u = 0; u < 4; ++u) { const int it = it4 * 4 + u, row = it >> 3, h = it & 7; wo[u] = __builtin_nontemporal_load((const v4u*)((const bf16*)(ws + WS_RO) + (size_t)row * 4096 + h * 512 + lane * 8)); wg[u] = __builtin_nontemporal_load((const v4u*)((const bf16*)(ws + WS_RG) + (size_t)row * 4096 + h * 512 + lane * 8)); }
#pragma unroll
        for (int u = 0; u < 4; ++u) { const int it = it4 * 4 + u, row = it >> 3, h = it & 7; float o[8], g[8];
            const unsigned a[4] = {wo[u].x, wo[u].y, wo[u].z, wo[u].w}, c[4] = {wg[u].x, wg[u].y, wg[u].z, wg[u].w};
#pragma unroll
            for (int x = 0; x < 4; ++x) { o[2 * x] = bf2f(a[x] & 0xffff); o[2 * x + 1] = bf2f(a[x] >> 16); g[2 * x] = bf2f(c[x] & 0xffff); g[2 * x + 1] = bf2f(c[x] >> 16); }
            float s = 0.f;
#pragma unroll
            for (int x = 0; x < 8; ++x) s += o[x];
            const float mu = wave_sum(s) * (1.f / 512.f); float q = 0.f;
#pragma unroll
            for (int x = 0; x < 8; ++x) { o[x] -= mu; q += o[x] * o[x]; }
            const float rs = 1.0f / sqrtf(wave_sum(q) * (1.f / 512.f) + 1e-5f); const float* gw = gn + h * 512 + lane * 8;
            v4u w; float y[8];
#pragma unroll
            for (int x = 0; x < 8; ++x) y[x] = g[x] * (o[x] * rs * gw[x]);
            w.x = pk2(y[0], y[1]); w.y = pk2(y[2], y[3]); w.z = pk2(y[4], y[5]); w.w = pk2(y[6], y[7]);
            *(v4u*)((bf16*)(ws + WS_RGA) + (size_t)row * 4096 + h * 512 + lane * 8) = w; } }
    for (int it = F.gw; it < NS * 8; it += F.NGW) { const int row = MP + (it >> 3), h = it & 7; float o[8], g[8];
        { const float* po = ROS + (size_t)(row - MP) * 4096 + h * 512 + lane * 8; const float* pg = RSG + (size_t)(row - MP) * 4096 + h * 512 + lane * 8;
#pragma unroll
            for (int x = 0; x < 8; ++x) { o[x] = po[x]; g[x] = pg[x]; } }
        float s = 0.f;
#pragma unroll
        for (int x = 0; x < 8; ++x) s += o[x];
        const float mu = wave_sum(s) * (1.f / 512.f); float q = 0.f;
#pragma unroll
        for (int x = 0; x < 8; ++x) { o[x] -= mu; q += o[x] * o[x]; }
        const float rs = 1.0f / sqrtf(wave_sum(q) * (1.f / 512.f) + 1e-5f); const float* gw = gn + h * 512 + lane * 8;
        v4u w; float y[8];
#pragma unroll
        for (int x = 0; x < 8; ++x) y[x] = g[x] * (o[x] * rs * gw[x]);
        w.x = pk2(y[0], y[1]); w.y = pk2(y[2], y[3]); w.z = pk2(y[4], y[5]); w.w = pk2(y[6], y[7]);
        *(v4u*)((bf16*)(ws + WS_XS) + (size_t)(row - MP) * 4096 + h * 512 + lane * 8) = w; }
}
__device__ __forceinline__ void p_final_norm(Frame& F, const bf16* HB, const float* HS, const float* g, unsigned skip0, unsigned skip1) {
    const int lane = F.lane;
    for (int m = F.gw; m < MP + NS; m += F.NGW) { const float* xr = HS + (size_t)(m < MP ? 0 : m - MP) * DM; float* yr = m < MP ? F.out + O_YP + (size_t)m * DM : F.out + O_YS + (size_t)(m - MP) * DM;
        const f32x4* x4 = (const f32x4*)xr + lane; f32x4 v[8]; float s = 0.f;
#pragma unroll
        for (int j = 0; j < 8; ++j) { if (m < MP) { const v2u w = ((const v2u*)(HB + (size_t)m * DM) + lane)[64 * j]; v[j] = (f32x4){bf2f(w.x & 0xffff), bf2f(w.x >> 16), bf2f(w.y & 0xffff), bf2f(w.y >> 16)}; } else v[j] = x4[64 * j]; s += (v[j].x * v[j].x + v[j].y * v[j].y) + (v[j].z * v[j].z + v[j].w * v[j].w); }
        const float rstd = 1.0f / sqrtf(wave_sum(s) * (1.f / DM) + 1e-6f);
#pragma unroll
        for (int j = 0; j < 8; ++j) { const f32x4 gg = ((const f32x4*)g + lane)[64 * j]; const f32x4 y = v[j] * rstd * gg; const unsigned flat = (unsigned)(m < MP ? m : m - MP) * DM + 4u * (lane + 64 * j), sk = m < MP ? skip0 : skip1;
            if (flat + 3 < sk) continue;
            if (flat >= sk) __builtin_nontemporal_store(y, (f32x4*)yr + lane + 64 * j); else { for (int c = 0; c < 4; ++c) if (flat + c >= sk) yr[4 * (lane + 64 * j) + c] = y[c]; } } }
}
#if MK_CHECK
constexpr int CW_CHK = 1024;
__device__ __forceinline__ void chk_cmp(Frame& F, int ch, float got, float want, float rtol, float atol) {
    atomicAdd((unsigned*)(F.ctl + CW_CHK + 8 + ch), 1u);
    if (!(fabsf(got - want) <= atol + rtol * fabsf(want))) atomicAdd((unsigned*)(F.ctl + CW_CHK + ch), 1u);
}
__device__ __forceinline__ int chk_row(int i) { return i == 0 ? 0 : i == 1 ? 1 : i == 2 ? 63 : i == 3 ? 64 : i == 4 ? 255 : i == 5 ? 256 : i == 6 ? 3583 : i == 7 ? 3584 : i == 8 ? 4095 : i == 9 ? 4096 : i == 10 ? 8191 : 5000; }
__device__ __forceinline__ float bfr(float x) { return bf2f((unsigned short)f2bf(x)); }
__device__ void check_p1(Frame& F, const float* x_prompt, const float* x_sample, const float* norm_mix, const float* w_in) {
    unsigned char* ws = F.ws;
    const int NR = 12 + 32;
    for (int task = F.gw; task < NR * 41; task += F.NGW) {
        const int ri = task / 41, hh = task % 41, lane = F.lane;
        const bool smp = ri >= 12; const int row = smp ? ri - 12 : chk_row(ri);
        const float* xr = smp ? x_sample + (size_t)row * DM : x_prompt + (size_t)row * DM;
        double ss = 0; for (int k = 0; k < DM; ++k) ss += (double)xr[k] * xr[k];
        const float rstd = 1.0f / sqrtf((float)(ss / DM) + 1e-6f);
        const int b = smp ? row >> 2 : row >> 12, t = smp ? row & 3 : row & 4095; const float pos = smp ? (float)(PAST + t) : (float)t;
        if (hh == 40) {
            if (lane < 48) { double a = 0; for (int k = 0; k < DM; ++k) a += (double)bfr(xr[k] * rstd * norm_mix[k]) * (double)bfr(w_in[(size_t)k * NSA_N + 5120 + lane]);
                const float want = 1.f / (1.f + expf(-(float)a)); const float got = ((const float*)(ws + WS_GATES))[(size_t)(smp ? MP + row : row) * 48 + lane]; chk_cmp(F, 0, got, want, 1e-3f, 1e-3f); }
            continue;
        }
        const int n1 = hh * 128 + lane, n2 = n1 + 64; double a1 = 0, a2 = 0;
        for (int k = 0; k < DM; ++k) { const double xv = (double)bfr(xr[k] * rstd * norm_mix[k]); a1 += xv * (double)bfr(w_in[(size_t)k * NSA_N + n1]); a2 += xv * (double)bfr(w_in[(size_t)k * NSA_N + n2]); }
        float o1 = (float)a1, o2 = (float)a2;
        const bool roped = hh < 16 || (((hh - 16) >> 2) & 1) == 0;
        if (roped) { const float inv = powf(10000.f, -(float)lane / 64.f); const float ang = pos * inv; const double c = cos((double)ang), s = sin((double)ang);
            o1 = (float)(a1 * c - a2 * s); o2 = (float)(a2 * c + a1 * s); }
        if (hh < 16) {
            if (smp) { const float* q = (const float*)(ws + WS_QS) + (size_t)row * DM + hh * 128 + lane; chk_cmp(F, 0, q[0], o1, 2e-3f, 2e-3f); chk_cmp(F, 0, q[64], o2, 2e-3f, 2e-3f); }
            else { const bf16* q = (const bf16*)(ws + WS_Q) + ((size_t)(b * 16 + hh) * SEQ + t) * 128 + lane; chk_cmp(F, 1, bf2f(q[0]), o1, 1e-2f, 1e-2f); chk_cmp(F, 1, bf2f(q[64]), o2, 1e-2f, 1e-2f); }
        } else {
            const int hk = hh - 16, br = hk >> 3, e = (hk >> 2) & 1, g = hk & 3;
            const float* o = nullptr;
            if (smp) o = (br == 0) ? F.out + O_CMPS + (size_t)row * 1024 : (br == 1) ? F.out + O_SELS + (size_t)row * 1024 : F.out + O_WINS + ((size_t)b * 512 + 508 + t) * 1024;
            else { if (br == 0) o = F.out + O_CMPP + (size_t)row * 1024; else if (br == 1) o = F.out + O_SELP + (size_t)row * 1024; else if (t >= SEQ - 512) o = F.out + O_WINP + ((size_t)b * 512 + t - (SEQ - 512)) * 1024; }
            if (o) { o += e * 512 + g * 128 + lane; chk_cmp(F, 0, o[0], o1, 2e-3f, 2e-3f); chk_cmp(F, 0, o[64], o2, 2e-3f, 2e-3f); }
            if (!smp) { const bf16* kv = (br == 0 ? (const bf16*)(ws + WS_KVC) + ((size_t)((e * 2 + b) * 4 + g) * SEQ + t) * 128 : (const bf16*)(ws + WS_KV) + ((size_t)((((br - 1) * 2 + e) * 2 + b) * 4 + g) * SEQ + t) * 128) + lane; chk_cmp(F, 1, bf2f(kv[0]), o1, 1e-2f, 1e-2f); chk_cmp(F, 1, bf2f(kv[64]), o2, 1e-2f, 1e-2f); }
        }
    }
}
__device__ void check_cmp(Frame& F, const float* cache_cmp, const int* page_table, const float* cmp_pos, const float* w1, const float* b1, const float* w2) {
    unsigned char* ws = F.ws; const int lane = F.lane;
    for (int task = F.gw; task < 64 + 8; task += F.NGW) {
        int set, e, b, g, i;
        if (task < 64) { set = task >> 5; e = (task >> 4) & 1; const int bi = (task >> 3) & 1, gi = (task >> 2) & 1, ii = task & 3;
            if (set == 0) { b = bi; g = gi ? 3 : 0; i = ii == 0 ? 0 : ii == 1 ? 1 : ii == 2 ? 127 : 254; } else { b = bi ? 7 : 0; g = gi ? 2 : 1; i = ii == 0 ? 0 : ii == 1 ? 7 : ii == 2 ? 8 : 1022; } }
        else { const int j = task - 64; set = j >> 2; e = (j >> 1) & 1; b = j & 1; g = 1; i = set ? 1023 : 255; }
        const bf16* got = set == 0 ? (const bf16*)(ws + WS_KCP) + (((size_t)e * 8 + b * 4 + g) * 256 + i) * 128 : (const bf16*)(ws + WS_KCS) + (((size_t)e * 32 + b * 4 + g) * 1024 + i) * 128;
        if (task >= 64) { chk_cmp(F, 2, bf2f(got[lane]), 0.f, 0.f, 0.f); chk_cmp(F, 2, bf2f(got[lane + 64]), 0.f, 0.f, 0.f); continue; }
        double h0 = 0, h1 = 0;
        for (int k = 0; k < 4096; ++k) { const int s = k >> 7, d = k & 127, tok = i * 16 + s; float rv;
            if (set == 0) rv = F.out[O_CMPP + ((size_t)b * SEQ + tok) * 1024 + e * 512 + g * 128 + d];
            else { const int page = page_table[b * 128 + (tok >> 7)]; rv = cache_cmp[((size_t)page * 128 + (tok & 127)) * 1024 + e * 512 + g * 128 + d]; }
            const double x = (double)bfr(rv); const float* wr = w1 + ((size_t)e * 4096 + k) * 128; const double pp = (double)cmp_pos[e * 4096 + k];
            h0 += x * (double)bfr(wr[lane]) + pp * (double)wr[lane]; h1 += x * (double)bfr(wr[lane + 64]) + pp * (double)wr[lane + 64]; }
        h0 += b1[e * 128 + lane]; h1 += b1[e * 128 + lane + 64];
        const float a0 = bfr((float)(0.5 * h0 * (1.0 + tanh(0.7978845608028654 * (h0 + 0.044715 * h0 * h0 * h0))))), a1 = bfr((float)(0.5 * h1 * (1.0 + tanh(0.7978845608028654 * (h1 + 0.044715 * h1 * h1 * h1)))));
        double o0 = 0, o1 = 0;
        for (int h = 0; h < 128; ++h) { const float av = __shfl(h < 64 ? a0 : a1, h & 63); const float* wr = w2 + ((size_t)e * 128 + h) * 128; o0 += (double)av * (double)bfr(wr[lane]); o1 += (double)av * (double)bfr(wr[lane + 64]); }
        chk_cmp(F, 2, bf2f(got[lane]), (float)o0, 2e-2f, 1e-2f); chk_cmp(F, 2, bf2f(got[lane + 64]), (float)o1, 2e-2f, 1e-2f);
    }
}
__device__ void check_attn(Frame& F) {
    unsigned char* ws = F.ws; LAS float* L = (LAS float*)(F.lds + RING_OFF);
    for (int it = blockIdx.x; it < 32; it += F.G) { const int b = it >> 4, ti = it & 15, g = (ti + b) & 3, bg = b * 4 + g;
        const int t = ti == 0 ? 0 : ti == 1 ? 5 : ti == 2 ? 30 : ti == 3 ? 31 : ti == 4 ? 63 : ti == 5 ? 64 : ti == 6 ? 100 : ti == 7 ? 511 : ti == 8 ? 512 : ti == 9 ? 1000 : ti == 10 ? 1023 : ti == 11 ? 1024 : ti == 12 ? 2047 : ti == 13 ? 2048 : ti == 14 ? 3000 : 4095;
        VAttnCtx C{}; C.smp = 0; C.b = b; C.g = g; C.t = t; C.pos = t; C.KC = (const bf16*)(ws + WS_KCP) + (size_t)(0 * 8 + bg) * 256 * 128; C.VC = (const bf16*)(ws + WS_KCP) + (size_t)(1 * 8 + bg) * 256 * 128;
        C.n_cmp = 255; C.n_blk = 64; const bf16* kv = (const bf16*)(ws + WS_KV);
        C.Ks = kv + (size_t)(((0 * 2 + 0) * 2 + b) * 4 + g) * SEQ * 128; C.Vs = kv + (size_t)(((0 * 2 + 1) * 2 + b) * 4 + g) * SEQ * 128;
        C.Kw = kv + (size_t)(((1 * 2 + 0) * 2 + b) * 4 + g) * SEQ * 128; C.Vw = kv + (size_t)(((1 * 2 + 1) * 2 + b) * 4 + g) * SEQ * 128;
        const bf16* qb = (const bf16*)(ws + WS_Q); const bf16* ao = (const bf16*)(ws + WS_AO) + (size_t)(b * SEQ + t) * DM + 4 * g * 128;
        vattn_unit(C, L, [=](int r, int d) { return bf2f(qb[((size_t)(b * 16 + 4 * g + r) * SEQ + t) * 128 + d]); }, (const float*)(ws + WS_GATES) + (size_t)(b * SEQ + t) * 48,
                   [&](int r, int d, float v) { chk_cmp(F, 3, bf2f(ao[r * 128 + d]), v, 2e-2f, 2e-3f); chk_cmp(F, 4, bf2f(ao[r * 128 + d]), v, 1e-1f, 2e-2f); }); }
}
__device__ void diag_emit(Frame& F) {
    const unsigned n0 = F.ctl[CW_CHK + 0] + F.ctl[CW_CHK + 1] + F.ctl[CW_CHK + 2] + F.ctl[CW_CHK + 3], n1 = F.ctl[CW_CHK + 11] + F.ctl[CW_CHK + 10];
    for (size_t i = (size_t)F.gw * 64 + F.lane; i < O_CMPP; i += (size_t)F.NGW * 64) { const bool skip = (i < O_YS) ? (i < n0) : ((i - O_YS) < n1); if (!skip) F.out[i] = 0.f; }
}
#endif
constexpr int NPH = 16;
constexpr size_t SM_XS2 = WS_SMP, SM_RSQ = WS_SMP + 1 * MiB, SM_RSK = SM_RSQ + 256 * 1024, SM_RSV = SM_RSK + 256 * 1024, SM_RSG = SM_RSV + 512 * 1024, SM_ROS = SM_RSG + 512 * 1024, SM_HS = SM_ROS + 512 * 1024;
__global__ void __launch_bounds__(NTHR, 2) mk_fwd(Args args) {
    extern __shared__ __attribute__((aligned(16))) unsigned char lds[];
    Frame F;
    F.lds = (LAS unsigned char*)lds;
    F.MISC = (volatile LAS unsigned*)(F.lds + MISC_OFF);
    F.tid = threadIdx.x; F.lane = F.tid & 63; F.wave = __builtin_amdgcn_readfirstlane(F.tid >> 6);
    F.G = gridDim.x; F.gw = blockIdx.x * NWAVES + F.wave; F.NGW = F.G * NWAVES;
    F.ws = args.ws; F.out = args.out; F.ctl = (gu32*)(args.ws + WS_CTL);
    unsigned char* ws = args.ws;
    for (int u = F.tid; u < (LDS_BYTES - LDSCTL_OFF) / 4; u += NTHR) ((LAS unsigned*)(F.lds + LDSCTL_OFF))[u] = 0u;
    __syncthreads();
#if MK_ONE_LAUNCH
    XcdBarrier bar = xcd_barrier_post((unsigned*)(F.ctl + CW_BAR), F.MISC + 8);
#define GRID_BAR() xcd_barrier(bar)
#else
#define GRID_BAR() do {} while (0)
#endif
    const int lo = args.ph_lo, hi = args.ph_hi;
#if MK_PROBE >= 0
    volatile LAS unsigned long long* TS = (volatile LAS unsigned long long*)(F.lds + LDSCTL_OFF + 8192);
#define STAMP(k) do { if (blockIdx.x == 0 && F.tid == 0) TS[(k)] = __builtin_amdgcn_s_memrealtime(); } while (0)
    STAMP(0);
#else
#define STAMP(k) do {} while (0)
#endif
#define IN(k) (lo <= (k) && (k) < hi)
#define REP(k) for (int rep_ = 0; rep_ < 1 + ((MK_DBL >> (k)) & 1); ++rep_)
#define DUP(k, ...) do { __VA_ARGS__; if ((MK_DBL >> (k)) & 1) { __VA_ARGS__; } } while (0)
#define BOTH(k) (IN(k) && IN((k) + 1))
#define GEMM_LDS ((PG8_LAS unsigned char*)(F.lds + RING_OFF))
#define BF(off) ((bf16*)(ws + (off)))
#define PBF(off) ((const pg8::bf16_t*)(ws + (off)))
    const float* ropeN = (const float*)(ws + WS_ROPEN); const float* ropeR = (const float*)(ws + WS_ROPER);
    float* ssq0 = (float*)(F.ctl + CW_SSQ); float* ssq1 = ssq0 + SSQ_STRIDE; float* ssq2 = ssq1 + SSQ_STRIDE; float* ssq3 = ssq2 + SSQ_STRIDE;
    float* H = (float*)(ws + WS_H1); float* HS = (float*)(ws + SM_HS);
    const float* norm_mix = args.in[7]; const float* norm_ffn = args.in[8];

#ifndef P1_TAIL_CHUNKS
#define P1_TAIL_CHUNKS 0
#endif
#define MK_P0ARGS P0Args{args.in[8], args.in[0], args.in[1], args.in[2], args.in[4], args.in[7], args.in[10], args.in[11], args.in[12], args.in[13], args.in[15], args.in[16], args.in[18], args.in[19], args.in[20], (const int*)args.in[6]}
    if (IN(0)) {
        const P0Args A = MK_P0ARGS; REP(0) p0_prologue(F, A);
        if (BOTH(0)) GRID_BAR(); STAMP(1);
    }
    if (IN(1)) {
        pg8::Gemm g{PBF(WS_XN), PBF(WS_WIN_T), MP, NSA_NP, DM}; pg8::StaticOrder S; S.init(MP, NSA_NP, F.G, (int)blockIdx.x);
        EpiNsaIn E{BF(WS_Q), BF(WS_KV), BF(WS_KVC), (float*)(ws + WS_GATES), F.out, ropeN};
        DUP(1, pg8::gemm_phase<EpiNsaIn, pg8::StaticOrder, true, true>(GEMM_LDS, g, S, E));
        if (F.G == 256 && blockIdx.x >= 160) { const P0Args A = MK_P0ARGS; posp_items(A, ws, F.lane, ((int)blockIdx.x - 160) * 8 + F.wave, 96 * 8); }
        p1_sample(F, BF(WS_XS), BF(WS_WIN_T), ropeN, (float*)(ws + WS_QS), (float*)(ws + WS_GATES) + (size_t)MP * 48);
        { const int nu = (MP / 256) * (NSA_NP / 256); if ((int)blockIdx.x + (nu / F.G) * F.G >= nu && (nu % F.G) != 0) { const P0Args A = MK_P0ARGS; unsigned* conv = (unsigned*)(F.ctl + CW_TMO + 48);
            for (int k = 0; k < P1_TAIL_CHUNKS; ++k) { const int c = next_work(F, conv); if (c >= N_CONV_CHUNKS) break; convert_chunk(F, A, c); } } }
        if (BOTH(1)) GRID_BAR(); STAMP(2);
    }
    if (IN(2)) {
        if (blockIdx.x == 0 && F.tid < 256) { const int e = F.tid >> 7, h = F.tid & 127; float a = args.in[14][F.tid]; const float* pp = (const float*)(ws + WS_POSP) + (size_t)e * 64 * 128 + h;
#pragma unroll 16
            for (int sl = 0; sl < 64; ++sl) a += pp[sl * 128];
            ((float*)(ws + WS_POSB))[F.tid] = a; }
        DUP(2, p2_sample_fused(F, args.in[2], (const int*)args.in[6]); p2_prompt_per(F));
        if (BOTH(2)) GRID_BAR(); STAMP(3);
    }
    if (IN(3)) { REP(3) p3_finish(F); if (BOTH(3)) GRID_BAR(); STAMP(4); }
    if (IN(4)) { p4_sample_attention(F, args.in[3], args.in[4], (const int*)args.in[6]); { const P0Args A = MK_P0ARGS; p4_attention(F, A); } if (BOTH(4)) GRID_BAR(); STAMP(5); }
    if (IN(5)) {
        pg8::Gemm g{PBF(WS_AO), PBF(WS_WO_T), MP, DM, DM}; pg8::StaticOrder S; S.init(MP, DM, F.G, (int)blockIdx.x);
        EpiResid<true> E{args.in[0], BF(WS_XN), ssq0};
        pg8::gemm_phase<EpiResid<true>, pg8::StaticOrder, true, true>(GEMM_LDS, g, S, E);
        skinny_resid(F, BF(WS_AOS), BF(WS_WO_T), DM, args.in[1], HS, BF(WS_XS), ssq0 + MP);
        if (BOTH(5)) GRID_BAR(); STAMP(6);
    }
    if (IN(6)) {
        pg8::Gemm g{PBF(WS_XN), PBF(WS_W1_T), MP, DFF, DM}; pg8::StaticOrder S; S.init(MP, DFF, F.G, (int)blockIdx.x);
        EpiFfn1 E{BF(WS_HFF), ssq0};
        DUP(6, pg8::gemm_phase<EpiFfn1, pg8::StaticOrder, true, true>(GEMM_LDS, g, S, E));
        skinny_ffn1(F, BF(WS_XS), BF(WS_W1_T), BF(WS_HFFS), ssq0 + MP);
        if (BOTH(6)) GRID_BAR(); STAMP(7);
    }
    if (IN(7)) {
        pg8::Gemm g{PBF(WS_HFF), PBF(WS_W2_T), MP, DM, DFF, LDH}; pg8::StaticOrder S; S.init(MP, DM, F.G, (int)blockIdx.x);
        EpiResid<false> E{nullptr, BF(WS_XN), ssq1};
        pg8::gemm_phase<EpiResid<false>, pg8::StaticOrder, true, true>(GEMM_LDS, g, S, E);
        skinny_resid(F, BF(WS_HFFS), BF(WS_W2_T), DFF, HS, HS, BF(WS_XS), ssq1 + MP);
        if (BOTH(7)) GRID_BAR(); STAMP(8);
    }
    if (IN(8)) {
        pg8::Gemm g{PBF(WS_XN), PBF(WS_RIN_T), MP, RET_N, DM}; pg8::StaticOrder S; S.init(MP, RET_N, F.G, (int)blockIdx.x);
        EpiRetIn E{BF(WS_RQ), BF(WS_RK), BF(WS_RV), BF(WS_RG), BF(WS_RKT), ropeR, ssq1};
        DUP(8, pg8::gemm_phase<EpiRetIn, pg8::StaticOrder, true, true>(GEMM_LDS, g, S, E));
        skinny_retin(F, BF(WS_XS), BF(WS_RIN_T), ropeR, ssq1 + MP, (float*)(ws + SM_RSQ), (float*)(ws + SM_RSK), (float*)(ws + SM_RSV), (float*)(ws + SM_RSG));
        if (BOTH(8)) GRID_BAR(); STAMP(9);
    }
    if (IN(9)) {
        if (blockIdx.x & 1) { p_ret_sample(F, args.in[5], (const float*)(ws + SM_RSQ), (const float*)(ws + SM_RSK), (const float*)(ws + SM_RSV), (float*)(ws + SM_ROS)); p_ret_s(F); }
        else { p_ret_s(F); p_ret_sample(F, args.in[5], (const float*)(ws + SM_RSQ), (const float*)(ws + SM_RSK), (const float*)(ws + SM_RSV), (float*)(ws + SM_ROS)); }
        if (BOTH(9)) GRID_BAR(); STAMP(10); }
    if (IN(10)) { REP(10) p_ret_scan(F); if (BOTH(10)) GRID_BAR(); STAMP(11); }
    if (IN(11)) { REP(11) p_ret_gn(F, args.in[17], (const float*)(ws + SM_ROS), (const float*)(ws + SM_RSG)); if (BOTH(11)) GRID_BAR(); STAMP(12); }
    if (IN(12)) {
        pg8::Gemm g{PBF(WS_RGA), PBF(WS_RO_T), MP, DM, 4096}; pg8::StaticOrder S; S.init(MP, DM, F.G, (int)blockIdx.x);
        EpiResid<false> E{nullptr, BF(WS_XN), ssq2};
        pg8::gemm_phase<EpiResid<false>, pg8::StaticOrder, true, true>(GEMM_LDS, g, S, E);
        skinny_resid(F, BF(WS_XS), BF(WS_RO_T), 4096, HS, HS, BF(SM_XS2), ssq2 + MP);
        if (BOTH(12)) GRID_BAR(); STAMP(13);
    }
    if (IN(13)) {
        pg8::Gemm g{PBF(WS_XN), PBF(WS_W1_T + (size_t)DM * DFF * 2), MP, DFF, DM}; pg8::StaticOrder S; S.init(MP, DFF, F.G, (int)blockIdx.x);
        EpiFfn1 E{BF(WS_HFF), ssq2};
        pg8::gemm_phase<EpiFfn1, pg8::StaticOrder, true, true>(GEMM_LDS, g, S, E);
        skinny_ffn1(F, BF(SM_XS2), BF(WS_W1_T + (size_t)DM * DFF * 2), BF(WS_HFFS), ssq2 + MP);
        if (BOTH(13)) GRID_BAR(); STAMP(14);
    }
    const bool fuse_final = (F.G == 256) && !MK_CHECK;
    if (IN(14)) {
        pg8::Gemm g{PBF(WS_HFF), PBF(WS_W2_T + (size_t)DM * DFF * 2), MP, DM, DFF, LDH}; pg8::StaticOrder S; S.init(MP, DM, F.G, (int)blockIdx.x);
        if (fuse_final) {
            EpiFinal E{BF(WS_XN), ssq3, (unsigned*)(F.ctl + CW_PANEL), args.in[9], F.out + O_YP};
            pg8::gemm_phase<EpiFinal, pg8::StaticOrder, true, true>(GEMM_LDS, g, S, E);
            skinny_final(F, BF(WS_HFFS), BF(WS_W2_T + (size_t)DM * DFF * 2), DFF, HS, ssq3 + MP, (unsigned*)(F.ctl + CW_PANEL + 64 * 32), args.in[9], F.out + O_YS);
        } else {
            EpiResid<false> E{nullptr, BF(WS_XN), ssq3};
            pg8::gemm_phase<EpiResid<false>, pg8::StaticOrder, true, true>(GEMM_LDS, g, S, E);
            skinny_resid(F, BF(WS_HFFS), BF(WS_W2_T + (size_t)DM * DFF * 2), DFF, HS, HS, BF(WS_XS), ssq3 + MP);
            if (BOTH(14)) GRID_BAR();
        }
        STAMP(15);
    }
    const unsigned skip0 = 0u, skip1 = 0u;
    if (IN(15) && !MK_CHECK && !fuse_final) { REP(15) p_final_norm(F, BF(WS_XN), HS, args.in[9], skip0, skip1); if (BOTH(15)) GRID_BAR(); STAMP(16); }
#if MK_PROBE >= 0
    if (blockIdx.x == 0 && F.tid == 0) {
        const unsigned long long t1 = __builtin_amdgcn_s_memrealtime(), span = TS[MK_PROBE + 1] - TS[MK_PROBE];
        while (__builtin_amdgcn_s_memrealtime() - t1 < 9ull * span) __builtin_amdgcn_s_sleep(32);
    }
#endif
#undef IN
#undef BOTH
}

#if MK_CHECK
__global__ void __launch_bounds__(NTHR, 2) mk_chk(Args args, int which) {
    extern __shared__ __attribute__((aligned(16))) unsigned char lds[];
    Frame F; F.lds = (LAS unsigned char*)lds; F.MISC = (volatile LAS unsigned*)(F.lds + MISC_OFF);
    F.tid = threadIdx.x; F.lane = F.tid & 63; F.wave = __builtin_amdgcn_readfirstlane(F.tid >> 6);
    F.G = gridDim.x; F.gw = blockIdx.x * NWAVES + F.wave; F.NGW = F.G * NWAVES; F.ws = args.ws; F.out = args.out; F.ctl = (gu32*)(args.ws + WS_CTL);
    if (which == 0) check_p1(F, args.in[0], args.in[1], args.in[7], args.in[10]);
    else if (which == 1) check_cmp(F, args.in[2], (const int*)args.in[6], args.in[12], args.in[13], args.in[14], args.in[15]);
    else if (which == 2) check_attn(F);
    else diag_emit(F);
}
#endif
extern "C" void kernel_launch(void* const* d_in, const int* in_sizes, int n_in, void* d_out, int out_size, void* d_ws, size_t ws_size, hipStream_t stream) {
    static int grid = 0;
    if (grid == 0) {
        if (n_in != 21 || (size_t)out_size != O_END || ws_size < WS_END) { fprintf(stderr, "kernel_launch: unexpected shapes: n_in %d out %d ws %zu\n", n_in, out_size, ws_size); grid = -1; return; }
        int dev = 0, cus = 0, per_cu = 0;
        if (hipGetDevice(&dev) != hipSuccess || hipDeviceGetAttribute(&cus, hipDeviceAttributeMultiprocessorCount, dev) != hipSuccess) { grid = -1; return; }
        if (hipFuncSetAttribute((const void*)mk_fwd, hipFuncAttributeMaxDynamicSharedMemorySize, LDS_BYTES) != hipSuccess) { fprintf(stderr, "kernel_launch: hipFuncSetAttribute failed\n"); grid = -1; return; }
        if (hipOccupancyMaxActiveBlocksPerMultiprocessor(&per_cu, (const void*)mk_fwd, NTHR, LDS_BYTES) != hipSuccess || per_cu < 1) { fprintf(stderr, "kernel_launch: occupancy query says %d\n", per_cu); }
        (void)hipGetLastError();
        grid = cus;
    }
    if (grid < 0) return;
    if (hipMemsetAsync((char*)d_ws + WS_CTL, 0, CTL_ZERO_BYTES, stream) != hipSuccess) return;
    Args a{};
    for (int i = 0; i < 21; ++i) a.in[i] = (const float*)d_in[i];
    a.out = (float*)d_out; a.ws = (unsigned char*)d_ws;
#if MK_ONE_LAUNCH
    a.ph_lo = 0; a.ph_hi = NPH;
    hipLaunchKernelGGL(mk_fwd, dim3(grid), dim3(NTHR), LDS_BYTES, stream, a);
#if MK_CHECK
    hipFuncSetAttribute((const void*)mk_chk, hipFuncAttributeMaxDynamicSharedMemorySize, LDS_BYTES);
    for (int w = 0; w < 4; ++w) hipLaunchKernelGGL(mk_chk, dim3(grid), dim3(NTHR), LDS_BYTES, stream, a, w);
#endif
#else
    for (int p = 0; p < NPH; ++p) { a.ph_lo = p; a.ph_hi = p + 1; hipLaunchKernelGGL(mk_fwd, dim3(grid), dim3(NTHR), LDS_BYTES, stream, a); }
#endif
}
```

```cpp
#include <hip/hip_runtime.h>
#include <cstdio>
#include <cstdint>
#include <cmath>
#define MK_CHECK 0
#ifndef MK_PROBE
#define MK_PROBE -1
#endif
#ifndef MK_DBL
#define MK_DBL 0
#endif
namespace pg8 {
#define PG8_LAS __attribute__((address_space(3)))
typedef unsigned short bf16_t;
typedef short bf16x8 __attribute__((ext_vector_type(8)));
typedef float f32x4 __attribute__((ext_vector_type(4)));
typedef unsigned u32x4 __attribute__((ext_vector_type(4)));
constexpr int BM = 256, BK = 64, HALF = 128, HTB = HALF * BK * 2  , STAGE_BYTES = 8 * HTB, NXCD = 8, WGM = 8;

__host__ __device__ __forceinline__ int lds_byte(int r, int c) { const int st = (r >> 4) * 2 + (c >> 5), rr = r & 15, cc = c & 31, ob = rr * 64 + cc * 2; return st * 1024 + (ob ^ (((ob >> 9) & 1) << 5)); }
__host__ __device__ __forceinline__ void stage_rc(int b, int& R, int& C) { const int st = b / 1024, sb = b % 1024, swz = sb ^ (((sb >> 9) & 1) << 5); R = (st >> 1) * 16 + swz / 64; C = (st & 1) * 32 + (swz % 64) / 2; }
__host__ __device__ __forceinline__ int perm32(int rho) { const int n = rho >> 4, i = rho & 15; return 8 * (i >> 2) + 4 * n + (i & 3); }

struct Unit { int pm, pn; };
struct Gemm { const bf16_t* A; const bf16_t* Bt; int M, N, K; int lda = 0; };

struct StaticOrder {
    int nM, nN, nwg, G, c;
    __host__ __device__ void init(int M, int N, int G_, int c_) { nM = M / BM; nN = N / BM; nwg = nM * nN; G = G_; c = c_; }
    __host__ __device__ bool next(int i, Unit& u) const {
        const long L = (long)i * G + c; if (L >= nwg) return false;
        int wgid = (int)L; { const int q = nwg / NXCD, r = nwg % NXCD, xcd = wgid % NXCD, off = wgid / NXCD; wgid = (xcd < r ? xcd * (q + 1) : r * (q + 1) + (xcd - r) * q) + off; }
        const int nig = WGM * nN, gid = wgid / nig, fm = gid * WGM, gsz = (nM - fm) < WGM ? (nM - fm) : WGM;
        u.pm = fm + ((wgid % nig) % gsz); u.pn = (wgid % nig) / gsz; return true;
    }
    __device__ __forceinline__ void a_ready(const Unit&) const {}
    __device__ __forceinline__ void done(const Unit&) const {}
};

__device__ __forceinline__ unsigned cvt_pk_bf16(float lo, float hi) { unsigned r; asm volatile("v_cvt_pk_bf16_f32 %0, %1, %2" : "=v"(r) : "v"(lo), "v"(hi)); return r; }
typedef float f32x2 __attribute__((ext_vector_type(2)));
__device__ __forceinline__ f32x2 gelu_pk(f32x2 v) {
    const f32x2 av = __builtin_elementwise_abs(v), d = av * 0.2316418882f + 1.0f;
    f32x2 t; t.x = __builtin_amdgcn_rcpf(d.x); t.y = __builtin_amdgcn_rcpf(d.y);
    f32x2 q = t * 0.5307027145f + (-0.7265760135f); q = q * t + 0.7107068705f; q = q * t + (-0.142248368f); q = q * t + 0.127414796f; q = q * t;
    const f32x2 s = (v * v) * (-0.72134752044f);
    f32x2 e; e.x = __builtin_amdgcn_exp2f(s.x); e.y = __builtin_amdgcn_exp2f(s.y);
    const f32x2 m = v * (q * e), r = v - m;
    f32x2 o; o.x = v.x < 0.f ? m.x : r.x; o.y = v.y < 0.f ? m.y : r.y; return o;
}

template <int ACT  > struct EpiBf16 {
    static constexpr bool PERM = true, AFTER_DRAIN = false; static_assert(ACT == 0 || ACT == 1, "EpiBf16: ACT is 0 (none) or 1 (gelu_pk)");
    bf16_t* O; int ldc; const float* bias; int split_cols; size_t split_stride; float scale0;
    __device__ __forceinline__ void operator()(const f32x4 (&acc)[2][2][4][2], const Unit& u, int wr, int wc, int fr, int fq) const {
        const int row0 = u.pm * BM + wr * 64 + fr; int colt = u.pn * BM; bf16_t* base = O;
        float sc = 1.f; if (split_cols) { const int t = colt / split_cols; base += (size_t)t * split_stride; colt -= t * split_cols; if (t == 0) sc = scale0; }
        const int col0 = colt + wc * 32 + 8 * fq, bcol0 = u.pn * BM + wc * 32 + 8 * fq;
        f32x4 bv[2][2];
#pragma unroll
        for (int bj = 0; bj < 2; ++bj)
#pragma unroll
            for (int n = 0; n < 2; ++n) bv[bj][n] = bias ? *(const f32x4*)(bias + bcol0 + bj * HALF + 4 * n) : (f32x4){0.f, 0.f, 0.f, 0.f};
#pragma unroll
        for (int ai = 0; ai < 2; ++ai)
#pragma unroll
            for (int m = 0; m < 4; ++m) { bf16_t* rowp = base + (size_t)(row0 + ai * HALF + m * 16) * ldc + col0;
#pragma unroll
                for (int bj = 0; bj < 2; ++bj) { f32x4 v0 = acc[ai][bj][m][0] + bv[bj][0], v1 = acc[ai][bj][m][1] + bv[bj][1];
                    if (ACT == 1) { f32x2 a = gelu_pk((f32x2){v0[0], v0[1]}), b = gelu_pk((f32x2){v0[2], v0[3]}), c = gelu_pk((f32x2){v1[0], v1[1]}), d = gelu_pk((f32x2){v1[2], v1[3]});
                        v0 = (f32x4){a.x, a.y, b.x, b.y}; v1 = (f32x4){c.x, c.y, d.x, d.y}; }
                    v0 = v0 * sc; v1 = v1 * sc; u32x4 w; w.x = cvt_pk_bf16(v0[0], v0[1]); w.y = cvt_pk_bf16(v0[2], v0[3]); w.z = cvt_pk_bf16(v1[0], v1[1]); w.w = cvt_pk_bf16(v1[2], v1[3]);
                    *(u32x4*)(rowp + bj * HALF) = w; } }
    }
};
template <class Epi, class Sched, bool ALIGN_EPI = false, bool SP2 = false>
__device__ __forceinline__ void gemm_phase(PG8_LAS unsigned char* lds, const Gemm g, const Sched& S, const Epi& E) {
    const int tid = threadIdx.x, wid = __builtin_amdgcn_readfirstlane(tid >> 6), lane = tid & 63, wr = wid >> 2, wc = wid & 3, fr = lane & 15, fq = lane >> 4;
    const int K = g.K, nt = K / BK, LA = g.lda ? g.lda : K;
    unsigned voffA[2], voffB[2];
#pragma unroll
    for (int i = 0; i < 2; ++i) { int R, C; stage_rc(tid * 16 + i * 8192, R, C); const int Rb = Epi::PERM ? ((R & ~31) + perm32(R & 31)) : R;
        voffA[i] = (unsigned)(R * LA + C) * 2u; voffB[i] = (unsigned)(Rb * K + C) * 2u; }
    const size_t kstep = (size_t)(BK * 2);
    const size_t hstepB = (size_t)HALF * K * 2, hstepA = (size_t)HALF * LA * 2;
    const size_t tstepB = 2 * hstepB, tstepA = 2 * hstepA;
    const unsigned ldsw = (unsigned)wid * 1024u;
    const int aoff = lds_byte(wr * 64 + fr, fq * 8), boff = lds_byte(wc * 32 + fr, fq * 8);
#define PG8_SA(b, h) (((b) * 2 + (h)) * HTB)
#define PG8_SB(b, h) ((4 + (b) * 2 + (h)) * HTB)
#define PG8_STAGE(bufoff, gbase, voff) do { _Pragma("unroll") for (int _i = 0; _i < 2; ++_i) \
        __builtin_amdgcn_global_load_lds((const unsigned*)((const char*)(gbase) + (voff)[_i]), (PG8_LAS unsigned*)(lds + (bufoff) + ldsw + _i * 8192), 16, 0, 0); } while (0)
#define PG8_LDA(dst, b, h) do { _Pragma("unroll") for (int m = 0; m < 4; ++m) _Pragma("unroll") for (int k = 0; k < 2; ++k) dst[m][k] = *(const PG8_LAS bf16x8*)(lds + PG8_SA(b, h) + aoff + m * 2048 + k * 1024); } while (0)
#define PG8_LDB(dst, b, h) do { _Pragma("unroll") for (int n = 0; n < 2; ++n) _Pragma("unroll") for (int k = 0; k < 2; ++k) dst[n][k] = *(const PG8_LAS bf16x8*)(lds + PG8_SB(b, h) + boff + n * 2048 + k * 1024); } while (0)
#define PG8_MMA(ai, bj, At, Bt) do { __builtin_amdgcn_s_setprio(1); _Pragma("unroll") for (int m = 0; m < 4; ++m) _Pragma("unroll") for (int n = 0; n < 2; ++n) _Pragma("unroll") for (int k = 0; k < 2; ++k) \
        acc[ai][bj][m][n] = __builtin_amdgcn_mfma_f32_16x16x32_bf16(Bt[n][k], At[m][k], acc[ai][bj][m][n], 0, 0, 0); __builtin_amdgcn_s_setprio(0); } while (0)
#define PG8_WAIT_V(n) asm volatile("s_waitcnt vmcnt(" #n ")" ::: "memory")
#define PG8_WAIT_L(n) asm volatile("s_waitcnt lgkmcnt(" #n ")" ::: "memory")
#define PG8_BAR __builtin_amdgcn_s_barrier()
#define PG8_SCHED __builtin_amdgcn_sched_barrier(0)
    Unit cur, nxt; int ui = 0;
    if (!S.next(0, cur)) return;
    f32x4 acc[2][2][4][2];
#pragma unroll
    for (int a = 0; a < 2; ++a)
#pragma unroll
        for (int b = 0; b < 2; ++b)
#pragma unroll
            for (int m = 0; m < 4; ++m)
#pragma unroll
                for (int n = 0; n < 2; ++n) acc[a][b][m][n] = (f32x4){0.f, 0.f, 0.f, 0.f};
    bf16x8 At[4][2], B0[2][2], B1[2][2];
    const char* cA = (const char*)g.A + (size_t)cur.pm * tstepA; const char* cB = (const char*)g.Bt + (size_t)cur.pn * tstepB;
    S.a_ready(cur);
    if constexpr (SP2) {
        PG8_STAGE(PG8_SB(0, 0), cB, voffB); PG8_STAGE(PG8_SB(0, 1), cB + hstepB, voffB); PG8_STAGE(PG8_SA(0, 0), cA, voffA); PG8_STAGE(PG8_SA(0, 1), cA + hstepA, voffA);
        if (wr == 1) PG8_BAR;
        PG8_WAIT_V(2); PG8_BAR;
        PG8_STAGE(PG8_SB(1, 0), cB + kstep, voffB); PG8_STAGE(PG8_SA(1, 0), cA + kstep, voffA); PG8_STAGE(PG8_SB(1, 1), cB + hstepB + kstep, voffB);
        PG8_WAIT_V(6); PG8_BAR;
    } else {
        PG8_STAGE(PG8_SB(0, 0), cB, voffB); PG8_STAGE(PG8_SA(0, 0), cA, voffA); PG8_STAGE(PG8_SB(0, 1), cB + hstepB, voffB); PG8_STAGE(PG8_SA(0, 1), cA + hstepA, voffA);
        if (wr == 1) PG8_BAR;
        PG8_WAIT_V(4); PG8_BAR;
        PG8_STAGE(PG8_SB(1, 0), cB + kstep, voffB); PG8_STAGE(PG8_SA(1, 0), cA + kstep, voffA); PG8_STAGE(PG8_SB(1, 1), cB + hstepB + kstep, voffB);
        PG8_WAIT_V(6); PG8_BAR;
    }
    for (;;) {
        const bool has_next = S.next(ui + 1, nxt);
        const char* nA = has_next ? (const char*)g.A + (size_t)nxt.pm * tstepA : cA; const char* nB = has_next ? (const char*)g.Bt + (size_t)nxt.pn * tstepB : cB;
        for (int t = 0; t < nt; t += 2) {
            const bool last = (t == nt - 2);
            const char* a1 = cA + (size_t)(t + 1) * kstep;
            const char* a2 = last ? nA : cA + (size_t)(t + 2) * kstep; const char* b2 = last ? nB : cB + (size_t)(t + 2) * kstep;
            const char* a3 = a2 + kstep; const char* b3 = b2 + kstep;
            if (last && has_next) S.a_ready(nxt);
            if constexpr (SP2) {
            PG8_LDB(B0, 0, 0); PG8_LDB(B1, 0, 1); PG8_SCHED; PG8_LDA(At, 0, 0); PG8_STAGE(PG8_SA(1, 1), a1 + hstepA, voffA);
            PG8_WAIT_V(8); PG8_WAIT_L(0); PG8_BAR; PG8_MMA(0, 0, At, B0); PG8_MMA(0, 1, At, B1); PG8_BAR; PG8_SCHED;
            PG8_LDA(At, 0, 1); PG8_STAGE(PG8_SB(0, 0), b2, voffB); PG8_STAGE(PG8_SB(0, 1), b2 + hstepB, voffB); PG8_STAGE(PG8_SA(0, 0), a2, voffA);
            PG8_WAIT_V(8); PG8_WAIT_L(0); PG8_BAR; PG8_MMA(1, 0, At, B0); PG8_MMA(1, 1, At, B1); PG8_BAR; PG8_SCHED;
            PG8_LDB(B0, 1, 0); PG8_LDB(B1, 1, 1); PG8_SCHED; PG8_LDA(At, 1, 0); PG8_STAGE(PG8_SA(0, 1), a2 + hstepA, voffA);
            PG8_WAIT_V(8); PG8_WAIT_L(0); PG8_BAR; PG8_MMA(0, 0, At, B0); PG8_MMA(0, 1, At, B1); PG8_BAR; PG8_SCHED;
            PG8_LDA(At, 1, 1); PG8_STAGE(PG8_SB(1, 0), b3, voffB); PG8_STAGE(PG8_SB(1, 1), b3 + hstepB, voffB); PG8_STAGE(PG8_SA(1, 0), a3, voffA);
            PG8_WAIT_V(8); PG8_WAIT_L(0); PG8_BAR; PG8_MMA(1, 0, At, B0); PG8_MMA(1, 1, At, B1); PG8_BAR; PG8_SCHED;
            } else {
            PG8_LDB(B0, 0, 0); PG8_SCHED; PG8_LDA(At, 0, 0); PG8_STAGE(PG8_SA(1, 1), a1 + hstepA, voffA);
            PG8_WAIT_L(8); PG8_BAR; PG8_WAIT_L(0); PG8_MMA(0, 0, At, B0); PG8_BAR; PG8_SCHED;
            PG8_LDB(B1, 0, 1); PG8_STAGE(PG8_SB(0, 0), b2, voffB);
            PG8_BAR; PG8_WAIT_L(0); PG8_MMA(0, 1, At, B1); PG8_BAR;
            PG8_LDA(At, 0, 1); PG8_STAGE(PG8_SA(0, 0), a2, voffA);
            PG8_BAR; PG8_WAIT_L(0); PG8_MMA(1, 0, At, B0); PG8_BAR; PG8_SCHED;
            PG8_STAGE(PG8_SB(0, 1), b2 + hstepB, voffB);
            PG8_WAIT_V(6); PG8_BAR; PG8_MMA(1, 1, At, B1); PG8_BAR;
            PG8_LDB(B0, 1, 0); PG8_SCHED; PG8_LDA(At, 1, 0); PG8_STAGE(PG8_SA(0, 1), a2 + hstepA, voffA);
            PG8_WAIT_L(8); PG8_BAR; PG8_WAIT_L(0); PG8_MMA(0, 0, At, B0); PG8_BAR; PG8_SCHED;
            PG8_LDB(B1, 1, 1); PG8_STAGE(PG8_SB(1, 0), b3, voffB);
            PG8_BAR; PG8_WAIT_L(0); PG8_MMA(0, 1, At, B1); PG8_BAR;
            PG8_LDA(At, 1, 1); PG8_STAGE(PG8_SA(1, 0), a3, voffA);
            PG8_BAR; PG8_WAIT_L(0); PG8_MMA(1, 0, At, B0); PG8_BAR; PG8_SCHED;
            PG8_STAGE(PG8_SB(1, 1), b3 + hstepB, voffB);
            PG8_WAIT_V(6); PG8_BAR; PG8_MMA(1, 1, At, B1); PG8_BAR;
            }
        }
        if constexpr (ALIGN_EPI) { if (wr == 0) PG8_BAR; }
        if constexpr (!Epi::AFTER_DRAIN) { E(acc, cur, wr, wc, fr, fq); S.done(cur); }
        if (!has_next) break;
#pragma unroll
        for (int a = 0; a < 2; ++a)
#pragma unroll
            for (int b = 0; b < 2; ++b)
#pragma unroll
                for (int m = 0; m < 4; ++m)
#pragma unroll
                    for (int n = 0; n < 2; ++n) acc[a][b][m][n] = (f32x4){0.f, 0.f, 0.f, 0.f};
        cur = nxt; cA = nA; cB = nB; ++ui;
        if constexpr (ALIGN_EPI) { if (wr == 1) PG8_BAR; }
    }
    PG8_WAIT_V(0);
    if constexpr (!ALIGN_EPI) { if (wr == 0) PG8_BAR; }
    PG8_BAR;
    if constexpr (Epi::AFTER_DRAIN) { E.fused(acc, cur, wr, wc, fr, fq, lds, wid, lane); S.done(cur); }
#undef PG8_SA
#undef PG8_SB
#undef PG8_STAGE
#undef PG8_LDA
#undef PG8_LDB
#undef PG8_MMA
#undef PG8_WAIT_V
#undef PG8_WAIT_L
#undef PG8_BAR
#undef PG8_SCHED
}
}
#ifndef MK_ONE_LAUNCH
#define MK_ONE_LAUNCH 1
#endif
constexpr int NWAVES = 8, NTHR = 512;
constexpr int DM = 2048, SEQ = 4096, MP = 8192  , NS = 32  ;
constexpr int NSA_N = 5168, NSA_NP = 5376, DFF = 8192, RET_N = 12288;
constexpr int PAST = 16384;
constexpr int NPOSE = 4100;
constexpr size_t O_YP = 0, O_YS = 16777216, O_CMPP = O_YS + 65536, O_CMPS = O_CMPP + 8388608, O_SELP = O_CMPS + 32768, O_SELS = O_SELP + 8388608,
                 O_WINP = O_SELS + 32768, O_WINS = O_WINP + 1048576, O_RETP = O_WINS + 4194304, O_RETS = O_RETP + 2097152, O_END = O_RETS + 8388608;
constexpr size_t MiB = 1u << 20;
constexpr size_t WS_CTL = 0, CTL_ZERO_BYTES = 2 * MiB;
constexpr size_t WS_WIN_T = 2 * MiB, WS_WO_T = 24 * MiB, WS_RIN_T = 32 * MiB, WS_RO_T = 80 * MiB, WS_W1_T = 96 * MiB, WS_W2_T = 160 * MiB;
constexpr size_t WS_CW1_T = 224 * MiB, WS_CW2_T = 226 * MiB, WS_POSP = 226 * MiB + 65536, WS_POSB = WS_POSP + 65536;
constexpr size_t WS_ROPEN = 227 * MiB, WS_ROPER = 230 * MiB;
constexpr size_t WS_XN = 236 * MiB, WS_XS = 268 * MiB, WS_HFFS = 269 * MiB, WS_Q = 270 * MiB, WS_KV = 302 * MiB  , WS_GATES = 350 * MiB, WS_QS = 352 * MiB;
constexpr size_t WS_KCP = 357 * MiB, WS_KCS = 358 * MiB, WS_AO = 374 * MiB, WS_AOS = 406 * MiB;
constexpr size_t WS_H1 = 408 * MiB, WS_H2 = 474 * MiB, WS_HFF = 540 * MiB;
constexpr size_t WS_KVC = 670 * MiB  , WS_CC = 686 * MiB  ;
constexpr size_t WS_PER = 942 * MiB  , WS_PERS = WS_PER + 4 * MiB;
constexpr size_t WS_RQ = 1010 * MiB, WS_RK = 1042 * MiB, WS_RV = 1074 * MiB, WS_RG = 1138 * MiB, WS_RS = 1202 * MiB, WS_RO = 1218 * MiB, WS_RGA = 1282 * MiB;
constexpr size_t WS_RKT = 686 * MiB;
constexpr size_t WS_SMP = 1346 * MiB;
constexpr size_t WS_END = 1354 * MiB;
constexpr int CW_TMO = 0;
constexpr int CW_BAR = 4096;
constexpr int CW_SSQ = 65536;
constexpr int SSQ_STRIDE = 8448;
constexpr int RING_OFF = 0, RING_BYTES = 131072;
constexpr int LDSCTL_OFF = RING_BYTES, MISC_OFF = LDSCTL_OFF + 320;
constexpr int LDS_BYTES = 147456;

#define GAS __attribute__((address_space(1)))
#define LAS __attribute__((address_space(3)))
typedef unsigned short bf16;
typedef unsigned v4u __attribute__((ext_vector_type(4)));
typedef unsigned v2u __attribute__((ext_vector_type(2)));
typedef float f32x4 __attribute__((ext_vector_type(4)));
typedef float f32x2 __attribute__((ext_vector_type(2)));
typedef short bf16x8 __attribute__((ext_vector_type(8)));
typedef GAS unsigned gu32;
#define RLX_AGENT __ATOMIC_RELAXED, __HIP_MEMORY_SCOPE_AGENT
#define LDS_WAIT() asm volatile("s_waitcnt lgkmcnt(0)" ::: "memory")
#define VM_WAIT() asm volatile("s_waitcnt vmcnt(0)" ::: "memory")
typedef float pkf2_t __attribute__((ext_vector_type(2))); typedef __bf16 pkb2_t __attribute__((ext_vector_type(2)));
__device__ __forceinline__ unsigned pk2(float lo, float hi) { const pkf2_t v = {lo, hi}; const pkb2_t b = __builtin_convertvector(v, pkb2_t); return __builtin_bit_cast(unsigned, b); }
__device__ __forceinline__ unsigned f2bf(float f) { return pk2(f, f) & 0xffffu; }
__device__ __forceinline__ float bf2f(unsigned short h) { return __builtin_bit_cast(float, (unsigned)h << 16); }
__device__ __forceinline__ float wave_sum(float v) {
#pragma unroll
    for (int o = 1; o < 64; o <<= 1) v += __shfl_xor(v, o);
    return v;
}
__device__ __forceinline__ float wave_max(float v) {
#pragma unroll
    for (int o = 1; o < 64; o <<= 1) v = fmaxf(v, __shfl_xor(v, o));
    return v;
}

#define XB_TMO      128
#define XB_XCNT(j)  (256  + 64 * (j))
#define XB_XSUB(j)  (1280 + 64 * (j))
#define XB_XGEN(j)  (2304 + 64 * (j))
#define XB_TOP      3328
#define XB_TOPGEN   3392
#define XCD_BAR_WORDS 3456
#define XB_SPIN_CAP (1u << 18)

__device__ __forceinline__ unsigned xb_ld(unsigned* p)              { return __hip_atomic_load(p, __ATOMIC_RELAXED, __HIP_MEMORY_SCOPE_AGENT); }
__device__ __forceinline__ unsigned xb_add(unsigned* p, unsigned v) { return __hip_atomic_fetch_add(p, v, __ATOMIC_RELAXED, __HIP_MEMORY_SCOPE_AGENT); }
__device__ __forceinline__ unsigned xb_xcc_id() { return (unsigned)__builtin_amdgcn_s_getreg((3 << 11) | 20) & 0xFu; }
#define XB_SPIN(cond, bar) do { unsigned _sp = 0; while (cond) { __builtin_amdgcn_s_sleep(1); \
    if ((++_sp & 255u) == 0u) { if (xb_ld(&(bar)[XB_TMO])) break; if (_sp > XB_SPIN_CAP) { atomicAdd(&(bar)[XB_TMO], 1u); break; } } } } while (0)

struct XcdBarrier {
    unsigned* bar; unsigned x;
    volatile LAS unsigned* st;
};
__device__ __forceinline__ XcdBarrier xcd_barrier_post(unsigned* bar, volatile LAS unsigned* st) {
    XcdBarrier b; b.bar = bar; b.x = xb_xcc_id(); b.st = st;
    if (threadIdx.x == 0) (void)xb_add(&bar[XB_XCNT(b.x)], 1u);
    return b;
}
__device__ __forceinline__ void xcd_barrier_complete(unsigned* bar, unsigned x, unsigned& nloc, unsigned& nx) {
    const unsigned G = gridDim.x * gridDim.y * gridDim.z;
    unsigned sum, cnt, mine, sp = 0u;
    for (;;) {
        sum = 0u; cnt = 0u; mine = 0u;
#pragma unroll
        for (unsigned j = 0; j < 16; ++j) { const unsigned c = xb_ld(&bar[XB_XCNT(j)]); sum += c; cnt += (c > 0u) ? 1u : 0u; mine = (j == x) ? c : mine; }
        if (sum == G) break;
        __builtin_amdgcn_s_sleep(1);
        if ((++sp & 255u) == 0u) { if (xb_ld(&bar[XB_TMO])) break; if (sp > XB_SPIN_CAP) { atomicAdd(&bar[XB_TMO], 1u); break; } }
    }
    nloc = mine > 0u ? mine : 1u; nx = cnt > 0u ? cnt : 1u;
}
__device__ __forceinline__ void xcd_barrier(const XcdBarrier& b) {
    asm volatile("s_waitcnt vmcnt(0)" ::: "memory");
    __syncthreads();
    if (threadIdx.x == 0) {
        unsigned* bar = b.bar;
        __builtin_amdgcn_s_waitcnt(0);
        unsigned nloc = b.st[0], nx = b.st[1];
        if (nloc == 0u) { xcd_barrier_complete(bar, b.x, nloc, nx); b.st[0] = nloc; b.st[1] = nx; }
        const unsigned old = xb_add(&bar[XB_XSUB(b.x)], 1u);
        const unsigned gen = old / nloc;
        if (old + 1u == (gen + 1u) * nloc) {
            __builtin_amdgcn_fence(__ATOMIC_RELEASE, "agent");
            asm volatile("s_waitcnt vmcnt(0)" ::: "memory");
            const unsigned og = xb_add(&bar[XB_TOP], 1u);
            const unsigned tg = og / nx;
            if (og + 1u == (tg + 1u) * nx) xb_add(&bar[XB_TOPGEN], 1u);
            else XB_SPIN(xb_ld(&bar[XB_TOPGEN]) == tg, bar);
            __builtin_amdgcn_fence(__ATOMIC_ACQUIRE, "agent");
            xb_add(&bar[XB_XGEN(b.x)], 1u);
            asm volatile("s_waitcnt vmcnt(0)" ::: "memory");
        } else {
            XB_SPIN(xb_ld(&bar[XB_XGEN(b.x)]) == gen, bar);
            __builtin_amdgcn_fence(__ATOMIC_ACQUIRE, "agent");
            asm volatile("s_waitcnt vmcnt(0)" ::: "memory");
        }
    }
    __syncthreads();
}

struct Args { const float* in[21]; float* out; unsigned char* ws; int ph_lo, ph_hi; };
struct Frame {
    LAS unsigned char* lds;
    volatile LAS unsigned* MISC;
    gu32* ctl;
    int tid, lane, wave, G;
    int gw, NGW;
    unsigned char* ws; float* out;
};
__host__ __device__ __forceinline__ int head_col_of_d(int d) { return ((d & 63) >> 4) * 32 + (d >> 6) * 16 + (d & 15); }
__host__ __device__ __forceinline__ int inproj_dest(int n) { if (n >= 5120) return n; return (n & ~127) + head_col_of_d(n & 127); }

struct TItem { const float* W; const float* gk; bf16* WT; int N, k0, n0, kind, K; };
__device__ __forceinline__ void t_load(const TItem& I, int lane, f32x4 (&v)[8], f32x4 (&g)[2]) {
    const int nc = min(I.n0 + (lane & 7) * 4, I.N - 4);
#pragma unroll
    for (int i = 0; i < 8; ++i) { const int kk = 8 * i + (lane >> 3); v[i] = __builtin_nontemporal_load((const f32x4*)(I.W + (size_t)(I.k0 + kk) * I.N + nc)); }
    { const f32x4* gp = (const f32x4*)(I.gk ? I.gk + I.k0 + 8 * (lane & 7) : I.W); g[0] = gp[0]; g[1] = gp[1]; }
}
__device__ __forceinline__ void t_store(const TItem& I, int lane, LAS float* scr, const f32x4 (&v)[8], const f32x4 (&g)[2], bool valid, bf16* dump) {
    const int n4 = (lane & 7) * 4;
#pragma unroll
    for (int i = 0; i < 8; ++i) { const int kk = 8 * i + (lane >> 3); LAS float* d = scr + kk * 33 + n4; d[0] = v[i][0]; d[1] = v[i][1]; d[2] = v[i][2]; d[3] = v[i][3]; }
    LDS_WAIT(); asm volatile("" ::: "memory");
    const int c = lane & 7; const bool hg = I.gk != nullptr; const f32x4 one = (f32x4){1.f, 1.f, 1.f, 1.f}; const f32x4 g0 = hg ? g[0] : one, g1 = hg ? g[1] : one;
#pragma unroll
    for (int j = 0; j < 4; ++j) { const int nl = (lane >> 3) + 8 * j; const LAS float* s = scr + (8 * c) * 33 + nl;
        v4u o; o.x = pk2(s[0 * 33] * g0[0], s[1 * 33] * g0[1]); o.y = pk2(s[2 * 33] * g0[2], s[3 * 33] * g0[3]); o.z = pk2(s[4 * 33] * g1[0], s[5 * 33] * g1[1]); o.w = pk2(s[6 * 33] * g1[2], s[7 * 33] * g1[3]);
        const int n = I.n0 + nl;
        bf16* d = (I.kind == 0) ? I.WT + (size_t)n * I.K + I.k0 : (I.kind == 1) ? I.WT + (size_t)inproj_dest(n) * DM + I.k0 : I.WT + ((size_t)((I.k0 >> 11) * 128 + n)) * 2048 + (I.k0 & 2047);
        d = (valid && n < I.N) ? d + 8 * c : dump + lane * 8;
        *(GAS v4u*)d = o; }
    LDS_WAIT(); asm volatile("" ::: "memory");
}
__device__ __forceinline__ void rms_load(const float* xrow, int lane, f32x4 (&v)[8]) {
    const GAS f32x4* xr = (const GAS f32x4*)xrow + lane;
#pragma unroll
    for (int j = 0; j < 8; ++j) v[j] = __builtin_nontemporal_load(xr + 64 * j);
}
__device__ __forceinline__ void rms_finish(const f32x4 (&v)[8], const float* g, bf16* orow, int lane) {
    float s = 0.f;
#pragma unroll
    for (int j = 0; j < 8; ++j) s += (v[j].x * v[j].x + v[j].y * v[j].y) + (v[j].z * v[j].z + v[j].w * v[j].w);
    const float rstd = 1.0f / sqrtf(wave_sum(s) * (1.f / DM) + 1e-6f);
    const GAS f32x4* gr = (const GAS f32x4*)g + lane; GAS v2u* o8 = (GAS v2u*)orow + lane;
#pragma unroll
    for (int j = 0; j < 8; ++j) { const f32x4 gg = gr[64 * j]; v2u o; o.x = pk2(v[j].x * rstd * gg.x, v[j].y * rstd * gg.y); o.y = pk2(v[j].z * rstd * gg.z, v[j].w * rstd * gg.w); o8[64 * j] = o; }
}
__device__ __forceinline__ void cossin_acc(float ang, float& c, float& s) {
    const double x = (double)ang; const double n = __builtin_rint(x * 0.15915494309189535); const double r = x - n * 6.283185307179586476925;
    const double qd = __builtin_rint(r * 0.63661977236758134); const double y = r - qd * 1.5707963267948966192; const int q = ((int)qd) & 3;
    const double y2 = y * y;
    const double sp = y * (1.0 + y2 * (-1.6666666666666666e-1 + y2 * (8.3333333333333332e-3 + y2 * (-1.9841269841269841e-4 + y2 * (2.7557319223985893e-6 + y2 * (-2.5052108385441720e-8))))));
    const double cp = 1.0 + y2 * (-0.5 + y2 * (4.1666666666666664e-2 + y2 * (-1.3888888888888889e-3 + y2 * (2.4801587301587302e-5 + y2 * (-2.7557319223985888e-7 + y2 * 2.0876756987868099e-9)))));
    const double sv = (q == 0) ? sp : (q == 1) ? cp : (q == 2) ? -sp : -cp;
    const double cv = (q == 0) ? cp : (q == 1) ? -sp : (q == 2) ? -cp : sp;
    c = (float)cv; s = (float)sv;
}
struct P0Args { const float *norm_ffn; const float *x_prompt, *x_sample, *cache_cmp, *state_win, *norm_mix, *nsa_w_in, *nsa_w_out, *cmp_pos, *cmp_w1, *cmp_w2, *ret_w_in, *ret_w_out, *ffn_w1, *ffn_w2; const int* page_table; };
constexpr int I_IN = 32 * 162, I_WO = 32 * 64, I_RIN = 32 * 384, I_RO = 64 * 64, I_W1 = 32 * 256, I_W2 = 128 * 64, I_CW1 = 64 * 4, I_CW2 = 2 * 4;
constexpr int N_EARLY = I_IN + 2 * I_CW1 + 2 * I_CW2, N_LATE = I_WO + I_RIN + I_RO + 2 * I_W1 + 2 * I_W2, NITEMS = N_EARLY + N_LATE;
constexpr int CONV_CHUNK = 128, N_CONV_CHUNKS = N_LATE / CONV_CHUNK;
static_assert(N_LATE % CONV_CHUNK == 0, "late items split evenly");
__device__ __forceinline__ TItem p0_item(const P0Args& A, unsigned char* ws, int it) {
    int r = it;
    if (r < I_IN) { const int kb = r / 162, nb = r % 162; return TItem{A.nsa_w_in, nullptr, (bf16*)(ws + WS_WIN_T), NSA_N, 64 * kb, 32 * nb, 1, DM}; } r -= I_IN;
    if (r < 2 * I_CW1) { const int e = r / I_CW1; r %= I_CW1; const int kb = r / 4, nb = r % 4;
        return TItem{A.cmp_w1 + (size_t)e * 4096 * 128, nullptr, (bf16*)(ws + WS_CW1_T) + (size_t)e * 256 * 2048, 128, 64 * kb, 32 * nb, 2, 0}; } r -= 2 * I_CW1;
    if (r < 2 * I_CW2) { const int e = r / I_CW2; r %= I_CW2; const int kb = r / 4, nb = r % 4;
        return TItem{A.cmp_w2 + (size_t)e * 128 * 128, nullptr, (bf16*)(ws + WS_CW2_T) + (size_t)e * 128 * 128, 128, 64 * kb, 32 * nb, 0, 128}; } r -= 2 * I_CW2;
    if (r < I_WO) { const int kb = r / 64, nb = r % 64; return TItem{A.nsa_w_out, nullptr, (bf16*)(ws + WS_WO_T), DM, 64 * kb, 32 * nb, 0, DM}; } r -= I_WO;
    if (r < I_RIN) { const int kb = r / 384, nb = r % 384; return TItem{A.ret_w_in, A.norm_mix + DM, (bf16*)(ws + WS_RIN_T), RET_N, 64 * kb, 32 * nb, 0, DM}; } r -= I_RIN;
    if (r < I_RO) { const int kb = r / 64, nb = r % 64; return TItem{A.ret_w_out, nullptr, (bf16*)(ws + WS_RO_T), DM, 64 * kb, 32 * nb, 0, 4096}; } r -= I_RO;
    if (r < 2 * I_W1) { const int l = r / I_W1; r %= I_W1; const int kb = r / 256, nb = r % 256;
        return TItem{A.ffn_w1 + (size_t)l * DM * DFF, A.norm_ffn + l * DM, (bf16*)(ws + WS_W1_T) + (size_t)l * DM * DFF, DFF, 64 * kb, 32 * nb, 0, DM}; } r -= 2 * I_W1;
    { const int l = r / I_W2; r %= I_W2; const int kb = r / 64, nb = r % 64;
        return TItem{A.ffn_w2 + (size_t)l * DM * DFF, nullptr, (bf16*)(ws + WS_W2_T) + (size_t)l * DM * DFF, DM, 64 * kb, 32 * nb, 0, DFF}; }
}
template <int DEPTH>
__device__ __forceinline__ void convert_items(const P0Args& A, unsigned char* ws, LAS float* scr, int lane, bf16* dump, int i0, int last, int step) {
    f32x4 v[DEPTH][8], g[DEPTH][2]; TItem I[DEPTH]; int idx[DEPTH]; const int lc = last - 1;
#pragma unroll
    for (int s = 0; s < DEPTH; ++s) { idx[s] = i0 + s * step; I[s] = p0_item(A, ws, min(idx[s], lc)); t_load(I[s], lane, v[s], g[s]); }
    while (idx[0] < last) {
#pragma unroll
        for (int s = 0; s < DEPTH; ++s) {
            t_store(I[s], lane, scr, v[s], g[s], idx[s] < last, dump);
            idx[s] += DEPTH * step; I[s] = p0_item(A, ws, min(idx[s], lc)); t_load(I[s], lane, v[s], g[s]);
        }
    }
}
struct CMat { const float* W; const float* gk; bf16* WT; int N, K, NB; };
__device__ __forceinline__ void cm_load(const CMat& M, int k0, int n0, int lane, f32x4 (&v)[8], f32x4 (&g)[2]) {
    const float* p = M.W + (size_t)(k0 + (lane >> 3)) * M.N + n0 + (lane & 7) * 4; const size_t st = (size_t)8 * M.N;
#pragma unroll
    for (int i = 0; i < 8; ++i) v[i] = __builtin_nontemporal_load((const f32x4*)(p + i * st));
    const f32x4* gp = (const f32x4*)(M.gk ? M.gk + k0 + 8 * (lane & 7) : M.W); g[0] = gp[0]; g[1] = gp[1];
}
__device__ __forceinline__ void cm_store(const CMat& M, int k0, int n0, int lane, LAS float* scr, const f32x4 (&v)[8], const f32x4 (&g)[2]) {
    const int n4 = (lane & 7) * 4;
#pragma unroll
    for (int i = 0; i < 8; ++i) { const int kk = 8 * i + (lane >> 3); LAS float* d = scr + kk * 33 + n4; d[0] = v[i][0]; d[1] = v[i][1]; d[2] = v[i][2]; d[3] = v[i][3]; }
    LDS_WAIT(); asm volatile("" ::: "memory");
    const int c = lane & 7; const bool hg = M.gk != nullptr; const f32x4 one = (f32x4){1.f, 1.f, 1.f, 1.f}; const f32x4 g0 = hg ? g[0] : one, g1 = hg ? g[1] : one;
    bf16* d = M.WT + (size_t)(n0 + (lane >> 3)) * M.K + k0 + 8 * c; const size_t st = (size_t)8 * M.K;
#pragma unroll
    for (int j = 0; j < 4; ++j) { const LAS float* s = scr + (8 * c) * 33 + (lane >> 3) + 8 * j;
        v4u o; o.x = pk2(s[0 * 33] * g0[0], s[1 * 33] * g0[1]); o.y = pk2(s[2 * 33] * g0[2], s[3 * 33] * g0[3]); o.z = pk2(s[4 * 33] * g1[0], s[5 * 33] * g1[1]); o.w = pk2(s[6 * 33] * g1[2], s[7 * 33] * g1[3]);
        *(GAS v4u*)(d + j * st) = o; }
    LDS_WAIT(); asm volatile("" ::: "memory");
}
__device__ __forceinline__ void convert_chunk(Frame& F, const P0Args& A, int c) {
    int tid = threadIdx.x; asm volatile("" : "+v"(tid));
    const int wave = __builtin_amdgcn_readfirstlane(tid >> 6), lane = tid & 63;
    LAS float* scr = (LAS float*)(F.lds + RING_OFF + wave * 16384); unsigned char* ws = F.ws;
    int r = c * CONV_CHUNK; CMat M;
    if (r < I_WO) M = CMat{A.nsa_w_out, nullptr, (bf16*)(ws + WS_WO_T), DM, DM, 64};
    else if ((r -= I_WO) < I_RIN) M = CMat{A.ret_w_in, A.norm_mix + DM, (bf16*)(ws + WS_RIN_T), RET_N, DM, 384};
    else if ((r -= I_RIN) < I_RO) M = CMat{A.ret_w_out, nullptr, (bf16*)(ws + WS_RO_T), DM, 4096, 64};
    else if ((r -= I_RO) < 2 * I_W1) { const int l = r / I_W1; r %= I_W1; M = CMat{A.ffn_w1 + (size_t)l * DM * DFF, A.norm_ffn + l * DM, (bf16*)(ws + WS_W1_T) + (size_t)l * DM * DFF, DFF, DM, 256}; }
    else { r -= 2 * I_W1; const int l = r / I_W2; r %= I_W2; M = CMat{A.ffn_w2 + (size_t)l * DM * DFF, nullptr, (bf16*)(ws + WS_W2_T) + (size_t)l * DM * DFF, DM, DFF, 64}; }
    const int kb0 = r / M.NB, nb0 = r % M.NB; const bool wrap = M.NB == 64;
    auto k0_of = [&](int i) { return 64 * (kb0 + (wrap ? (i >> 6) : 0)); };
    auto n0_of = [&](int i) { return 32 * (wrap ? (i & 63) : nb0 + i); };
    f32x4 v[4][8], g[4][2];
#pragma unroll
    for (int s = 0; s < 4; ++s) { const int i = wave + 8 * s; cm_load(M, k0_of(i), n0_of(i), lane, v[s], g[s]); }
    for (int rr = 0; rr < 3; ++rr) {
#pragma unroll
        for (int s = 0; s < 4; ++s) { const int i = wave + 8 * (4 * rr + s); cm_store(M, k0_of(i), n0_of(i), lane, scr, v[s], g[s]); const int i2 = i + 32; cm_load(M, k0_of(i2), n0_of(i2), lane, v[s], g[s]); }
    }
#pragma unroll
    for (int s = 0; s < 4; ++s) { const int i = wave + 8 * (12 + s); cm_store(M, k0_of(i), n0_of(i), lane, scr, v[s], g[s]); }
}
constexpr int N_WIN_PIECES = 16;
__device__ __forceinline__ void win_copy_piece(Frame& F, const P0Args& A, int p) {
    int tid = threadIdx.x; asm volatile("" : "+v"(tid));
    constexpr int PB = 508 * 256, HP = PB / 2;
    const int b = p >> 1, o0 = (p & 1) * HP;
    const GAS f32x4* src = (const GAS f32x4*)(A.state_win + ((size_t)b * 512 + 4) * 1024) + o0; GAS f32x4* dst = (GAS f32x4*)(F.out + O_WINS + (size_t)b * 512 * 1024) + o0;
    for (int i0 = tid; i0 < HP; i0 += NTHR * 8) { f32x4 t[8];
#pragma unroll
        for (int j = 0; j < 8; ++j) { const int i = i0 + j * NTHR; if (i < HP) t[j] = __builtin_nontemporal_load(src + i); }
#pragma unroll
        for (int j = 0; j < 8; ++j) { const int i = i0 + j * NTHR; if (i < HP) __builtin_nontemporal_store(t[j], dst + i); } }
}
__device__ __forceinline__ void posp_items(const P0Args& A, unsigned char* ws, int lane, int w0, int nw) {
    for (int it = w0; it < 256; it += nw) { const int e = it >> 7, hg = (it >> 6) & 1, sl = it & 63, h = hg * 64 + lane;
        const float* pp = A.cmp_pos + (size_t)e * 4096 + sl * 64; const float* ww = A.cmp_w1 + ((size_t)e * 4096 + sl * 64) * 128 + h; float a = 0.f;
#pragma unroll 16
        for (int k = 0; k < 64; ++k) a += pp[k] * ww[(size_t)k * 128];
        ((float*)(ws + WS_POSP))[(e * 64 + sl) * 128 + h] = a; }
}
__device__ __forceinline__ void p0_prologue(Frame& F, const P0Args& A) {
    unsigned char* ws = F.ws;
    LAS float* scr = (LAS float*)(F.lds + RING_OFF + F.wave * 16384);
    const int lane = F.lane, gw = F.gw, NGW = F.NGW;
    convert_items<2>(A, ws, scr, lane, (bf16*)(ws + WS_H1) + (size_t)gw * 512, gw, N_EARLY, NGW);
    { GAS v4u* z = (GAS v4u*)((bf16*)(ws + WS_WIN_T) + (size_t)NSA_N * DM); const int n16 = (NSA_NP - NSA_N) * DM / 8;
      for (int i = gw * 64 + lane; i < n16; i += NGW * 64) z[i] = (v4u){0u, 0u, 0u, 0u}; }
    { auto xrow = [&](int m) -> const float* { return m < MP ? A.x_prompt + (size_t)m * DM : A.x_sample + (size_t)(m - MP) * DM; };
      auto orow = [&](int m) -> bf16* { return m < MP ? (bf16*)(ws + WS_XN) + (size_t)m * DM : (bf16*)(ws + WS_XS) + (size_t)(m - MP) * DM; };
      f32x4 va[8], vb[8]; int ma = gw; constexpr int ML = MP + NS - 1; rms_load(xrow(min(ma, ML)), lane, va);
      while (ma < MP + NS) {
          const int mb = ma + NGW; rms_load(xrow(min(mb, ML)), lane, vb);
          rms_finish(va, A.norm_mix, orow(ma), lane);
          ma = mb + NGW; rms_load(xrow(min(ma, ML)), lane, va);
          if (mb < MP + NS) rms_finish(vb, A.norm_mix, orow(mb), lane);
      } }
    { f32x2* tn = (f32x2*)(ws + WS_ROPEN); f32x2* tr = (f32x2*)(ws + WS_ROPER); const int NT1 = NPOSE * 64, NT2 = NPOSE * 128;
      for (int i = gw * 64 + lane; i < NT1 + NT2; i += NGW * 64) {
          int p, k, half; if (i < NT1) { p = i >> 6; k = i & 63; half = 64; } else { const int j = i - NT1; p = j >> 7; k = j & 127; half = 128; }
          const float pos = (float)(p < 4096 ? p : PAST + (p - 4096));
          const float inv = (float)exp2(-(double)k / (double)half * 13.287712379549449);
          const float ang = pos * inv; float c, s; cossin_acc(ang, c, s);
          if (i < NT1) tn[i] = (f32x2){c, s}; else tr[i - NT1] = (f32x2){c, s}; } }
    if (F.G != 256) posp_items(A, ws, lane, gw, NGW);
}
__device__ __forceinline__ void skinny_mma(const bf16* A, const bf16* Wt, int K, int col0, int lane, f32x4 (&acc)[2][2]) {
    const int r = lane & 15, q = lane >> 4;
    const bf16* a0 = A + (size_t)r * K + q * 8; const bf16* a1 = a0 + (size_t)16 * K;
    const bf16* w0 = Wt + (size_t)(col0 + r) * K + q * 8; const bf16* w1 = w0 + (size_t)16 * K;
#pragma unroll
    for (int i = 0; i < 2; ++i)
#pragma unroll
        for (int j = 0; j < 2; ++j) acc[i][j] = (f32x4){0.f, 0.f, 0.f, 0.f};
#pragma unroll 4
    for (int k0 = 0; k0 < K; k0 += 32) {
        const bf16x8 fa0 = *(const bf16x8*)(a0 + k0), fa1 = *(const bf16x8*)(a1 + k0), fw0 = *(const bf16x8*)(w0 + k0), fw1 = *(const bf16x8*)(w1 + k0);
        acc[0][0] = __builtin_amdgcn_mfma_f32_16x16x32_bf16(fw0, fa0, acc[0][0], 0, 0, 0);
        acc[0][1] = __builtin_amdgcn_mfma_f32_16x16x32_bf16(fw1, fa0, acc[0][1], 0, 0, 0);
        acc[1][0] = __builtin_amdgcn_mfma_f32_16x16x32_bf16(fw0, fa1, acc[1][0], 0, 0, 0);
        acc[1][1] = __builtin_amdgcn_mfma_f32_16x16x32_bf16(fw1, fa1, acc[1][1], 0, 0, 0);
    }
}
__device__ __forceinline__ void skinny_mma_part(const bf16* A, const bf16* Wt, int ld, int kbeg, int klen, int col0, int lane, f32x4 (&acc)[2][2]) {
    const int r = lane & 15, q = lane >> 4;
    const bf16* a0 = A + (size_t)r * ld + kbeg + q * 8; const bf16* a1 = a0 + (size_t)16 * ld;
    const bf16* w0 = Wt + (size_t)(col0 + r) * ld + kbeg + q * 8; const bf16* w1 = w0 + (size_t)16 * ld;
#pragma unroll
    for (int i = 0; i < 2; ++i)
#pragma unroll
        for (int j = 0; j < 2; ++j) acc[i][j] = (f32x4){0.f, 0.f, 0.f, 0.f};
#pragma unroll 8
    for (int k0 = 0; k0 < klen; k0 += 32) {
        const bf16x8 fa0 = *(const bf16x8*)(a0 + k0), fa1 = *(const bf16x8*)(a1 + k0), fw0 = *(const bf16x8*)(w0 + k0), fw1 = *(const bf16x8*)(w1 + k0);
        acc[0][0] = __builtin_amdgcn_mfma_f32_16x16x32_bf16(fw0, fa0, acc[0][0], 0, 0, 0);
        acc[0][1] = __builtin_amdgcn_mfma_f32_16x16x32_bf16(fw1, fa0, acc[0][1], 0, 0, 0);
        acc[1][0] = __builtin_amdgcn_mfma_f32_16x16x32_bf16(fw0, fa1, acc[1][0], 0, 0, 0);
        acc[1][1] = __builtin_amdgcn_mfma_f32_16x16x32_bf16(fw1, fa1, acc[1][1], 0, 0, 0);
    }
}
__device__ __forceinline__ void skinny_mma_wg(LAS float* red, const bf16* A, const bf16* Wt, int K, int col0, int wave, int lane, f32x4 (&acc)[2][2]) {
    const int r = lane & 15, q = lane >> 4, kw = K >> 3;
    const bf16* a0 = A + (size_t)r * K + wave * kw + q * 8; const bf16* a1 = a0 + (size_t)16 * K;
    const bf16* w0 = Wt + (size_t)(col0 + r) * K + wave * kw + q * 8; const bf16* w1 = w0 + (size_t)16 * K;
#pragma unroll
    for (int i = 0; i < 2; ++i)
#pragma unroll
        for (int j = 0; j < 2; ++j) acc[i][j] = (f32x4){0.f, 0.f, 0.f, 0.f};
#pragma unroll 8
    for (int k0 = 0; k0 < kw; k0 += 32) {
        const bf16x8 fa0 = *(const bf16x8*)(a0 + k0), fa1 = *(const bf16x8*)(a1 + k0), fw0 = *(const bf16x8*)(w0 + k0), fw1 = *(const bf16x8*)(w1 + k0);
        acc[0][0] = __builtin_amdgcn_mfma_f32_16x16x32_bf16(fw0, fa0, acc[0][0], 0, 0, 0);
        acc[0][1] = __builtin_amdgcn_mfma_f32_16x16x32_bf16(fw1, fa0, acc[0][1], 0, 0, 0);
        acc[1][0] = __builtin_amdgcn_mfma_f32_16x16x32_bf16(fw0, fa1, acc[1][0], 0, 0, 0);
        acc[1][1] = __builtin_amdgcn_mfma_f32_16x16x32_bf16(fw1, fa1, acc[1][1], 0, 0, 0);
    }
    LAS f32x4* rp = (LAS f32x4*)red + (wave * 64 + lane) * 4;
    rp[0] = acc[0][0]; rp[1] = acc[0][1]; rp[2] = acc[1][0]; rp[3] = acc[1][1];
    __syncthreads();
    if (wave == 0) {
#pragma unroll
        for (int w = 1; w < 8; ++w) { const LAS f32x4* sp = (const LAS f32x4*)red + (w * 64 + lane) * 4; acc[0][0] += sp[0]; acc[0][1] += sp[1]; acc[1][0] += sp[2]; acc[1][1] += sp[3]; } }
    __syncthreads();
}
__device__ __forceinline__ float sigmoidf_(float x) { return __builtin_amdgcn_rcpf(1.0f + __expf(-x)); }
__device__ __forceinline__ void rope4(const f32x4 x1, const f32x4 x2, const f32x4 csA, const f32x4 csB, f32x4& o1, f32x4& o2) {
    o1 = (f32x4){x1[0] * csA[0] - x2[0] * csA[1], x1[1] * csA[2] - x2[1] * csA[3], x1[2] * csB[0] - x2[2] * csB[1], x1[3] * csB[2] - x2[3] * csB[3]};
    o2 = (f32x4){x2[0] * csA[0] + x1[0] * csA[1], x2[1] * csA[2] + x1[1] * csA[3], x2[2] * csB[0] + x1[2] * csB[1], x2[3] * csB[2] + x1[3] * csB[3]};
}
__device__ __forceinline__ v2u pk4(const f32x4 v) { v2u o; o.x = pk2(v[0], v[1]); o.y = pk2(v[2], v[3]); return o; }

struct EpiNsaIn {
    static constexpr bool PERM = false, AFTER_DRAIN = false;
    bf16* Q; bf16* KV; bf16* KVC; float* gates; float* out; const float* rope;
    __device__ __forceinline__ void operator()(const pg8::f32x4 (&acc)[2][2][4][2], const pg8::Unit& u, int wr, int wc, int fr, int fq) const {
        const int pn = u.pn;
        if (pn == 20) {
            if (wc < 2) {
#pragma unroll
                for (int ai = 0; ai < 2; ++ai)
#pragma unroll
                    for (int m = 0; m < 4; ++m) { const int row = u.pm * 256 + ai * 128 + wr * 64 + m * 16 + fr;
#pragma unroll
                        for (int n = 0; n < 2; ++n) { const int c = 32 * wc + 16 * n + 4 * fq;
                            if (c < 48) { const f32x4 v = acc[ai][0][m][n]; *(GAS f32x4*)(gates + (size_t)row * 48 + c) = (f32x4){sigmoidf_(v[0]), sigmoidf_(v[1]), sigmoidf_(v[2]), sigmoidf_(v[3])}; } } }
            }
            return;
        }
        if (pn < 8) { tile<true, 0>(acc, u, wr, wc, fr, fq, 0, 0); return; }
        const int hk0 = 2 * (pn - 8), br = hk0 >> 3, e = (hk0 >> 2) & 1, g0 = hk0 & 3; const bool wout = ((u.pm * 256) & 4095) >= SEQ - 512;
        if (br == 0) { if (e == 0) tile<true, 1>(acc, u, wr, wc, fr, fq, e, g0); else tile<false, 1>(acc, u, wr, wc, fr, fq, e, g0); }
        else if (br == 1) { if (e == 0) tile<true, 2>(acc, u, wr, wc, fr, fq, e, g0); else tile<false, 2>(acc, u, wr, wc, fr, fq, e, g0); }
        else if (wout) { if (e == 0) tile<true, 3>(acc, u, wr, wc, fr, fq, e, g0); else tile<false, 3>(acc, u, wr, wc, fr, fq, e, g0); }
        else { if (e == 0) tile<true, 4>(acc, u, wr, wc, fr, fq, e, g0); else tile<false, 4>(acc, u, wr, wc, fr, fq, e, g0); }
    }
    template <bool ROPE, int KIND>
    __device__ __forceinline__ void tile(const pg8::f32x4 (&acc)[2][2][4][2], const pg8::Unit& u, int wr, int wc, int fr, int fq, int e, int g0) const {
        const int pn = u.pn, d = wc * 16 + 4 * fq, row0 = u.pm * 256 + wr * 64 + fr;
        f32x4 cs[2][2];
        auto ldr = [&](int it, int sset) { const int t = (row0 + (it >> 2) * 128 + (it & 3) * 16) & 4095; const float* rp = rope + ((size_t)t * 64 + d) * 2;
            cs[sset][0] = *(const GAS f32x4*)rp; cs[sset][1] = *(const GAS f32x4*)(rp + 4); };
        if constexpr (ROPE) ldr(0, 0);
#pragma unroll
        for (int it = 0; it < 8; ++it) { if constexpr (ROPE) { if (it + 1 < 8) ldr(it + 1, (it + 1) & 1); }
            const int ai = it >> 2, m = it & 3, row = row0 + ai * 128 + m * 16, b = row >> 12, t = row & 4095;
#pragma unroll
            for (int bj = 0; bj < 2; ++bj) { const f32x4 x1 = acc[ai][bj][m][0], x2 = acc[ai][bj][m][1]; f32x4 o1 = x1, o2 = x2;
                if constexpr (ROPE) rope4(x1, x2, cs[it & 1][0], cs[it & 1][1], o1, o2);
                if constexpr (KIND == 0) { const int hh = 2 * pn + bj; bf16* q = Q + ((size_t)(b * 16 + hh) * SEQ + t) * 128 + d; *(GAS v2u*)q = pk4(o1); *(GAS v2u*)(q + 64) = pk4(o2); }
                else { const int g = g0 + bj;
                    bf16* kv = (KIND == 1 ? KVC + ((size_t)((e * 2 + b) * 4 + g) * SEQ + t) * 128 : KV + ((size_t)(((((KIND == 2) ? 0 : 1) * 2 + e) * 2 + b) * 4 + g) * SEQ + t) * 128) + d; *(GAS v2u*)kv = pk4(o1); *(GAS v2u*)(kv + 64) = pk4(o2);
                    if constexpr (KIND != 4) { float* o = (KIND == 1) ? out + O_CMPP + (size_t)row * 1024 : (KIND == 2) ? out + O_SELP + (size_t)row * 1024 : out + O_WINP + ((size_t)b * 512 + (t - (SEQ - 512))) * 1024;
                        o += e * 512 + g * 128 + d; __builtin_nontemporal_store(o1, (GAS f32x4*)o); __builtin_nontemporal_store(o2, (GAS f32x4*)(o + 64)); } } } }
    }
};
__device__ __forceinline__ void p1_sample(Frame& F, const bf16* XS, const bf16* WinT, const float* rope, float* QS, float* GS) {
    const int lane = F.lane, r16 = lane & 15, q4 = lane >> 4;
    LAS float* red = (LAS float*)(F.lds + RING_OFF);
    const bool alt = (F.G == 256);
    for (int sl = alt ? (int)blockIdx.x - 160 : (int)blockIdx.x; sl >= 0 && sl < 162; sl += alt ? 96 : F.G) {
        f32x4 acc[2][2]; const int col0 = 32 * sl; skinny_mma_wg(red, XS, WinT, DM, col0, F.wave, lane, acc);
        if (F.wave != 0) continue;
#pragma unroll
        for (int rh = 0; rh < 2; ++rh) { const int sr = rh * 16 + r16, b = sr >> 2, t = sr & 3;
            if (col0 >= 5120) {
#pragma unroll
                for (int cs = 0; cs < 2; ++cs) { const int c = col0 - 5120 + cs * 16 + 4 * q4;
                    if (c < 48) { const f32x4 v = acc[rh][cs]; *(f32x4*)(GS + sr * 48 + c) = (f32x4){sigmoidf_(v[0]), sigmoidf_(v[1]), sigmoidf_(v[2]), sigmoidf_(v[3])}; } }
            } else {
                const int hh = col0 >> 7, wc = (col0 & 127) >> 5, d = wc * 16 + 4 * q4;
                const f32x4 csA = *(const f32x4*)(rope + ((size_t)(4096 + t) * 64 + d) * 2), csB = *(const f32x4*)(rope + ((size_t)(4096 + t) * 64 + d) * 2 + 4);
                const f32x4 x1 = acc[rh][0], x2 = acc[rh][1]; f32x4 o1 = x1, o2 = x2;
                if (hh < 16) { rope4(x1, x2, csA, csB, o1, o2); float* q = QS + (size_t)sr * DM + hh * 128 + d; *(f32x4*)q = o1; *(f32x4*)(q + 64) = o2; }
                else { const int hk = hh - 16, br = hk >> 3, e = (hk >> 2) & 1, g = hk & 3;
                    if (e == 0) rope4(x1, x2, csA, csB, o1, o2);
                    float* o = (br == 0) ? F.out + O_CMPS + (size_t)sr * 1024 : (br == 1) ? F.out + O_SELS + (size_t)sr * 1024 : F.out + O_WINS + ((size_t)b * 512 + 508 + t) * 1024;
                    o += e * 512 + g * 128 + d; *(f32x4*)o = o1; *(f32x4*)(o + 64) = o2; }
            }
        }
    }
}
struct CmpOrder {
    int G, c;
    __device__ bool next(int i, pg8::Unit& u) const { const int L = i * G + c; if (L >= 256) return false; u.pm = 16 + L; u.pn = L >> 7; return true; }
    __device__ __forceinline__ void a_ready(const pg8::Unit&) const {}
    __device__ __forceinline__ void done(const pg8::Unit&) const {}
};
struct EpiPer {
    static constexpr bool PERM = false, AFTER_DRAIN = false;
    bf16* PER;
    __device__ __forceinline__ void operator()(const pg8::f32x4 (&acc)[2][2][4][2], const pg8::Unit& u, int wr, int wc, int fr, int fq) const {
#pragma unroll
        for (int ai = 0; ai < 2; ++ai)
#pragma unroll
            for (int m = 0; m < 4; ++m) { bf16* rowp = PER + (size_t)(u.pm * 256 + ai * 128 + wr * 64 + m * 16 + fr) * 256 + wc * 32 + 4 * fq;
#pragma unroll
                for (int bj = 0; bj < 2; ++bj)
#pragma unroll
                    for (int n = 0; n < 2; ++n) *(GAS v2u*)(rowp + bj * 128 + n * 16) = pk4(acc[ai][bj][m][n]); }
    }
};
__device__ __forceinline__ void p2_prompt_per(Frame& F) {
    unsigned char* ws = F.ws; const int lane = F.lane, r16 = lane & 15, q4 = lane >> 4, wave = F.wave, tq = wave >> 1, kh = wave & 1;
    LAS float* red = (LAS float*)(F.lds + RING_OFF);
    for (int base = blockIdx.x * 4; base < 1024; base += F.G * 4) { const int it = base + tq, e = it >> 9, rg = (it >> 3) & 63, cg = it & 7;
        f32x4 acc[2][2]; skinny_mma_part((const bf16*)(ws + WS_KVC) + ((size_t)e * 2048 + rg * 32) * 2048, (const bf16*)(ws + WS_CW1_T) + (size_t)e * 256 * 2048, 2048, kh * 1024, 1024, cg * 32, lane, acc);
        LAS f32x4* rp = (LAS f32x4*)red + (wave * 64 + lane) * 4;
        if (kh) { rp[0] = acc[0][0]; rp[1] = acc[0][1]; rp[2] = acc[1][0]; rp[3] = acc[1][1]; }
        __syncthreads();
        if (!kh) { const LAS f32x4* sp = (const LAS f32x4*)red + ((wave + 1) * 64 + lane) * 4; acc[0][0] += sp[0]; acc[0][1] += sp[1]; acc[1][0] += sp[2]; acc[1][1] += sp[3];
            bf16* per = (bf16*)(ws + WS_PER);
#pragma unroll
            for (int rh = 0; rh < 2; ++rh)
#pragma unroll
                for (int cs = 0; cs < 2; ++cs) *(v2u*)(per + ((size_t)e * 2048 + rg * 32 + rh * 16 + r16) * 256 + cg * 32 + cs * 16 + 4 * q4) = pk4(acc[rh][cs]); }
        __syncthreads(); }
}
__device__ __forceinline__ float gelu_tanh(float x) { const float u = 0.7978845608028654f * (x + 0.044715f * x * x * x); const float t = 1.0f - 2.0f / (__expf(2.0f * u) + 1.0f); return 0.5f * x * (1.0f + t); }
__device__ __forceinline__ void p3_finish(Frame& F) {
    unsigned char* ws = F.ws; const int lane = F.lane, r16 = lane & 15, q4 = lane >> 4;
    const bf16* per = (const bf16*)(ws + WS_PER); const float* posb = (const float*)(ws + WS_POSB);
    LAS bf16* w2l = (LAS bf16*)(F.lds + RING_OFF);
    for (int i = F.tid; i < 2 * 128 * 128 / 8; i += NTHR) *(LAS v4u*)(w2l + (i >> 4) * 136 + (i & 15) * 8) = *((const v4u*)(ws + WS_CW2_T) + i);
    __syncthreads();
    for (int it = F.gw; it < 2 * (128 + 2048); it += F.NGW) {
        int e, R0, NCH; size_t perbase; bf16* dst;
        if (it < 256) { e = it >> 7; R0 = (it & 127) * 16; NCH = 256; perbase = (size_t)e * 2048; dst = (bf16*)(ws + WS_KCP) + (size_t)e * 2048 * 128; }
        else { const int j = it - 256; e = j >> 11; R0 = (j & 2047) * 16; NCH = 1024; perbase = 4096 + (size_t)e * 32768; dst = (bf16*)(ws + WS_KCS) + (size_t)e * 32768 * 128; }
        const int R = R0 + r16, i = R & (NCH - 1); const bool valid = i < NCH - 1;
        bf16x8 af[4];
#pragma unroll
        for (int kk = 0; kk < 4; ++kk) { const int h0 = kk * 32 + q4 * 8; f32x4 a0 = {0.f, 0.f, 0.f, 0.f}, a1 = a0;
            if (valid) { const v4u u0 = *(const v4u*)(per + (perbase + R) * 256 + h0), u1 = *(const v4u*)(per + (perbase + R + 1) * 256 + 128 + h0); const float* pb = posb + e * 128 + h0;
                a0 = (f32x4){bf2f(u0.x & 0xffff) + bf2f(u1.x & 0xffff), bf2f(u0.x >> 16) + bf2f(u1.x >> 16), bf2f(u0.y & 0xffff) + bf2f(u1.y & 0xffff), bf2f(u0.y >> 16) + bf2f(u1.y >> 16)} + *(const f32x4*)pb;
                a1 = (f32x4){bf2f(u0.z & 0xffff) + bf2f(u1.z & 0xffff), bf2f(u0.z >> 16) + bf2f(u1.z >> 16), bf2f(u0.w & 0xffff) + bf2f(u1.w & 0xffff), bf2f(u0.w >> 16) + bf2f(u1.w >> 16)} + *(const f32x4*)(pb + 4);
#pragma unroll
                for (int j = 0; j < 4; ++j) { a0[j] = gelu_tanh(a0[j]); a1[j] = gelu_tanh(a1[j]); } }
            v4u w; w.x = pk2(a0[0], a0[1]); w.y = pk2(a0[2], a0[3]); w.z = pk2(a1[0], a1[1]); w.w = pk2(a1[2], a1[3]); af[kk] = __builtin_bit_cast(bf16x8, w); }
        const LAS bf16* w2t = w2l + e * 128 * 136;
#pragma unroll
        for (int nt = 0; nt < 8; ++nt) { f32x4 acc = {0.f, 0.f, 0.f, 0.f};
#pragma unroll
            for (int kk = 0; kk < 4; ++kk) { const bf16x8 wf = *(const LAS bf16x8*)(w2t + (nt * 16 + r16) * 136 + kk * 32 + q4 * 8); acc = __builtin_amdgcn_mfma_f32_16x16x32_bf16(wf, af[kk], acc, 0, 0, 0); }
            *(v2u*)(dst + (size_t)R * 128 + nt * 16 + 4 * q4) = pk4(acc); }
    }
    __syncthreads();
}
__device__ __forceinline__ void cmp_fused_unit(PG8_LAS unsigned char* lds, int L, const float* cache, const int* page_table, const bf16* CW1T, bf16* PER) {
    using namespace pg8;
    int tid = threadIdx.x; asm volatile("" : "+v"(tid));
    const int wid = __builtin_amdgcn_readfirstlane(tid >> 6), lane = tid & 63, wr = wid >> 2, wc = wid & 3, fr = lane & 15, fq = lane >> 4;
    const int e = L >> 7, bg = (L >> 2) & 31, qt = L & 3, b = bg >> 2, g = bg & 3, c0 = qt * 256;
    const float* asrc[2][2];
#pragma unroll
    for (int h = 0; h < 2; ++h)
#pragma unroll
        for (int i = 0; i < 2; ++i) { int R, C; stage_rc(tid * 16 + i * 8192, R, C); const int c = c0 + h * 128 + R; const int page = page_table[b * 128 + (c >> 3)];
            asrc[h][i] = cache + ((size_t)page * 128 + ((c * 16) & 127)) * 1024 + e * 512 + g * 128 + C; }
    unsigned voffB[2];
#pragma unroll
    for (int i = 0; i < 2; ++i) { int R, C; stage_rc(tid * 16 + i * 8192, R, C); voffB[i] = (unsigned)(R * 2048 + C) * 2u; }
    const char* Bg = (const char*)(CW1T + (size_t)e * 256 * 2048);
    const unsigned ldsw = (unsigned)wid * 1024u;
    const int aoff = lds_byte(wr * 64 + fr, fq * 8), boff = lds_byte(wc * 32 + fr, fq * 8);
#define CF_SA(bf, h) (((bf) * 2 + (h)) * HTB)
#define CF_SB(bf, h) ((4 + (bf) * 2 + (h)) * HTB)
#define CF_LOADA(kt, ST) do { const int ko_ = ((kt) >> 1) * 1024 + ((kt) & 1) * 64; _Pragma("unroll") for (int h = 0; h < 2; ++h) _Pragma("unroll") for (int i = 0; i < 2; ++i) { \
        ar[ST][h][i][0] = __builtin_nontemporal_load((const f32x4*)(asrc[h][i] + ko_)); ar[ST][h][i][1] = __builtin_nontemporal_load((const f32x4*)(asrc[h][i] + ko_ + 4)); } } while (0)
#define CF_DMAB(kt, bf) do { _Pragma("unroll") for (int h = 0; h < 2; ++h) _Pragma("unroll") for (int i = 0; i < 2; ++i) \
        __builtin_amdgcn_global_load_lds((const unsigned*)(Bg + (size_t)h * 128 * 2048 * 2 + (size_t)(kt) * 128 + voffB[i]), (PG8_LAS unsigned*)(lds + CF_SB(bf, h) + ldsw + i * 8192), 16, 0, 0); } while (0)
#define CF_WRITEA(bf) do { _Pragma("unroll") for (int h = 0; h < 2; ++h) _Pragma("unroll") for (int i = 0; i < 2; ++i) { v4u w; w.x = pk2(ar[bf][h][i][0][0], ar[bf][h][i][0][1]); w.y = pk2(ar[bf][h][i][0][2], ar[bf][h][i][0][3]); \
        w.z = pk2(ar[bf][h][i][1][0], ar[bf][h][i][1][1]); w.w = pk2(ar[bf][h][i][1][2], ar[bf][h][i][1][3]); *(PG8_LAS v4u*)(lds + CF_SA(bf, h) + tid * 16 + i * 8192) = w; } } while (0)
    f32x4 ar[2][2][2][2];
    pg8::f32x4 acc[2][2][4][2];
#pragma unroll
    for (int a = 0; a < 2; ++a)
#pragma unroll
        for (int bb = 0; bb < 2; ++bb)
#pragma unroll
            for (int m = 0; m < 4; ++m)
#pragma unroll
                for (int n = 0; n < 2; ++n) acc[a][bb][m][n] = (pg8::f32x4){0.f, 0.f, 0.f, 0.f};
    CF_LOADA(0, 0); CF_DMAB(0, 0);
    asm volatile("s_waitcnt vmcnt(0)" ::: "memory");
    CF_WRITEA(0);
    CF_LOADA(1, 1); CF_DMAB(1, 1); CF_LOADA(2, 0);
    asm volatile("s_waitcnt lgkmcnt(0)" ::: "memory"); __builtin_amdgcn_s_barrier(); asm volatile("" ::: "memory");
#define CF_STEP(kt, BF) do { \
        __builtin_amdgcn_sched_barrier(0); \
        _Pragma("unroll") for (int bj = 0; bj < 2; ++bj) { bf16x8 Bx[2][2]; \
            _Pragma("unroll") for (int n = 0; n < 2; ++n) _Pragma("unroll") for (int k = 0; k < 2; ++k) Bx[n][k] = *(const PG8_LAS bf16x8*)(lds + CF_SB(BF, bj) + boff + n * 2048 + k * 1024); \
            _Pragma("unroll") for (int ai = 0; ai < 2; ++ai) _Pragma("unroll") for (int mp = 0; mp < 2; ++mp) { bf16x8 At[2][2]; \
                _Pragma("unroll") for (int m = 0; m < 2; ++m) _Pragma("unroll") for (int k = 0; k < 2; ++k) At[m][k] = *(const PG8_LAS bf16x8*)(lds + CF_SA(BF, ai) + aoff + (2 * mp + m) * 2048 + k * 1024); \
                _Pragma("unroll") for (int m = 0; m < 2; ++m) _Pragma("unroll") for (int n = 0; n < 2; ++n) _Pragma("unroll") for (int k = 0; k < 2; ++k) \
                    acc[ai][bj][2 * mp + m][n] = __builtin_amdgcn_mfma_f32_16x16x32_bf16(Bx[n][k], At[m][k], acc[ai][bj][2 * mp + m][n], 0, 0, 0); \
                __builtin_amdgcn_sched_barrier(0); } } \
        if ((kt) + 1 < 32) { CF_WRITEA(1 - (BF)); } \
        if ((kt) + 3 < 32) asm volatile("s_waitcnt vmcnt(8) lgkmcnt(0)" ::: "memory"); else asm volatile("s_waitcnt vmcnt(0) lgkmcnt(0)" ::: "memory"); \
        __builtin_amdgcn_s_barrier(); asm volatile("" ::: "memory"); \
        if ((kt) + 2 < 32) CF_DMAB((kt) + 2, BF); \
        if ((kt) + 3 < 32) CF_LOADA((kt) + 3, 1 - (BF)); } while (0)
    for (int kt = 0; kt < 32; kt += 2) { CF_STEP(kt, 0); CF_STEP(kt + 1, 1); }
#undef CF_STEP
    EpiPer E{PER}; Unit u; u.pm = 16 + L; u.pn = e;
    E(acc, u, wr, wc, fr, fq);
    asm volatile("s_waitcnt vmcnt(0) lgkmcnt(0)" ::: "memory"); __builtin_amdgcn_s_barrier();
#undef CF_SA
#undef CF_SB
#undef CF_LOADA
#undef CF_DMAB
#undef CF_WRITEA
}
__device__ __forceinline__ void p2_sample_fused(Frame& F, const float* cache, const int* page_table) {
    for (int i = blockIdx.x; i < 256; i += F.G) { const int xcd = i & 7, slot = i >> 3, eg = slot & 7, bq = (slot >> 3) * 8 + xcd, L = (eg >> 2) * 128 + ((bq >> 2) * 4 + (eg & 3)) * 4 + (bq & 3);
        cmp_fused_unit((PG8_LAS unsigned char*)(F.lds + RING_OFF), L, cache, page_table, (const bf16*)(F.ws + WS_CW1_T), (bf16*)(F.ws + WS_PER)); }
}
namespace att {
typedef short s16x4 __attribute__((ext_vector_type(4)));
typedef float f32x16 __attribute__((ext_vector_type(16)));
typedef unsigned u32x4 __attribute__((ext_vector_type(4)));
constexpr float SCALE = 0.08838834764831845f;
constexpr float THR = 8.f;
constexpr int SHM_V = 64 * 128 * 2, SHM_K = 64 * 128 * 2;
constexpr int L_V = 0, L_K = 2 * SHM_V, L_ACC = 65536, L_WS = 131072 + 1024, L_SELM = L_WS + 8 * 512;
#define KSWZ(row, colB) ((row) * 256 + ((colB) ^ (((row) & 7) << 4)))
#define SBAR() __builtin_amdgcn_sched_barrier(0)
__device__ __forceinline__ int v_st(int k, int c) { const int kk = (k & ~0xC) | ((k & 4) << 1) | ((k & 8) >> 1); return ((kk >> 3) * 4 + (c >> 5)) * 512 + ((kk & 7) * 32 + (c & 31)) * 2; }
__device__ __forceinline__ int v_rd_base(int lane) { return ((lane & 3) << 3) | (((lane >> 2) & 3) << 6) | (((lane >> 4) & 1) << 5) | (((lane >> 5) & 1) << 8); }
constexpr int v_rd_off(int d0, int ks, int half) { return d0 * 512 + ks * 4096 + half * 2048; }
__device__ __forceinline__ int crow(int r, int hi) { return (r & 3) + 8 * (r >> 2) + 4 * hi; }
__device__ __forceinline__ unsigned cvtpk(float lo, float hi) { unsigned r; asm volatile("v_cvt_pk_bf16_f32 %0, %1, %2" : "=v"(r) : "v"(lo), "v"(hi)); return r; }
__device__ __forceinline__ void mask_lohi(f32x16& p0, f32x16& p1, int lo, int lim, int hi) {
    const float NEG = -__builtin_inff();
#pragma unroll
    for (int r = 0; r < 16; ++r) { const int c = (r & 3) + 8 * (r >> 2) + 4 * hi;
        if (c < lo || c > lim) p0[r] = NEG;
        if (c + 32 < lo || c + 32 > lim) p1[r] = NEG; }
}
__device__ __forceinline__ void partialSM(f32x16& p0, f32x16& p1, float& m_reg, float& mn, float& alpha, bool rv) {
    float pmax = p0[0];
#pragma unroll
    for (int r = 1; r < 16; ++r) pmax = fmaxf(pmax, p0[r]);
#pragma unroll
    for (int r = 0; r < 16; ++r) pmax = fmaxf(pmax, p1[r]);
    { auto rr = __builtin_amdgcn_permlane32_swap(__float_as_uint(pmax), __float_as_uint(pmax), false, false);
      pmax = fmaxf(__uint_as_float(rr[0]), __uint_as_float(rr[1])); }
    if (!rv) pmax = -__builtin_inff();
    constexpr float C2 = 1.4426950408889634f * SCALE;
    if (__builtin_expect(__all((pmax - m_reg) * SCALE <= THR), 1)) { mn = m_reg; alpha = 1.f; }
    else { mn = fmaxf(m_reg, pmax); alpha = __builtin_amdgcn_exp2f((m_reg - mn) * C2); m_reg = mn; }
    const float mnL = -mn * C2;
#pragma unroll
    for (int r = 0; r < 16; ++r) p0[r] = fmaf(p0[r], C2, mnL);
#pragma unroll
    for (int r = 0; r < 16; ++r) p1[r] = fmaf(p1[r], C2, mnL);
#pragma unroll
    for (int r = 0; r < 16; ++r) p0[r] = __builtin_amdgcn_exp2f(p0[r]);
}
__device__ __forceinline__ void finishSM(f32x16& p0, f32x16& p1, float alpha, float& l_reg, bf16x8& pa0, bf16x8& pa1, bf16x8& pa2, bf16x8& pa3, bool rv) {
#pragma unroll
    for (int r = 0; r < 16; ++r) p1[r] = __builtin_amdgcn_exp2f(p1[r]);
    float ps = 0;
#pragma unroll
    for (int r = 0; r < 16; ++r) ps += p0[r];
#pragma unroll
    for (int r = 0; r < 16; ++r) ps += p1[r];
    { auto rr = __builtin_amdgcn_permlane32_swap(__float_as_uint(ps), __float_as_uint(ps), false, false);
      ps = __uint_as_float(rr[0]) + __uint_as_float(rr[1]); }
    ps = rv ? ps : 0.f;
    l_reg = l_reg * alpha + ps;
#define PK4(P, B_, OUT) do { unsigned a0 = cvtpk(P[B_+0], P[B_+1]), a1 = cvtpk(P[B_+2], P[B_+3]);                          \
        unsigned b0 = cvtpk(P[B_+4], P[B_+5]), b1 = cvtpk(P[B_+6], P[B_+7]);                                             \
        auto r0 = __builtin_amdgcn_permlane32_swap(a0, b0, false, false); auto r1 = __builtin_amdgcn_permlane32_swap(a1, b1, false, false); \
        u32x4 w = {r0[0], r1[0], r0[1], r1[1]}; OUT = *reinterpret_cast<bf16x8*>(&w); } while (0)
    PK4(p0, 0, pa0); PK4(p0, 8, pa1); PK4(p1, 0, pa2); PK4(p1, 8, pa3);
#undef PK4
    if (!rv) { pa0 = bf16x8{}; pa1 = bf16x8{}; pa2 = bf16x8{}; pa3 = bf16x8{}; }
}
template <int KB>
__device__ __forceinline__ void qkt(f32x16& p0, f32x16& p1, const char* K_lds, int r32, int hi, const bf16x8* qr) {
    p0 = f32x16{}; p1 = f32x16{};
    __builtin_amdgcn_s_setprio(1);
    const char* kb[4];
#pragma unroll
    for (int dd = 0; dd < 4; ++dd) kb[dd] = K_lds + KB * SHM_K + KSWZ(r32, (dd * 16 + hi * 8) * 2);
#pragma unroll
    for (int d0 = 0; d0 < 8; ++d0) { const char* a = kb[d0 & 3] + (d0 >> 2) * 128;
        bf16x8 b0 = *reinterpret_cast<const bf16x8*>(a);
        bf16x8 b1 = *reinterpret_cast<const bf16x8*>(a + 32 * 256);
        p0 = __builtin_amdgcn_mfma_f32_32x32x16_bf16(b0, qr[d0], p0, 0, 0, 0);
        p1 = __builtin_amdgcn_mfma_f32_32x32x16_bf16(b1, qr[d0], p1, 0, 0, 0);
        if (d0 == 3) SBAR(); }
    __builtin_amdgcn_s_setprio(0);
}
template <int VB>
__device__ __forceinline__ void pv_tile(f32x16* o, int vb0, bf16x8 pa0, bf16x8 pa1, bf16x8 pa2, bf16x8 pa3) {
#define TRRD(dst, off) asm volatile("ds_read_b64_tr_b16 %0, %1 offset:%2" : "=&v"(dst) : "v"(vb0), "i"(off) : "memory")
#define PV_D0(d0) do { s16x4 l0, l1, l2, l3, h0, h1, h2, h3; constexpr int b_ = VB * SHM_V + v_rd_off(d0, 0, 0); \
        TRRD(l0, b_); TRRD(h0, b_ + 2048); TRRD(l1, b_ + 4096); TRRD(h1, b_ + 6144); TRRD(l2, b_ + 8192); TRRD(h2, b_ + 10240); TRRD(l3, b_ + 12288); TRRD(h3, b_ + 14336); \
        asm volatile("s_waitcnt lgkmcnt(0)" ::: "memory"); SBAR();   \
        o[d0] = __builtin_amdgcn_mfma_f32_32x32x16_bf16(pa0, (bf16x8){l0[0], l0[1], l0[2], l0[3], h0[0], h0[1], h0[2], h0[3]}, o[d0], 0, 0, 0);   \
        o[d0] = __builtin_amdgcn_mfma_f32_32x32x16_bf16(pa1, (bf16x8){l1[0], l1[1], l1[2], l1[3], h1[0], h1[1], h1[2], h1[3]}, o[d0], 0, 0, 0);   \
        o[d0] = __builtin_amdgcn_mfma_f32_32x32x16_bf16(pa2, (bf16x8){l2[0], l2[1], l2[2], l2[3], h2[0], h2[1], h2[2], h2[3]}, o[d0], 0, 0, 0);   \
        o[d0] = __builtin_amdgcn_mfma_f32_32x32x16_bf16(pa3, (bf16x8){l3[0], l3[1], l3[2], l3[3], h3[0], h3[1], h3[2], h3[3]}, o[d0], 0, 0, 0); } while (0)
    __builtin_amdgcn_s_setprio(1);
    PV_D0(0); PV_D0(1); PV_D0(2); PV_D0(3);
    __builtin_amdgcn_s_setprio(0);
#undef PV_D0
#undef TRRD
}
struct St { f32x16 o[4]; float m, l; };
struct MaskCmp { int t; __device__ __forceinline__ void operator()(f32x16& p0, f32x16& p1, int tile, int hi) const { const int lim = ((t - 31) >> 4) - 64 * tile; if (!__all(lim >= 63)) mask_lohi(p0, p1, 0, lim, hi); }
    __device__ __forceinline__ bool rowvalid(int) const { return true; } };
struct MaskSel { int tl, qb; unsigned long long sel; __device__ __forceinline__ void operator()(f32x16& p0, f32x16& p1, int tile, int hi) const { if (tile == qb) mask_lohi(p0, p1, 0, tl, hi); }
    __device__ __forceinline__ bool rowvalid(int tile) const { return (sel >> tile) & 1ull; } };
struct MaskWin { int t; __device__ __forceinline__ void operator()(f32x16& p0, f32x16& p1, int tile, int hi) const {
    const int lo = t - 511 - 64 * tile, lim = t - 64 * tile; if (!__all(lo <= 0 && lim >= 63)) mask_lohi(p0, p1, lo, lim, hi); }
    __device__ __forceinline__ bool rowvalid(int) const { return true; } };

template <int BUF, class MaskF>
__device__ __forceinline__ void flash_tile(char* lds, const bf16x8* qr, St& S, int vb0, int r32, int hi, float* al_l, const MaskF& mk, int tile) {
    f32x16 p0, p1; qkt<BUF>(p0, p1, lds + L_K, r32, hi, qr);
    mk(p0, p1, tile, hi);
    const bool rv = mk.rowvalid(tile);
    float mn, alpha; partialSM(p0, p1, S.m, mn, alpha, rv);
    if (__any(alpha < 1.f)) { if (hi == 0) al_l[r32] = alpha; asm volatile("s_waitcnt lgkmcnt(0)" ::: "memory");
#pragma unroll
        for (int d_ = 0; d_ < 4; ++d_)
#pragma unroll
            for (int r = 0; r < 16; ++r) S.o[d_][r] *= al_l[crow(r, hi)]; }
    bf16x8 pa0, pa1, pa2, pa3; finishSM(p0, p1, alpha, S.l, pa0, pa1, pa2, pa3, rv); SBAR();
    pv_tile<BUF>(S.o, vb0, pa0, pa1, pa2, pa3);
}
template <int BUF>
__device__ __forceinline__ void imp_tile(char* lds, const bf16x8* qr, float m, float rl, int r32, int hi, const MaskCmp& mk, int tt, float& carry, float* imp_row) {
    f32x16 p0, p1; qkt<BUF>(p0, p1, lds + L_K, r32, hi, qr);
    mk(p0, p1, tt, hi);
    constexpr float C2 = 1.4426950408889634f * SCALE; const float mnL = -m * C2;
#pragma unroll
    for (int r = 0; r < 16; ++r) { p0[r] = __builtin_amdgcn_exp2f(fmaf(p0[r], C2, mnL)) * rl; p1[r] = __builtin_amdgcn_exp2f(fmaf(p1[r], C2, mnL)) * rl; }
    float G[8], PL[8];
#pragma unroll
    for (int kk = 0; kk < 4; ++kk) { G[kk] = (p0[4 * kk] + p0[4 * kk + 1]) + (p0[4 * kk + 2] + p0[4 * kk + 3]); G[4 + kk] = (p1[4 * kk] + p1[4 * kk + 1]) + (p1[4 * kk + 2] + p1[4 * kk + 3]);
        PL[kk] = __shfl_xor(p0[4 * kk + 3], 32); PL[4 + kk] = __shfl_xor(p1[4 * kk + 3], 32); }
#pragma unroll
    for (int kk = 0; kk < 8; ++kk) { const float prev = hi ? PL[kk] : (kk ? PL[kk > 0 ? kk - 1 : 0] : carry); imp_row[16 * tt + 2 * kk + hi] = G[kk] + prev; }
    carry = PL[7];
}

struct Stage { bf16x8 k0, k1, v0, v1; };
#define ATT_LOAD(St_, Kg_, Vg_, tile_) do { const size_t ro_ = ((size_t)(tile_) * 64 + sr) * 128 + sc; St_.k0 = *(const bf16x8*)((Kg_) + ro_); St_.k1 = *(const bf16x8*)((Kg_) + ro_ + 32 * 128); \
        if (Vg_) { St_.v0 = *(const bf16x8*)((Vg_) + ro_); St_.v1 = *(const bf16x8*)((Vg_) + ro_ + 32 * 128); } } while (0)
#define ATT_WRITE(St_, buf_, hasv_) do { *(bf16x8*)(lds + L_K + (buf_) * SHM_K + kws) = St_.k0; *(bf16x8*)(lds + L_K + (buf_) * SHM_K + kws + 32 * 256) = St_.k1; \
        if (hasv_) { *(bf16x8*)(lds + L_V + (buf_) * SHM_V + vst0) = St_.v0; *(bf16x8*)(lds + L_V + (buf_) * SHM_V + vst1) = St_.v1; } } while (0)

template <class MaskF>
__device__ __forceinline__ void flash_branch(char* lds, const bf16* Kg, const bf16* Vg, int j_lo, int j_hi, const MaskF& mk, const bf16x8* qr, St& S, int vb0, int r32, int hi, float* al_l, int sr, int sc, int kws, int vst0, int vst1) {
    const int n = j_hi - j_lo; Stage sg;
    ATT_LOAD(sg, Kg, Vg, j_lo); ATT_WRITE(sg, 0, true); if (n > 1) ATT_LOAD(sg, Kg, Vg, j_lo + 1);
    __syncthreads();
    for (int t = 0; t < n; t += 2) {
        flash_tile<0>(lds, qr, S, vb0, r32, hi, al_l, mk, j_lo + t);
        if (t + 1 < n) { ATT_WRITE(sg, 1, true); if (t + 2 < n) ATT_LOAD(sg, Kg, Vg, j_lo + t + 2); }
        __syncthreads();
        if (t + 1 < n) {
            flash_tile<1>(lds, qr, S, vb0, r32, hi, al_l, mk, j_lo + t + 1);
            if (t + 2 < n) { ATT_WRITE(sg, 0, true); if (t + 3 < n) ATT_LOAD(sg, Kg, Vg, j_lo + t + 3); }
            __syncthreads();
        }
    }
}
__device__ __forceinline__ void merge_branch(St& S, bf16* accw, float* sc_l, float gate, int r32, int hi, bool first) {
    if (hi == 0) sc_l[r32] = S.l > 0.f ? gate / S.l : 0.f;
    asm volatile("s_waitcnt lgkmcnt(0)" ::: "memory");
#pragma unroll
    for (int r = 0; r < 16; ++r) { const int row = crow(r, hi); const float s = sc_l[row];
#pragma unroll
        for (int d0 = 0; d0 < 4; ++d0) { bf16* a = accw + row * 128 + d0 * 32 + r32; const float v = S.o[d0][r] * s; *a = (bf16)f2bf(first ? v : bf2f(*a) + v); } }
    asm volatile("s_waitcnt lgkmcnt(0)" ::: "memory");
}

__device__ __forceinline__ void attn_unit(char* lds, int b, int g, int qb, const bf16* Qb, const bf16* KCP, const bf16* KV, const float* gates, bf16* AO) {
    int tid = threadIdx.x; asm volatile("" : "+v"(tid));
    const int wid = __builtin_amdgcn_readfirstlane(tid >> 6), lane = tid & 63, r32 = lane & 31, hi = lane >> 5;
    const int hr = wid & 3, qh = wid >> 2, h = 4 * g + hr, ql = qh * 32 + r32, t = 64 * qb + ql;
    const int sr = tid >> 4, sc = (tid & 15) * 8, vst0 = v_st(sr, sc), vst1 = v_st(32 + sr, sc), kws = KSWZ(sr, sc * 2);
    const int vb0 = (int)(uintptr_t)(lds + L_V) + v_rd_base(lane);
    float* wsf = (float*)(lds + L_WS) + wid * 128; float* al_l = wsf; float* sc_l = wsf + 32;
    bf16* accw = (bf16*)(lds + L_ACC) + wid * 32 * 128;
    float* imp4 = (float*)(lds + L_ACC);
    unsigned long long* selm = (unsigned long long*)(lds + L_SELM);
    bf16x8 qr[8];
    { const bf16* qp = Qb + ((size_t)(b * 16 + h) * SEQ + t) * 128 + hi * 8;
#pragma unroll
      for (int d0 = 0; d0 < 8; ++d0) qr[d0] = *(const bf16x8*)(qp + d0 * 16); }
    const float* grow = gates + (size_t)(b * SEQ + t) * 48 + h;
    const float g_cmp = grow[0], g_sel = grow[16], g_win = grow[32];
    const int bg = b * 4 + g;
    St S;
    const bf16* Kc = KCP + (size_t)(0 * 8 + bg) * 256 * 128; const bf16* Vc = KCP + (size_t)(1 * 8 + bg) * 256 * 128;
    const int nt_cmp = (4 * qb + 2) / 64 + 1;
    const MaskCmp mc{t};
#pragma unroll
    for (int d_ = 0; d_ < 4; ++d_) S.o[d_] = f32x16{};
    S.m = -1e30f; S.l = 0.f;
    flash_branch(lds, Kc, Vc, 0, nt_cmp, mc, qr, S, vb0, r32, hi, al_l, sr, sc, kws, vst0, vst1);
    { const float rl = S.l > 0.f ? 1.0f / S.l : 0.f; float carry = 0.f; float* imp_row = imp4 + ((size_t)hr * 64 + ql) * 64; Stage sg; const bf16* nov = nullptr;
      ATT_LOAD(sg, Kc, nov, 0); ATT_WRITE(sg, 0, false); if (nt_cmp > 1) ATT_LOAD(sg, Kc, nov, 1);
      __syncthreads();
      for (int tt = 0; tt < 4; tt += 2) {
          if (tt < nt_cmp) imp_tile<0>(lds, qr, S.m, rl, r32, hi, mc, tt, carry, imp_row);
          else {
#pragma unroll
              for (int kk = 0; kk < 8; ++kk) imp_row[16 * tt + 2 * kk + hi] = 0.f; }
          if (tt + 1 < nt_cmp) { ATT_WRITE(sg, 1, false); if (tt + 2 < nt_cmp) ATT_LOAD(sg, Kc, nov, tt + 2); }
          __syncthreads();
          if (tt + 1 < nt_cmp) imp_tile<1>(lds, qr, S.m, rl, r32, hi, mc, tt + 1, carry, imp_row);
          else {
#pragma unroll
              for (int kk = 0; kk < 8; ++kk) imp_row[16 * (tt + 1) + 2 * kk + hi] = 0.f; }
          if (tt + 2 < nt_cmp) { ATT_WRITE(sg, 0, false); if (tt + 3 < nt_cmp) ATT_LOAD(sg, Kc, nov, tt + 3); }
          __syncthreads();
      } }
    { int j = lane; asm volatile("" : "+v"(j));
      for (int qi = 0; qi < 8; ++qi) { const int q = wid * 8 + qi;
        const float v = ((imp4[(0 * 64 + q) * 64 + j] + imp4[(1 * 64 + q) * 64 + j]) + imp4[(2 * 64 + q) * 64 + j]) + imp4[(3 * 64 + q) * 64 + j];
        const bool visible = j <= qb, forced = (j == 0) || (visible && j > qb - 2);
        unsigned long long sel = __ballot(forced), cand = __ballot(visible && !forced); int need = 16 - __popcll(sel);
        if (__popcll(cand) <= need) sel |= cand;
        else { const unsigned long long key = ((unsigned long long)__float_as_uint(v) << 6) | (unsigned)(63 - j);
            for (int bit = 37; bit >= 0; --bit) { const unsigned long long ones = __ballot(((key >> bit) & 1ull) != 0ull) & cand; const int c = __popcll(ones);
                if (c >= need) cand = ones; else { sel |= ones; need -= c; cand &= ~ones; } }
            sel |= cand; }
        if (lane == 0) selm[q] = sel; } }
    __syncthreads();
    const unsigned long long mysel = selm[ql];
    __syncthreads();
    merge_branch(S, accw, sc_l, g_cmp, r32, hi, true);
    { const bf16* Ks = KV + (size_t)(((0 * 2 + 0) * 2 + b) * 4 + g) * SEQ * 128; const bf16* Vs = KV + (size_t)(((0 * 2 + 1) * 2 + b) * 4 + g) * SEQ * 128;
#pragma unroll
      for (int d_ = 0; d_ < 4; ++d_) S.o[d_] = f32x16{};
      S.m = -1e30f; S.l = 0.f;
      const MaskSel ms{ql, qb, mysel};
      flash_branch(lds, Ks, Vs, 0, qb + 1, ms, qr, S, vb0, r32, hi, al_l, sr, sc, kws, vst0, vst1);
      merge_branch(S, accw, sc_l, g_sel, r32, hi, false); }
    { const bf16* Kw = KV + (size_t)(((1 * 2 + 0) * 2 + b) * 4 + g) * SEQ * 128; const bf16* Vw = KV + (size_t)(((1 * 2 + 1) * 2 + b) * 4 + g) * SEQ * 128;
#pragma unroll
      for (int d_ = 0; d_ < 4; ++d_) S.o[d_] = f32x16{};
      S.m = -1e30f; S.l = 0.f;
      const MaskWin mw{t};
      flash_branch(lds, Kw, Vw, qb >= 8 ? qb - 8 : 0, qb + 1, mw, qr, S, vb0, r32, hi, al_l, sr, sc, kws, vst0, vst1);
      merge_branch(S, accw, sc_l, g_win, r32, hi, false); }
    int lane2 = lane; asm volatile("" : "+v"(lane2));
#pragma unroll
    for (int i = 0; i < 8; ++i) { const int row = i * 4 + (lane2 >> 4), ch = lane2 & 15; const v4u w = *(const v4u*)(accw + row * 128 + ch * 8);
        *(GAS v4u*)(AO + (size_t)(b * SEQ + 64 * qb + qh * 32 + row) * DM + h * 128 + ch * 8) = w; }
    __syncthreads();
}
#undef KSWZ
#undef SBAR
}
__device__ __forceinline__ int next_work(Frame& F, unsigned* counter) {
    volatile LAS int* slot = (volatile LAS int*)(F.lds + LDSCTL_OFF + 64);
    if (F.tid == 0) *slot = (int)__hip_atomic_fetch_add(counter, 1u, __ATOMIC_RELAXED, __HIP_MEMORY_SCOPE_AGENT);
    __syncthreads();
    const int idx = *slot;
    __syncthreads();
    return idx;
}
__device__ __forceinline__ void p4_attention(Frame& F, const P0Args& A) {
    unsigned char* ws = F.ws; unsigned* counter = (unsigned*)(F.ctl + CW_TMO + 32); unsigned* conv = (unsigned*)(F.ctl + CW_TMO + 48); bool conv_left = true;
    for (;;) { const int u = next_work(F, counter); if (u >= 512) break; const int qb = 63 - (u >> 3), b = (u >> 2) & 1, g = u & 3;
        att::attn_unit((char*)F.lds, b, g, qb, (const bf16*)(ws + WS_Q), (const bf16*)(ws + WS_KCP), (const bf16*)(ws + WS_KV), (const float*)(ws + WS_GATES), (bf16*)(ws + WS_AO));
        if (conv_left) { const int c = next_work(F, conv); if (c < N_CONV_CHUNKS) convert_chunk(F, A, c); else if (c < N_CONV_CHUNKS + N_WIN_PIECES) win_copy_piece(F, A, c - N_CONV_CHUNKS); else conv_left = false; } }
    while (conv_left) { const int c = next_work(F, conv); if (c < N_CONV_CHUNKS) convert_chunk(F, A, c); else if (c < N_CONV_CHUNKS + N_WIN_PIECES) win_copy_piece(F, A, c - N_CONV_CHUNKS); else conv_left = false; }
}
struct KRow { const void* p; int f32; };
__device__ __forceinline__ void krow_load8(const KRow& r, int d8, float (&v)[8]) {
    if (r.f32) { const f32x4 a = *((const f32x4*)r.p + 2 * d8), b = *((const f32x4*)r.p + 2 * d8 + 1); v[0] = a[0]; v[1] = a[1]; v[2] = a[2]; v[3] = a[3]; v[4] = b[0]; v[5] = b[1]; v[6] = b[2]; v[7] = b[3]; }
    else { const v4u w = *((const v4u*)r.p + d8); v[0] = bf2f(w.x & 0xffff); v[1] = bf2f(w.x >> 16); v[2] = bf2f(w.y & 0xffff); v[3] = bf2f(w.y >> 16); v[4] = bf2f(w.z & 0xffff); v[5] = bf2f(w.z >> 16); v[6] = bf2f(w.w & 0xffff); v[7] = bf2f(w.w >> 16); }
}
__device__ __forceinline__ f32x2 krow_load2(const KRow& r, int d2) {
    if (r.f32) return *((const f32x2*)r.p + d2);
    const unsigned w = *((const unsigned*)r.p + d2); return (f32x2){bf2f(w & 0xffff), bf2f(w >> 16)};
}
struct VAttnCtx {
    int smp;
    int b, g, t, pos;
    const bf16 *KC, *VC;
    int n_cmp, n_blk;
    const bf16 *Ks, *Vs, *Kw, *Vw;
    const float *cache_sel, *state_win, *out; const int* page_table;
};
__device__ __forceinline__ bool sel_key(const VAttnCtx& C, int blk, int kin, KRow& kr, KRow& vr) {
    const int kpos = blk * 64 + kin; if (kpos > C.pos) return false;
    if (!C.smp) { kr = KRow{C.Ks + (size_t)kpos * 128, 0}; vr = KRow{C.Vs + (size_t)kpos * 128, 0}; return true; }
    if (kpos >= PAST) { const float* r = C.out + O_SELS + (size_t)(C.b * 4 + (kpos - PAST)) * 1024 + C.g * 128; kr = KRow{r, 1}; vr = KRow{r + 512, 1}; return true; }
    const int page = C.page_table[C.b * 128 + (kpos >> 7)]; const float* r = C.cache_sel + ((size_t)page * 128 + (kpos & 127)) * 1024 + C.g * 128; kr = KRow{r, 1}; vr = KRow{r + 512, 1}; return true;
}
__device__ __forceinline__ bool win_key(const VAttnCtx& C, int i, KRow& kr, KRow& vr) {
    if (!C.smp) { const int kpos = C.pos - 511 + i; if (kpos < 0 || kpos > C.pos) return false; kr = KRow{C.Kw + (size_t)kpos * 128, 0}; vr = KRow{C.Vw + (size_t)kpos * 128, 0}; return true; }
    const int kpos = PAST - 512 + i, dlt = C.pos - kpos; if (dlt < 0 || dlt >= 512) return false;
    const float* r = (i < 512) ? C.state_win + ((size_t)C.b * 512 + i) * 1024 + C.g * 128 : C.out + O_WINS + ((size_t)C.b * 512 + 508 + (i - 512)) * 1024 + C.g * 128;
    kr = KRow{r, 1}; vr = KRow{r + 512, 1}; return true;
}
template <int BR>
__device__ __forceinline__ void vattn_branch(const VAttnCtx& C, LAS float* L, int nkeys, const LAS int* sel_idx, float (&oacc)[4][2], float (&lsum)[4]) {
    int tid = threadIdx.x; asm volatile("" : "+v"(tid)); const int lane = tid & 63, wave = tid >> 6;
    LAS float* q = L; LAS float* sc = L + 512; LAS float* red = L + 4864; LAS float* opart = L + 5120;
    float lmax[4] = {-__builtin_inff(), -__builtin_inff(), -__builtin_inff(), -__builtin_inff()};
    for (int k = tid; k < nkeys; k += NTHR) { KRow kr{nullptr, 0}, vr{nullptr, 0}; bool ok;
        if (BR == 0) { ok = (16 * k + 31) <= C.pos; kr = KRow{C.KC + (size_t)k * 128, 0}; }
        else if (BR == 1) ok = sel_key(C, sel_idx[k >> 6], k & 63, kr, vr);
        else ok = win_key(C, k, kr, vr);
        float s[4] = {0.f, 0.f, 0.f, 0.f};
        if (ok) {
            if (kr.f32) { for (int c = 0; c < 2; ++c) { f32x4 v[16];
#pragma unroll
                    for (int u = 0; u < 16; ++u) v[u] = *((const f32x4*)kr.p + c * 16 + u);
#pragma unroll
                    for (int u = 0; u < 16; ++u)
#pragma unroll
                        for (int r = 0; r < 4; ++r) { const f32x4 qq = *(const LAS f32x4*)(q + r * 128 + c * 64 + u * 4); s[r] += (qq[0] * v[u][0] + qq[1] * v[u][1]) + (qq[2] * v[u][2] + qq[3] * v[u][3]); } } }
            else { v4u w[16];
#pragma unroll
                    for (int u = 0; u < 16; ++u) w[u] = *((const v4u*)kr.p + u);
#pragma unroll
                    for (int u = 0; u < 16; ++u) { const float kv[8] = {bf2f(w[u].x & 0xffff), bf2f(w[u].x >> 16), bf2f(w[u].y & 0xffff), bf2f(w[u].y >> 16), bf2f(w[u].z & 0xffff), bf2f(w[u].z >> 16), bf2f(w[u].w & 0xffff), bf2f(w[u].w >> 16)};
#pragma unroll
                        for (int r = 0; r < 4; ++r) { const LAS float* qq = q + r * 128 + u * 8;
#pragma unroll
                            for (int j = 0; j < 8; ++j) s[r] += qq[j] * kv[j]; } } } }
#pragma unroll
        for (int r = 0; r < 4; ++r) { s[r] = ok ? s[r] * 0.08838834764831845f : -__builtin_inff(); sc[k * 4 + r] = s[r]; lmax[r] = fmaxf(lmax[r], s[r]); } }
#pragma unroll
    for (int r = 0; r < 4; ++r) { lmax[r] = wave_max(lmax[r]); if (lane == 0) red[wave * 4 + r] = lmax[r]; }
    __syncthreads();
    float m[4];
#pragma unroll
    for (int r = 0; r < 4; ++r) { float v = red[r]; for (int w = 1; w < 8; ++w) v = fmaxf(v, red[w * 4 + r]); m[r] = v; }
    __syncthreads();
    float ls[4] = {0.f, 0.f, 0.f, 0.f};
    for (int k = tid; k < nkeys; k += NTHR) {
#pragma unroll
        for (int r = 0; r < 4; ++r) { const float s = sc[k * 4 + r]; const float p = (s == -__builtin_inff()) ? 0.f : __expf(s - m[r]); sc[k * 4 + r] = p; ls[r] += p; } }
#pragma unroll
    for (int r = 0; r < 4; ++r) { ls[r] = wave_sum(ls[r]); if (lane == 0) red[wave * 4 + r] = ls[r]; }
    __syncthreads();
#pragma unroll
    for (int r = 0; r < 4; ++r) { float v = 0.f; for (int w = 0; w < 8; ++w) v += red[w * 4 + r]; lsum[r] = v; }
    float o[4][2] = {{0.f, 0.f}, {0.f, 0.f}, {0.f, 0.f}, {0.f, 0.f}};
    for (int k0 = wave; k0 < nkeys; k0 += 256) { f32x2 vv[32];
#pragma unroll
        for (int u = 0; u < 32; ++u) { const int k = k0 + 8 * u; KRow kr{nullptr, 0}, vr{nullptr, 0}; bool ok = k < nkeys; vv[u] = (f32x2){0.f, 0.f};
            if (ok) { if (BR == 0) { ok = (16 * k + 31) <= C.pos; vr = KRow{C.VC + (size_t)k * 128, 0}; } else if (BR == 1) ok = sel_key(C, sel_idx[k >> 6], k & 63, kr, vr); else ok = win_key(C, k, kr, vr); }
            if (ok) vv[u] = krow_load2(vr, lane); }
#pragma unroll
        for (int u = 0; u < 32; ++u) { const int k = k0 + 8 * u; if (k < nkeys) { const f32x4 p = *(const LAS f32x4*)(sc + k * 4);
#pragma unroll
                for (int r = 0; r < 4; ++r) { o[r][0] += p[r] * vv[u][0]; o[r][1] += p[r] * vv[u][1]; } } } }
#pragma unroll
    for (int r = 0; r < 4; ++r) { opart[(wave * 4 + r) * 128 + 2 * lane] = o[r][0]; opart[(wave * 4 + r) * 128 + 2 * lane + 1] = o[r][1]; }
    __syncthreads();
    if (wave == 0) {
#pragma unroll
        for (int r = 0; r < 4; ++r) { float a0 = 0.f, a1 = 0.f; for (int w = 0; w < 8; ++w) { a0 += opart[(w * 4 + r) * 128 + 2 * lane]; a1 += opart[(w * 4 + r) * 128 + 2 * lane + 1]; } oacc[r][0] = a0; oacc[r][1] = a1; } }
    __syncthreads();
}
template <class QF, class EmitF>
__device__ __forceinline__ void vattn_unit(const VAttnCtx& C, LAS float* L, const QF& qf, const float* gates_row, const EmitF& emit) {
    int tid = threadIdx.x; asm volatile("" : "+v"(tid)); const int lane = tid & 63, wave = tid >> 6;
    LAS float* sc = L + 512; LAS float* imp = L + 9216; LAS float* score = L + 10240; LAS int* idx = (LAS int*)(L + 10512);
    L[tid] = qf(tid >> 7, tid & 127);
    __syncthreads();
    float ocmp[4][2], osel[4][2], owin[4][2], lc[4], lsl[4], lw[4];
    vattn_branch<0>(C, L, C.n_cmp, nullptr, ocmp, lc);
    for (int c = tid; c < 1024; c += NTHR) { float v = 0.f; if (c < C.n_cmp) {
#pragma unroll
            for (int r = 0; r < 4; ++r) v += lc[r] > 0.f ? sc[c * 4 + r] / lc[r] : 0.f; } imp[c] = v; }
    __syncthreads();
    const int cur = C.pos >> 6;
    if (tid < C.n_blk) { float v = 0.f; for (int c = 4 * tid - 1; c <= 4 * tid + 3; ++c) if (c >= 0 && c < C.n_cmp) v += imp[c];
        const bool visible = tid <= cur, forced = (tid == 0) || (visible && tid > cur - 2); score[tid] = forced ? 1e9f : (visible ? v : -1e9f); }
    __syncthreads();
    if (tid < C.n_blk) { const float s = score[tid]; int rank = 0; for (int j = 0; j < C.n_blk; ++j) { const float o = score[j]; rank += (o > s || (o == s && j < tid)) ? 1 : 0; } if (rank < 16) idx[rank] = tid; }
    __syncthreads();
    vattn_branch<1>(C, L, 16 * 64, idx, osel, lsl);
    vattn_branch<2>(C, L, C.smp ? 516 : 512, nullptr, owin, lw);
    if (wave == 0) {
#pragma unroll
        for (int r = 0; r < 4; ++r) { const int h = 4 * C.g + r; const float g0 = gates_row[h], g1 = gates_row[16 + h], g2 = gates_row[32 + h];
            const float s0 = lc[r] > 0.f ? g0 / lc[r] : 0.f, s1 = lsl[r] > 0.f ? g1 / lsl[r] : 0.f, s2 = lw[r] > 0.f ? g2 / lw[r] : 0.f;
            emit(r, 2 * lane, ocmp[r][0] * s0 + osel[r][0] * s1 + owin[r][0] * s2); emit(r, 2 * lane + 1, ocmp[r][1] * s0 + osel[r][1] * s1 + owin[r][1] * s2); } }
    __syncthreads();
}

__device__ __forceinline__ bool p4_sample_attention(Frame& F, const float* cache_sel, const float* state_win, const int* page_table, int max_tasks) {
    unsigned char* ws = F.ws;
    unsigned* counter = (unsigned*)(F.ctl + CW_TMO + 16);
    for (int done_ = 0; done_ < max_tasks; ++done_) { const int it = next_work(F, counter); if (it >= 128) return false; unsigned lb_ = 0; asm volatile("" : "+s"(lb_)); LAS float* L = (LAS float*)(F.lds + RING_OFF + lb_);
        const int b = it >> 4, g = (it >> 2) & 3, t = it & 3, bg = b * 4 + g, sr = b * 4 + t;
        VAttnCtx C{}; C.smp = 1; C.b = b; C.g = g; C.t = t; C.pos = PAST + t; C.KC = (const bf16*)(ws + WS_KCS) + (size_t)(0 * 32 + bg) * 1024 * 128; C.VC = (const bf16*)(ws + WS_KCS) + (size_t)(1 * 32 + bg) * 1024 * 128;
        C.n_cmp = 1023; C.n_blk = 257; C.cache_sel = cache_sel; C.state_win = state_win; C.out = F.out; C.page_table = page_table;
        const float* qs = (const float*)(ws + WS_QS) + (size_t)sr * DM + 4 * g * 128; bf16* ao = (bf16*)(ws + WS_AOS) + (size_t)sr * DM + 4 * g * 128;
        vattn_unit(C, L, [=](int r, int d) { return qs[r * 128 + d]; }, (const float*)(ws + WS_GATES) + (size_t)(MP + sr) * 48, [=](int r, int d, float v) { ao[r * 128 + d] = (bf16)f2bf(v); }); }
    return true;
}
__device__ __forceinline__ void p4_all(Frame& F, const P0Args& A, const float* cache_sel, const float* state_win, const int* page_table) {
    unsigned char* ws = F.ws; unsigned* counter = (unsigned*)(F.ctl + CW_TMO + 32); unsigned* conv = (unsigned*)(F.ctl + CW_TMO + 48); bool conv_left = true, smp_left = true;
    for (;;) { const int u = next_work(F, counter); if (u >= 512) break; const int qb = 63 - (u >> 3), b = (u >> 2) & 1, g = u & 3;
        att::attn_unit((char*)F.lds, b, g, qb, (const bf16*)(ws + WS_Q), (const bf16*)(ws + WS_KCP), (const bf16*)(ws + WS_KV), (const float*)(ws + WS_GATES), (bf16*)(ws + WS_AO));
        if (smp_left) smp_left = p4_sample_attention(F, cache_sel, state_win, page_table, 1);
        if (conv_left) { const int c = next_work(F, conv); if (c < N_CONV_CHUNKS) convert_chunk(F, A, c); else if (c < N_CONV_CHUNKS + N_WIN_PIECES) win_copy_piece(F, A, c - N_CONV_CHUNKS); else conv_left = false; } }
    while (smp_left) smp_left = p4_sample_attention(F, cache_sel, state_win, page_table, 1);
    while (conv_left) { const int c = next_work(F, conv); if (c < N_CONV_CHUNKS) convert_chunk(F, A, c); else if (c < N_CONV_CHUNKS + N_WIN_PIECES) win_copy_piece(F, A, c - N_CONV_CHUNKS); else conv_left = false; }
}
__device__ __forceinline__ float rstd_of(const float* ssq, int row) { return 1.0f / sqrtf(ssq[row] * (1.f / DM) + 1e-6f); }

template <bool FIRST> struct EpiResid {
    static constexpr bool PERM = false, AFTER_DRAIN = false;
    const float* X; bf16* HB; float* ssq;
    __device__ __forceinline__ void operator()(const pg8::f32x4 (&acc)[2][2][4][2], const pg8::Unit& u, int wr, int wc, int fr_, int fq_) const {
        int fr = fr_, fq = fq_; asm volatile("" : "+v"(fr), "+v"(fq));
        const int col0 = u.pn * 256 + wc * 32 + 4 * fq, row0 = u.pm * 256 + wr * 64 + fr;
        f32x4 xb[2][4]; v2u hb[2][4];
        auto ld = [&](int it, int sset) { const size_t off = (size_t)(row0 + (it >> 2) * 128 + (it & 3) * 16) * DM + col0;
#pragma unroll
            for (int q = 0; q < 4; ++q) { const size_t o = off + (q >> 1) * 128 + (q & 1) * 16;
                if (FIRST) xb[sset][q] = __builtin_nontemporal_load((const GAS f32x4*)(X + o)); else hb[sset][q] = *(const GAS v2u*)(HB + o); } };
        ld(0, 0);
#pragma unroll
        for (int it = 0; it < 8; ++it) { if (it + 1 < 8) ld(it + 1, (it + 1) & 1);
            const int ai = it >> 2, m = it & 3, row = row0 + ai * 128 + m * 16; const size_t off = (size_t)row * DM + col0; float sum = 0.f;
#pragma unroll
            for (int q = 0; q < 4; ++q) { const int bj = q >> 1, n = q & 1; f32x4 h;
                if (FIRST) h = xb[it & 1][q]; else { const v2u w = hb[it & 1][q]; h = (f32x4){bf2f(w.x & 0xffff), bf2f(w.x >> 16), bf2f(w.y & 0xffff), bf2f(w.y >> 16)}; }
                h += acc[ai][bj][m][n]; sum += (h[0] * h[0] + h[1] * h[1]) + (h[2] * h[2] + h[3] * h[3]); *(GAS v2u*)(HB + off + bj * 128 + n * 16) = pk4(h); }
            sum += __shfl_xor(sum, 16); sum += __shfl_xor(sum, 32);
            if (fq == 0) atomicAdd(ssq + row, sum); }
    }
};
constexpr int LDH = DFF + 64;
struct EpiFfn1 {
    static constexpr bool PERM = true, AFTER_DRAIN = false;
    bf16* O; const float* ssq;
    __device__ __forceinline__ void operator()(const pg8::f32x4 (&acc)[2][2][4][2], const pg8::Unit& u, int wr, int wc, int fr, int fq) const {
        const int col0 = u.pn * 256 + wc * 32 + 8 * fq;
        float rs8[8];
#pragma unroll
        for (int it = 0; it < 8; ++it) rs8[it] = rstd_of(ssq, u.pm * 256 + (it >> 2) * 128 + wr * 64 + (it & 3) * 16 + fr);
#pragma unroll
        for (int ai = 0; ai < 2; ++ai)
#pragma unroll
            for (int m = 0; m < 4; ++m) { const int row = u.pm * 256 + ai * 128 + wr * 64 + m * 16 + fr; const float rs = rs8[ai * 4 + m]; bf16* rowp = O + (size_t)row * LDH + col0;
#pragma unroll
                for (int bj = 0; bj < 2; ++bj) { f32x4 v0 = acc[ai][bj][m][0] * rs, v1 = acc[ai][bj][m][1] * rs;
#pragma unroll
                    for (int j = 0; j < 4; ++j) { const float a = fmaxf(v0[j], 0.f), b = fmaxf(v1[j], 0.f); v0[j] = a * a; v1[j] = b * b; }
                    v4u w; w.x = pk2(v0[0], v0[1]); w.y = pk2(v0[2], v0[3]); w.z = pk2(v1[0], v1[1]); w.w = pk2(v1[2], v1[3]); *(GAS v4u*)(rowp + bj * 128) = w; } }
    }
};
__device__ __forceinline__ size_t ft_off(int t, int d) { return ((size_t)(((t >> 5) * 16 + (d >> 4)) * 64 + ((d >> 3) & 1) * 32 + (t & 31))) * 8 + (d & 7); }
__device__ __forceinline__ float siluf_(float x) { return x * __builtin_amdgcn_rcpf(1.0f + __expf(-x)); }
struct EpiRetIn {
    static constexpr bool PERM = true, AFTER_DRAIN = false;
    bf16 *RQ, *RK, *RV, *RG, *RKT; const float* rope; const float* ssq;
    __device__ __forceinline__ void operator()(const pg8::f32x4 (&acc)[2][2][4][2], const pg8::Unit& u, int wr, int wc, int fr_, int fq_) const {
        int fr = fr_, fq = fq_; asm volatile("" : "+v"(fr), "+v"(fq));
        const int pn = u.pn, cw = wc * 32 + 8 * fq;
        float rs8[8];
#pragma unroll
        for (int it = 0; it < 8; ++it) rs8[it] = rstd_of(ssq, u.pm * 256 + (it >> 2) * 128 + wr * 64 + (it & 3) * 16 + fr);
        if (pn < 16) {
            const int h = pn & 7; const float scq = pn < 8 ? 1.0f : 0.0625f; bf16* base = (pn < 8 ? RQ : RK);
            f32x4 cs[2][4];
            auto ldr = [&](int it, int sset) { const int t = (u.pm * 256 + (it >> 2) * 128 + wr * 64 + (it & 3) * 16 + fr) & 4095; const float* rp = rope + ((size_t)t * 128 + cw) * 2;
#pragma unroll
                for (int q = 0; q < 4; ++q) cs[sset][q] = *(const GAS f32x4*)(rp + 4 * q); };
            ldr(0, 0);
#pragma unroll
            for (int it = 0; it < 8; ++it) { if (it + 1 < 8) ldr(it + 1, (it + 1) & 1);
                const int ai = it >> 2, m = it & 3, row = u.pm * 256 + ai * 128 + wr * 64 + m * 16 + fr, b = row >> 12, t = row & 4095; const float sc = rs8[it] * scq;
                bf16* dst = base + (size_t)(b * 8 + h) * SEQ * 256; v4u w1, w2;
#pragma unroll
                for (int n = 0; n < 2; ++n) { const f32x4 csA = cs[it & 1][2 * n], csB = cs[it & 1][2 * n + 1];
                    f32x4 o1, o2; rope4(acc[ai][0][m][n] * sc, acc[ai][1][m][n] * sc, csA, csB, o1, o2);
                    if (n == 0) { w1.x = pk2(o1[0], o1[1]); w1.y = pk2(o1[2], o1[3]); w2.x = pk2(o2[0], o2[1]); w2.y = pk2(o2[2], o2[3]); } else { w1.z = pk2(o1[0], o1[1]); w1.w = pk2(o1[2], o1[3]); w2.z = pk2(o2[0], o2[1]); w2.w = pk2(o2[2], o2[3]); } }
                *(GAS v4u*)(dst + ft_off(t, cw)) = w1; *(GAS v4u*)(dst + ft_off(t, cw + 128)) = w2; }
        } else if (pn < 32) {
            const int h = (pn - 16) >> 1, c0 = ((pn - 16) & 1) * 256 + cw;
#pragma unroll
            for (int ai = 0; ai < 2; ++ai)
#pragma unroll
                for (int m = 0; m < 4; ++m) { const int row = u.pm * 256 + ai * 128 + wr * 64 + m * 16 + fr, b = row >> 12, t = row & 4095; const float rs = rs8[ai * 4 + m];
                    bf16* dst = RV + ((size_t)(b * 8 + h) * SEQ + t) * 512 + c0;
#pragma unroll
                    for (int bj = 0; bj < 2; ++bj) { const f32x4 v0 = acc[ai][bj][m][0] * rs, v1 = acc[ai][bj][m][1] * rs; v4u w; w.x = pk2(v0[0], v0[1]); w.y = pk2(v0[2], v0[3]); w.z = pk2(v1[0], v1[1]); w.w = pk2(v1[2], v1[3]); *(GAS v4u*)(dst + bj * 128) = w; } }
        } else {
#pragma unroll
            for (int ai = 0; ai < 2; ++ai)
#pragma unroll
                for (int m = 0; m < 4; ++m) { const int row = u.pm * 256 + ai * 128 + wr * 64 + m * 16 + fr; const float rs = rs8[ai * 4 + m];
                    bf16* dst = RG + (size_t)row * 4096 + (pn - 32) * 256 + cw;
#pragma unroll
                    for (int bj = 0; bj < 2; ++bj) { const f32x4 v0 = acc[ai][bj][m][0] * rs, v1 = acc[ai][bj][m][1] * rs; v4u w; w.x = pk2(siluf_(v0[0]), siluf_(v0[1])); w.y = pk2(siluf_(v0[2]), siluf_(v0[3])); w.z = pk2(siluf_(v1[0]), siluf_(v1[1])); w.w = pk2(siluf_(v1[2]), siluf_(v1[3])); *(GAS v4u*)(dst + bj * 128) = w; } }
        }
    }
};

constexpr int CW_PANEL = 8192;
__device__ __forceinline__ float ld_ssq(const float* p) { return __uint_as_float(__hip_atomic_load((const unsigned*)p, __ATOMIC_RELAXED, __HIP_MEMORY_SCOPE_AGENT)); }
struct EpiFinal {
    static constexpr bool PERM = false, AFTER_DRAIN = true;
    const bf16* HB; float* ssq; unsigned* cnt; const float* gfin; float* y;
    __device__ __forceinline__ void fused(pg8::f32x4 (&acc)[2][2][4][2], const pg8::Unit& u, int wr, int wc, int fr_, int fq_, PG8_LAS unsigned char* lds, int wid, int lane) const {
        int fr = fr_, fq = fq_; asm volatile("" : "+v"(fr), "+v"(fq));
        const int col0 = u.pn * 256 + wc * 32 + 4 * fq, row0 = u.pm * 256 + wr * 64 + fr;
        { v2u hb[2][4];
          auto ld = [&](int it, int sset) { const size_t off = (size_t)(row0 + (it >> 2) * 128 + (it & 3) * 16) * DM + col0;
#pragma unroll
              for (int q = 0; q < 4; ++q) hb[sset][q] = *(const GAS v2u*)(HB + off + (q >> 1) * 128 + (q & 1) * 16); };
          ld(0, 0);
#pragma unroll
          for (int it = 0; it < 8; ++it) { if (it + 1 < 8) ld(it + 1, (it + 1) & 1);
              const int ai = it >> 2, m = it & 3, row = row0 + ai * 128 + m * 16; float sum = 0.f;
#pragma unroll
              for (int q = 0; q < 4; ++q) { const int bj = q >> 1, n = q & 1; const v2u w = hb[it & 1][q]; f32x4 h = (f32x4){bf2f(w.x & 0xffff), bf2f(w.x >> 16), bf2f(w.y & 0xffff), bf2f(w.y >> 16)};
                  h += acc[ai][bj][m][n]; acc[ai][bj][m][n] = h; sum += (h[0] * h[0] + h[1] * h[1]) + (h[2] * h[2] + h[3] * h[3]); }
              sum += __shfl_xor(sum, 16); sum += __shfl_xor(sum, 32);
              if (fq == 0) atomicAdd(ssq + row, sum); } }
        asm volatile("s_waitcnt vmcnt(0)" ::: "memory");
        __syncthreads();
        unsigned* c = cnt + 64 * u.pm;
        if (wid == 0) { if (lane == 0) __hip_atomic_fetch_add(c, 1u, __ATOMIC_RELAXED, __HIP_MEMORY_SCOPE_AGENT);
            unsigned sp = 0; while ((unsigned)__builtin_amdgcn_readfirstlane((int)__hip_atomic_load(c, __ATOMIC_RELAXED, __HIP_MEMORY_SCOPE_AGENT)) < 8u) { __builtin_amdgcn_s_sleep(2); if (++sp > (1u << 20)) break; }
            __builtin_amdgcn_fence(__ATOMIC_ACQUIRE, "agent"); }
        asm volatile("s_waitcnt vmcnt(0) lgkmcnt(0)" ::: "memory");
        __syncthreads();
        float rs8[8]; f32x4 g4[4];
#pragma unroll
        for (int it = 0; it < 8; ++it) rs8[it] = ld_ssq(ssq + row0 + (it >> 2) * 128 + (it & 3) * 16);
#pragma unroll
        for (int q = 0; q < 4; ++q) g4[q] = *(const GAS f32x4*)(gfin + col0 + (q >> 1) * 128 + (q & 1) * 16);
#pragma unroll
        for (int it = 0; it < 8; ++it) rs8[it] = 1.0f / sqrtf(rs8[it] * (1.f / DM) + 1e-6f);
#pragma unroll
        for (int ai = 0; ai < 2; ++ai)
#pragma unroll
            for (int m = 0; m < 4; ++m) { const int row = row0 + ai * 128 + m * 16; const size_t off = (size_t)row * DM + col0; const float rs = rs8[ai * 4 + m];
#pragma unroll
                for (int q = 0; q < 4; ++q) { const int bj = q >> 1, n = q & 1; __builtin_nontemporal_store(acc[ai][bj][m][n] * rs * g4[q], (GAS f32x4*)(y + off + bj * 128 + n * 16)); } }
    }
};
__device__ __forceinline__ void skinny_final(Frame& F, const bf16* A, const bf16* Wt, int K, const float* Hin, float* ssq_s, unsigned* cnt, const float* gfin, float* ys) {
    const int lane = F.lane, r16 = lane & 15, q4 = lane >> 4;
    LAS float* red = (LAS float*)(F.lds + RING_OFF);
    for (int sl = blockIdx.x; sl < DM / 32; sl += F.G) { f32x4 acc[2][2]; skinny_mma_wg(red, A, Wt, K, 32 * sl, F.wave, lane, acc);
        if (F.wave != 0) continue;
#pragma unroll
        for (int rh = 0; rh < 2; ++rh) { const int sr = rh * 16 + r16; float s = 0.f;
#pragma unroll
            for (int cs = 0; cs < 2; ++cs) { const int col = 32 * sl + cs * 16 + 4 * q4; const f32x4 h = *(const f32x4*)(Hin + (size_t)sr * DM + col) + acc[rh][cs]; acc[rh][cs] = h; s += (h[0] * h[0] + h[1] * h[1]) + (h[2] * h[2] + h[3] * h[3]); }
            s += __shfl_xor(s, 16); s += __shfl_xor(s, 32);
            if (q4 == 0) atomicAdd(ssq_s + sr, s); }
        asm volatile("s_waitcnt vmcnt(0)" ::: "memory");
        if (lane == 0) __hip_atomic_fetch_add(cnt, 1u, __ATOMIC_RELAXED, __HIP_MEMORY_SCOPE_AGENT);
        { unsigned sp = 0; while ((unsigned)__builtin_amdgcn_readfirstlane((int)__hip_atomic_load(cnt, __ATOMIC_RELAXED, __HIP_MEMORY_SCOPE_AGENT)) < (unsigned)(DM / 32)) { __builtin_amdgcn_s_sleep(2); if (++sp > (1u << 20)) break; } }
        __builtin_amdgcn_fence(__ATOMIC_ACQUIRE, "agent");
#pragma unroll
        for (int rh = 0; rh < 2; ++rh) { const int sr = rh * 16 + r16; const float rs = 1.0f / sqrtf(ld_ssq(ssq_s + sr) * (1.f / DM) + 1e-6f);
#pragma unroll
            for (int cs = 0; cs < 2; ++cs) { const int col = 32 * sl + cs * 16 + 4 * q4; *(f32x4*)(ys + (size_t)sr * DM + col) = acc[rh][cs] * rs * *(const f32x4*)(gfin + col); } } }
}
__device__ __forceinline__ void skinny_resid(Frame& F, const bf16* A, const bf16* Wt, int K, const float* Hin, float* H, bf16* XNs, float* ssq_s) {
    const int lane = F.lane, r16 = lane & 15, q4 = lane >> 4;
    LAS float* red = (LAS float*)(F.lds + RING_OFF);
    for (int sl = blockIdx.x; sl < DM / 32; sl += F.G) { f32x4 acc[2][2]; skinny_mma_wg(red, A, Wt, K, 32 * sl, F.wave, lane, acc);
        if (F.wave != 0) continue;
#pragma unroll
        for (int rh = 0; rh < 2; ++rh) { const int sr = rh * 16 + r16; float s = 0.f;
#pragma unroll
            for (int cs = 0; cs < 2; ++cs) { const int col = 32 * sl + cs * 16 + 4 * q4; const size_t off = (size_t)sr * DM + col; const f32x4 h = *(const f32x4*)(Hin + off) + acc[rh][cs]; *(f32x4*)(H + off) = h;
                s += (h[0] * h[0] + h[1] * h[1]) + (h[2] * h[2] + h[3] * h[3]); *(v2u*)(XNs + off) = pk4(h); }
            s += __shfl_xor(s, 16); s += __shfl_xor(s, 32);
            if (q4 == 0) atomicAdd(ssq_s + sr, s); } }
}
__device__ __forceinline__ void skinny_ffn1(Frame& F, const bf16* A, const bf16* Wt, bf16* HFFs, const float* ssq_s) {
    const int lane = F.lane, r16 = lane & 15, q4 = lane >> 4;
    LAS float* red = (LAS float*)(F.lds + RING_OFF);
    for (int sl = blockIdx.x; sl < DFF / 32; sl += F.G) { f32x4 acc[2][2]; skinny_mma_wg(red, A, Wt, DM, 32 * sl, F.wave, lane, acc);
        if (F.wave != 0) continue;
#pragma unroll
        for (int rh = 0; rh < 2; ++rh) { const int sr = rh * 16 + r16; const float rs = rstd_of(ssq_s, sr);
#pragma unroll
            for (int cs = 0; cs < 2; ++cs) { f32x4 v = acc[rh][cs] * rs;
#pragma unroll
                for (int j = 0; j < 4; ++j) { const float a = fmaxf(v[j], 0.f); v[j] = a * a; }
                *(v2u*)(HFFs + (size_t)sr * DFF + 32 * sl + cs * 16 + 4 * q4) = pk4(v); } } }
}
__device__ __forceinline__ void skinny_retin(Frame& F, const bf16* A, const bf16* Wt, const float* rope, const float* ssq_s, float* RSQ, float* RSK, float* RSV, float* RSG) {
    const int lane = F.lane, r16 = lane & 15, q4 = lane >> 4;
    LAS float* red = (LAS float*)(F.lds + RING_OFF);
    const int nsl = (F.G == 256) ? (((int)blockIdx.x < 64) ? 1 : (((int)blockIdx.x < 128) ? 2 : 1)) : 0;
    for (int k = 0; (F.G == 256) ? (k < nsl) : ((int)blockIdx.x + k * F.G < 64 + 256); ++k) {
        const int task = (F.G == 256) ? (((int)blockIdx.x < 64) ? (int)blockIdx.x : 64 + ((int)blockIdx.x - 64) + 192 * k) : (int)blockIdx.x + k * F.G;
        if (task < 64) { const int hh = task >> 2, wc = task & 3; f32x4 a1[2][2], a2[2][2]; skinny_mma_wg(red, A, Wt, DM, hh * 256 + wc * 32, F.wave, lane, a1); skinny_mma_wg(red, A, Wt, DM, hh * 256 + 128 + wc * 32, F.wave, lane, a2);
            if (F.wave != 0) continue;
#pragma unroll
            for (int rh = 0; rh < 2; ++rh) { const int sr = rh * 16 + r16, t = sr & 3; const float rs = rstd_of(ssq_s, sr) * (hh < 8 ? 1.f : 0.0625f); float* dst = (hh < 8 ? RSQ : RSK) + (size_t)sr * 2048 + (hh & 7) * 256;
#pragma unroll
                for (int cs = 0; cs < 2; ++cs) { const int d = wc * 32 + cs * 16 + 4 * q4; const f32x4 csA = *(const f32x4*)(rope + ((size_t)(4096 + t) * 128 + d) * 2), csB = *(const f32x4*)(rope + ((size_t)(4096 + t) * 128 + d) * 2 + 4);
                    f32x4 o1, o2; rope4(a1[rh][cs] * rs, a2[rh][cs] * rs, csA, csB, o1, o2); *(f32x4*)(dst + d) = o1; *(f32x4*)(dst + 128 + d) = o2; } } }
        else { const int sl = task - 64, col0 = 4096 + 32 * sl; f32x4 acc[2][2]; skinny_mma_wg(red, A, Wt, DM, col0, F.wave, lane, acc);
            if (F.wave != 0) continue;
#pragma unroll
            for (int rh = 0; rh < 2; ++rh) { const int sr = rh * 16 + r16; const float rs = rstd_of(ssq_s, sr);
#pragma unroll
                for (int cs = 0; cs < 2; ++cs) { const int c = 32 * sl + cs * 16 + 4 * q4; f32x4 v = acc[rh][cs] * rs;
                    if (c < 4096) *(f32x4*)(RSV + (size_t)sr * 4096 + c) = v; else *(f32x4*)(RSG + (size_t)sr * 4096 + (c - 4096)) = (f32x4){siluf_(v[0]), siluf_(v[1]), siluf_(v[2]), siluf_(v[3])}; } } }
    }
}
namespace ret {
typedef float f32x16 __attribute__((ext_vector_type(16)));
__device__ __forceinline__ float log2_gamma(int h) { return log2f(1.0f - exp2f(-5.0f - (float)h)); }
__device__ __forceinline__ int crow(int r, int hi) { return (r & 3) + 8 * (r >> 2) + 4 * hi; }
__device__ __forceinline__ void r1_unit(int bh, int c, const bf16* RQ, const bf16* RK, bf16* RS, bf16* RKT, int wid, int lane) {
    const int r32 = lane & 31, hi = lane >> 5, h = bh & 7, ib = wid >> 1; const float l2g = log2_gamma(h);
    { const int jb = wid >> 1, j = jb * 32 + r32; const float kdf = exp2f((float)(127 - j) * l2g); bf16* img = RKT + ((size_t)bh * 32 + c) * 256 * 128;
      const bf16* kf = RK + (size_t)bh * SEQ * 256 + ((size_t)((c * 4 + jb) * 16 + (wid & 1) * 8) * 64 + lane) * 8; bf16x8 fr8[8];
#pragma unroll
      for (int kq = 0; kq < 8; ++kq) fr8[kq] = *(const bf16x8*)(kf + kq * 512);
#pragma unroll
      for (int kq = 0; kq < 8; ++kq)
#pragma unroll
          for (int x = 0; x < 8; ++x) { const int d = ((wid & 1) * 8 + kq) * 16 + hi * 8 + x; img[d * 128 + (j ^ (x << 3))] = (bf16)f2bf(bf2f((unsigned short)fr8[kq][x]) * kdf); } }
    const bf16* qp = RQ + (size_t)bh * SEQ * 256 + ((size_t)((c * 4 + ib) * 16) * 64 + lane) * 8;
    bf16* sp = RS + ((size_t)bh * 32 + c) * 128 * 128;
#pragma unroll
    for (int jj = 0; jj < 2; ++jj) { const int jb = 2 * (wid & 1) + jj;
        if (jb > ib) {
#pragma unroll
            for (int r = 0; r < 16; ++r) { const int j = jb * 32 + r32; sp[((ib * 8 + (j >> 4)) * 64 + ((j >> 3) & 1) * 32 + crow(r, hi)) * 8 + (j & 7)] = 0; }
            continue; }
        const bf16* kp = RK + (size_t)bh * SEQ * 256 + ((size_t)((c * 4 + jb) * 16) * 64 + lane) * 8;
        f32x16 acc = f32x16{};
#pragma unroll
        for (int kk = 0; kk < 16; ++kk) { const bf16x8 a = *(const bf16x8*)(qp + kk * 512), b = *(const bf16x8*)(kp + kk * 512); acc = __builtin_amdgcn_mfma_f32_32x32x16_bf16(a, b, acc, 0, 0, 0); }
#pragma unroll
        for (int r = 0; r < 16; ++r) { const int i = ib * 32 + crow(r, hi), j = jb * 32 + r32; const float v = (i >= j) ? acc[r] * exp2f((float)(i - j) * l2g) : 0.f; sp[((ib * 8 + (j >> 4)) * 64 + ((j >> 3) & 1) * 32 + crow(r, hi)) * 8 + (j & 7)] = (bf16)f2bf(v); }
    }
}
constexpr int VT_LD = 136, ST_LD = 264, L_KT = 0  , L_VT = 65536, L_ST = 74240, L_XC = 91136;
__device__ __forceinline__ void r2_unit(char* lds, int bh, int es, const bf16* RQ, const bf16* RKT, const bf16* RV, const bf16* RS, bf16* RO, float* out_state) {
    int tid = threadIdx.x; asm volatile("" : "+v"(tid));
    const int wid = __builtin_amdgcn_readfirstlane(tid >> 6), lane = tid & 63, r32 = lane & 31, hi = lane >> 5, h = bh & 7, b = bh >> 3;
    const float l2g = log2_gamma(h), gC = exp2f(128.f * l2g);
    char* KT = lds + L_KT; bf16* VT = (bf16*)(lds + L_VT); bf16* ST = (bf16*)(lds + L_ST); float* XC = (float*)(lds + L_XC);
    f32x16 accS = f32x16{};
    for (int i = tid; i < 32 * ST_LD / 2; i += NTHR) ((unsigned*)ST)[i] = 0u;
    const int jq = tid & 31, dg = tid >> 5;
    const int ib = wid & 3;
    v4u kreg[8], vreg[4]; bf16x8 pf[16];
#define R2_LOADKV(c_) do { const bf16* ki_ = RKT + ((size_t)bh * 32 + (c_)) * 256 * 128; const size_t t0_ = (size_t)bh * SEQ + (c_) * 128 + 4 * jq; \
        _Pragma("unroll") for (int i = 0; i < 8; ++i) kreg[i] = *(const v4u*)(ki_ + (size_t)(tid + 512 * i) * 8); \
        if (tid < 128) { _Pragma("unroll") for (int tk = 0; tk < 4; ++tk) vreg[tk] = *(const v4u*)(RV + (t0_ + tk) * 512 + es * 32 + dg * 8); } } while (0)
#define R2_LOADPF(c_) do { if (wid < 4) { const bf16* sr_ = RS + ((size_t)bh * 32 + (c_)) * 128 * 128 + ((size_t)(ib * 8) * 64 + lane) * 8; _Pragma("unroll") for (int kk = 0; kk < 8; ++kk) pf[kk] = *(const bf16x8*)(sr_ + kk * 512); } \
        else { const bf16* qr_ = RQ + (size_t)bh * SEQ * 256 + ((size_t)(((c_) * 4 + ib) * 16) * 64 + lane) * 8; _Pragma("unroll") for (int kk = 0; kk < 16; ++kk) pf[kk] = *(const bf16x8*)(qr_ + kk * 512); } } while (0)
    R2_LOADKV(0); R2_LOADPF(0);
    for (int c = 0; c < 32; ++c) {
#pragma unroll
        for (int i = 0; i < 8; ++i) *(v4u*)(KT + (size_t)(tid + 512 * i) * 16) = kreg[i];
        if (tid < 128) {
#pragma unroll
            for (int x2 = 0; x2 < 4; ++x2) { const unsigned w0 = ((const unsigned*)&vreg[0])[x2], w1 = ((const unsigned*)&vreg[1])[x2], w2 = ((const unsigned*)&vreg[2])[x2], w3 = ((const unsigned*)&vreg[3])[x2];
                v2u lo, hh; lo.x = (w0 & 0xffff) | (w1 << 16); lo.y = (w2 & 0xffff) | (w3 << 16); hh.x = (w0 >> 16) | (w1 & 0xffff0000u); hh.y = (w2 >> 16) | (w3 & 0xffff0000u);
                *(v2u*)(VT + (dg * 8 + 2 * x2) * VT_LD + 4 * jq) = lo; *(v2u*)(VT + (dg * 8 + 2 * x2 + 1) * VT_LD + 4 * jq) = hh; } }
        __syncthreads();
        const int cn = c < 31 ? c + 1 : 31;
        f32x16 aO = f32x16{};
        if (wid < 4) {
#pragma unroll
            for (int kk = 0; kk < 8; ++kk) if (kk < 2 * (ib + 1)) { const bf16x8 bb = *(const bf16x8*)(VT + r32 * VT_LD + kk * 16 + hi * 8); aO = __builtin_amdgcn_mfma_f32_32x32x16_bf16(pf[kk], bb, aO, 0, 0, 0); }
        } else {
#pragma unroll
            for (int kk = 0; kk < 16; ++kk) { const bf16x8 bb = *(const bf16x8*)(ST + r32 * ST_LD + kk * 16 + hi * 8); aO = __builtin_amdgcn_mfma_f32_32x32x16_bf16(pf[kk], bb, aO, 0, 0, 0); }
#pragma unroll
            for (int r = 0; r < 16; ++r) aO[r] *= exp2f((float)(ib * 32 + crow(r, hi) + 1) * l2g);
            f32x4* xp = (f32x4*)(XC + (ib * 64 + lane) * 16);
            xp[0] = (f32x4){aO[0], aO[1], aO[2], aO[3]}; xp[1] = (f32x4){aO[4], aO[5], aO[6], aO[7]}; xp[2] = (f32x4){aO[8], aO[9], aO[10], aO[11]}; xp[3] = (f32x4){aO[12], aO[13], aO[14], aO[15]};
        }
        R2_LOADPF(cn);
        R2_LOADKV(cn);
#pragma unroll
        for (int r = 0; r < 16; ++r) accS[r] *= gC;
#pragma unroll
        for (int kk = 0; kk < 8; ++kk) { const bf16x8 a = *(const bf16x8*)(VT + r32 * VT_LD + kk * 16 + hi * 8), bb = *(const bf16x8*)(KT + (wid * 32 + r32) * 256 + (((kk * 16 + hi * 8) * 2) ^ ((r32 & 7) << 4))); accS = __builtin_amdgcn_mfma_f32_32x32x16_bf16(a, bb, accS, 0, 0, 0); }
        __syncthreads();
#pragma unroll
        for (int r = 0; r < 16; ++r) ST[crow(r, hi) * ST_LD + wid * 32 + r32] = (bf16)f2bf(accS[r]);
        if (wid < 4) { const f32x4* xp = (const f32x4*)(XC + (ib * 64 + lane) * 16); const f32x4 x0 = xp[0], x1 = xp[1], x2 = xp[2], x3 = xp[3];
            const float xc[16] = {x0[0], x0[1], x0[2], x0[3], x1[0], x1[1], x1[2], x1[3], x2[0], x2[1], x2[2], x2[3], x3[0], x3[1], x3[2], x3[3]};
#pragma unroll
            for (int r = 0; r < 16; ++r) RO[((size_t)b * SEQ + c * 128 + ib * 32 + crow(r, hi)) * 4096 + h * 512 + es * 32 + r32] = (bf16)f2bf(aO[r] + xc[r]); }
    }
#undef R2_LOADKV
#undef R2_LOADPF
#pragma unroll
    for (int r = 0; r < 16; ++r) out_state[(((size_t)bh) * 256 + wid * 32 + r32) * 512 + es * 32 + crow(r, hi)] = accS[r];
    __syncthreads();
}
}
__device__ __forceinline__ void p_ret_s(Frame& F) {
    unsigned char* ws = F.ws;
    for (int it = blockIdx.x; it < 512; it += F.G) ret::r1_unit(it >> 5, it & 31, (const bf16*)(ws + WS_RQ), (const bf16*)(ws + WS_RK), (bf16*)(ws + WS_RS), (bf16*)(ws + WS_RKT), F.wave, F.lane);
}
__device__ __forceinline__ void p_ret_scan(Frame& F) {
    unsigned char* ws = F.ws;
    for (int i = blockIdx.x; i < 256; i += F.G) { const int it = ((i & 7) + 8 * (i >> 7)) * 16 + ((i >> 3) & 15); ret::r2_unit((char*)F.lds, it >> 4, it & 15, (const bf16*)(ws + WS_RQ), (const bf16*)(ws + WS_RKT), (const bf16*)(ws + WS_RV), (const bf16*)(ws + WS_RS), (bf16*)(ws + WS_RO), F.out + O_RETP); }
}
__device__ __forceinline__ void p_ret_sample(Frame& F, const float* state_in, const float* RSQ, const float* RSK, const float* RSV, float* ROS) {
    LAS float* L = (LAS float*)(F.lds + RING_OFF);
    const int tid = F.tid;
    for (int it = blockIdx.x; it < 256; it += F.G) { const int bh = it >> 2, eq = it & 3, b = bh >> 3, h = bh & 7; const float l2g = ret::log2_gamma(h);
        for (int i = tid; i < 2048; i += NTHR) { const int isk = i >> 10, tk = (i >> 8) & 3, d = i & 255; L[i] = (isk ? RSK : RSQ)[(size_t)(b * 4 + tk) * 2048 + h * 256 + d]; }
        __syncthreads();
        if (tid < 16) { const int i = tid >> 2, j = tid & 3; float s = 0.f; if (i >= j) { for (int d = 0; d < 256; ++d) s += L[i * 256 + d] * L[1024 + j * 256 + d]; s *= exp2f((float)(i - j) * l2g); } L[2048 + tid] = s; }
        __syncthreads();
        const int e = eq * 128 + (tid & 127), dg = tid >> 7;
        float v[4], kd[4]; for (int j = 0; j < 4; ++j) { v[j] = RSV[(size_t)(b * 4 + j) * 4096 + h * 512 + e]; kd[j] = exp2f((float)(3 - j) * l2g); }
        const float g4 = exp2f(4.f * l2g); float cr[4] = {0.f, 0.f, 0.f, 0.f};
        for (int d0 = dg * 64; d0 < dg * 64 + 64; d0 += 16) { float stv[16];
#pragma unroll
            for (int u = 0; u < 16; ++u) stv[u] = __builtin_nontemporal_load(state_in + ((size_t)bh * 256 + d0 + u) * 512 + e);
#pragma unroll
            for (int u = 0; u < 16; ++u) { const int d = d0 + u; const float st = stv[u]; float ns = g4 * st;
#pragma unroll
                for (int j = 0; j < 4; ++j) { cr[j] += L[j * 256 + d] * st; ns += L[1024 + j * 256 + d] * kd[j] * v[j]; }
                F.out[O_RETS + ((size_t)bh * 256 + d) * 512 + e] = ns; } }
#pragma unroll
        for (int i = 0; i < 4; ++i) L[2112 + (dg * 4 + i) * 128 + (tid & 127)] = cr[i];
        __syncthreads();
        if (tid < 128) {
#pragma unroll
            for (int i = 0; i < 4; ++i) { float c = 0.f; for (int g = 0; g < 4; ++g) c += L[2112 + (g * 4 + i) * 128 + tid]; float inner = 0.f; for (int j = 0; j <= i; ++j) inner += L[2048 + i * 4 + j] * v[j];
                ROS[(size_t)(b * 4 + i) * 4096 + h * 512 + e] = inner + c * exp2f((float)(i + 1) * l2g); } }
        __syncthreads();
    }
}
__device__ __forceinline__ void p_ret_gn(Frame& F, const float* gn, const float* ROS, const float* RSG) {
    unsigned char* ws = F.ws; const int lane = F.lane;
    for (int it4 = F.gw; it4 < MP * 2; it4 += F.NGW) { v4u wo[4], wg[4];
#pragma unroll
        for (int u = 0; u < 4; ++u) { const int it = it4 * 4 + u, row = it >> 3, h = it & 7; wo[u] = __builtin_nontemporal_load((const v4u*)((const bf16*)(ws + WS_RO) + (size_t)row * 4096 + h * 512 + lane * 8)); wg[u] = __builtin_nontemporal_load((const v4u*)((const bf16*)(ws + WS_RG) + (size_t)row * 4096 + h * 512 + lane * 8)); }
#pragma unroll
        for (int u = 0; u < 4; ++u) { const int it = it4 * 4 + u, row = it >> 3, h = it & 7; float o[8], g[8];
            const unsigned a[4] = {wo[u].x, wo[u].y, wo[u].z, wo[u].w}, c[4] = {wg[u].x, wg[u].y, wg[u].z, wg[u].w};
#pragma unroll
            for (int x = 0; x < 4; ++x) { o[2 * x] = bf2f(a[x] & 0xffff); o[2 * x + 1] = bf2f(a[x] >> 16); g[2 * x] = bf2f(c[x] & 0xffff); g[2 * x + 1] = bf2f(c[x] >> 16); }
            float s = 0.f;
#pragma unroll
            for (int x = 0; x < 8; ++x) s += o[x];
            const float mu = wave_sum(s) * (1.f / 512.f); float q = 0.f;
#pragma unroll
            for (int x = 0; x < 8; ++x) { o[x] -= mu; q += o[x] * o[x]; }
            const float rs = 1.0f / sqrtf(wave_sum(q) * (1.f / 512.f) + 1e-5f); const float* gw = gn + h * 512 + lane * 8;
            v4u w; float y[8];
#pragma unroll
            for (int x = 0; x < 8; ++x) y[x] = g[x] * (o[x] * rs * gw[x]);
            w.x = pk2(y[0], y[1]); w.y = pk2(y[2], y[3]); w.z = pk2(y[4], y[5]); w.w = pk2(y[6], y[7]);
            *(v4u*)((bf16*)(ws + WS_RGA) + (size_t)row * 4096 + h * 512 + lane * 8) = w; } }
    for (int it = F.gw; it < NS * 8; it += F.NGW) { const int row = MP + (it >> 3), h = it & 7; float o[8], g[8];
        { const float* po = ROS + (size_t)(row - MP) * 4096 + h * 512 + lane * 8; const float* pg = RSG + (size_t)(row - MP) * 4096 + h * 512 + lane * 8;
#pragma unroll
            for (int x = 0; x < 8; ++x) { o[x] = po[x]; g[x] = pg[x]; } }
        float s = 0.f;
#pragma unroll
        for (int x = 0; x < 8; ++x) s += o[x];
        const float mu = wave_sum(s) * (1.f / 512.f); float q = 0.f;
#pragma unroll
        for (int x = 0; x < 8; ++x) { o[x] -= mu; q += o[x] * o[x]; }
        const float rs = 1.0f / sqrtf(wave_sum(q) * (1.f / 512.f) + 1e-5f); const float* gw = gn + h * 512 + lane * 8;
        v4u w; float y[8];
#pragma unroll
        for (int x = 0; x < 8; ++x) y[x] = g[x] * (o[x] * rs * gw[x]);
        w.x = pk2(y[0], y[1]); w.y = pk2(y[2], y[3]); w.z = pk2(y[4], y[5]); w.w = pk2(y[6], y[7]);
        *(v4u*)((bf16*)(ws + WS_XS) + (size_t)(row - MP) * 4096 + h * 512 + lane * 8) = w; }
}
__device__ __forceinline__ void p_final_norm(Frame& F, const bf16* HB, const float* HS, const float* g, unsigned skip0, unsigned skip1) {
    const int lane = F.lane;
    for (int m = F.gw; m < MP + NS; m += F.NGW) { const float* xr = HS + (size_t)(m < MP ? 0 : m - MP) * DM; float* yr = m < MP ? F.out + O_YP + (size_t)m * DM : F.out + O_YS + (size_t)(m - MP) * DM;
        const f32x4* x4 = (const f32x4*)xr + lane; f32x4 v[8]; float s = 0.f;
#pragma unroll
        for (int j = 0; j < 8; ++j) { if (m < MP) { const v2u w = ((const v2u*)(HB + (size_t)m * DM) + lane)[64 * j]; v[j] = (f32x4){bf2f(w.x & 0xffff), bf2f(w.x >> 16), bf2f(w.y & 0xffff), bf2f(w.y >> 16)}; } else v[j] = x4[64 * j]; s += (v[j].x * v[j].x + v[j].y * v[j].y) + (v[j].z * v[j].z + v[j].w * v[j].w); }
        const float rstd = 1.0f / sqrtf(wave_sum(s) * (1.f / DM) + 1e-6f);
#pragma unroll
        for (int j = 0; j < 8; ++j) { const f32x4 gg = ((const f32x4*)g + lane)[64 * j]; const f32x4 y = v[j] * rstd * gg; const unsigned flat = (unsigned)(m < MP ? m : m - MP) * DM + 4u * (lane + 64 * j), sk = m < MP ? skip0 : skip1;
            if (flat + 3 < sk) continue;
            if (flat >= sk) __builtin_nontemporal_store(y, (f32x4*)yr + lane + 64 * j); else { for (int c = 0; c < 4; ++c) if (flat + c >= sk) yr[4 * (lane + 64 * j) + c] = y[c]; } } }
}
#if MK_CHECK
constexpr int CW_CHK = 1024;
__device__ __forceinline__ void chk_cmp(Frame& F, int ch, float got, float want, float rtol, float atol) {
    atomicAdd((unsigned*)(F.ctl + CW_CHK + 8 + ch), 1u);
    if (!(fabsf(got - want) <= atol + rtol * fabsf(want))) atomicAdd((unsigned*)(F.ctl + CW_CHK + ch), 1u);
}
__device__ __forceinline__ int chk_row(int i) { return i == 0 ? 0 : i == 1 ? 1 : i == 2 ? 63 : i == 3 ? 64 : i == 4 ? 255 : i == 5 ? 256 : i == 6 ? 3583 : i == 7 ? 3584 : i == 8 ? 4095 : i == 9 ? 4096 : i == 10 ? 8191 : 5000; }
__device__ __forceinline__ float bfr(float x) { return bf2f((unsigned short)f2bf(x)); }
__device__ void check_p1(Frame& F, const float* x_prompt, const float* x_sample, const float* norm_mix, const float* w_in) {
    unsigned char* ws = F.ws;
    const int NR = 12 + 32;
    for (int task = F.gw; task < NR * 41; task += F.NGW) {
        const int ri = task / 41, hh = task % 41, lane = F.lane;
        const bool smp = ri >= 12; const int row = smp ? ri - 12 : chk_row(ri);
        const float* xr = smp ? x_sample + (size_t)row * DM : x_prompt + (size_t)row * DM;
        double ss = 0; for (int k = 0; k < DM; ++k) ss += (double)xr[k] * xr[k];
        const float rstd = 1.0f / sqrtf((float)(ss / DM) + 1e-6f);
        const int b = smp ? row >> 2 : row >> 12, t = smp ? row & 3 : row & 4095; const float pos = smp ? (float)(PAST + t) : (float)t;
        if (hh == 40) {
            if (lane < 48) { double a = 0; for (int k = 0; k < DM; ++k) a += (double)bfr(xr[k] * rstd * norm_mix[k]) * (double)bfr(w_in[(size_t)k * NSA_N + 5120 + lane]);
                const float want = 1.f / (1.f + expf(-(float)a)); const float got = ((const float*)(ws + WS_GATES))[(size_t)(smp ? MP + row : row) * 48 + lane]; chk_cmp(F, 0, got, want, 1e-3f, 1e-3f); }
            continue;
        }
        const int n1 = hh * 128 + lane, n2 = n1 + 64; double a1 = 0, a2 = 0;
        for (int k = 0; k < DM; ++k) { const double xv = (double)bfr(xr[k] * rstd * norm_mix[k]); a1 += xv * (double)bfr(w_in[(size_t)k * NSA_N + n1]); a2 += xv * (double)bfr(w_in[(size_t)k * NSA_N + n2]); }
        float o1 = (float)a1, o2 = (float)a2;
        const bool roped = hh < 16 || (((hh - 16) >> 2) & 1) == 0;
        if (roped) { const float inv = powf(10000.f, -(float)lane / 64.f); const float ang = pos * inv; const double c = cos((double)ang), s = sin((double)ang);
            o1 = (float)(a1 * c - a2 * s); o2 = (float)(a2 * c + a1 * s); }
        if (hh < 16) {
            if (smp) { const float* q = (const float*)(ws + WS_QS) + (size_t)row * DM + hh * 128 + lane; chk_cmp(F, 0, q[0], o1, 2e-3f, 2e-3f); chk_cmp(F, 0, q[64], o2, 2e-3f, 2e-3f); }
            else { const bf16* q = (const bf16*)(ws + WS_Q) + ((size_t)(b * 16 + hh) * SEQ + t) * 128 + lane; chk_cmp(F, 1, bf2f(q[0]), o1, 1e-2f, 1e-2f); chk_cmp(F, 1, bf2f(q[64]), o2, 1e-2f, 1e-2f); }
        } else {
            const int hk = hh - 16, br = hk >> 3, e = (hk >> 2) & 1, g = hk & 3;
            const float* o = nullptr;
            if (smp) o = (br == 0) ? F.out + O_CMPS + (size_t)row * 1024 : (br == 1) ? F.out + O_SELS + (size_t)row * 1024 : F.out + O_WINS + ((size_t)b * 512 + 508 + t) * 1024;
            else { if (br == 0) o = F.out + O_CMPP + (size_t)row * 1024; else if (br == 1) o = F.out + O_SELP + (size_t)row * 1024; else if (t >= SEQ - 512) o = F.out + O_WINP + ((size_t)b * 512 + t - (SEQ - 512)) * 1024; }
            if (o) { o += e * 512 + g * 128 + lane; chk_cmp(F, 0, o[0], o1, 2e-3f, 2e-3f); chk_cmp(F, 0, o[64], o2, 2e-3f, 2e-3f); }
            if (!smp) { const bf16* kv = (br == 0 ? (const bf16*)(ws + WS_KVC) + ((size_t)((e * 2 + b) * 4 + g) * SEQ + t) * 128 : (const bf16*)(ws + WS_KV) + ((size_t)((((br - 1) * 2 + e) * 2 + b) * 4 + g) * SEQ + t) * 128) + lane; chk_cmp(F, 1, bf2f(kv[0]), o1, 1e-2f, 1e-2f); chk_cmp(F, 1, bf2f(kv[64]), o2, 1e-2f, 1e-2f); }
        }
    }
}
__device__ void check_cmp(Frame& F, const float* cache_cmp, const int* page_table, const float* cmp_pos, const float* w1, const float* b1, const float* w2) {
    unsigned char* ws = F.ws; const int lane = F.lane;
    for (int task = F.gw; task < 64 + 8; task += F.NGW) {
        int set, e, b, g, i;
        if (task < 64) { set = task >> 5; e = (task >> 4) & 1; const int bi = (task >> 3) & 1, gi = (task >> 2) & 1, ii = task & 3;
            if (set == 0) { b = bi; g = gi ? 3 : 0; i = ii == 0 ? 0 : ii == 1 ? 1 : ii == 2 ? 127 : 254; } else { b = bi ? 7 : 0; g = gi ? 2 : 1; i = ii == 0 ? 0 : ii == 1 ? 7 : ii == 2 ? 8 : 1022; } }
        else { const int j = task - 64; set = j >> 2; e = (j >> 1) & 1; b = j & 1; g = 1; i = set ? 1023 : 255; }
        const bf16* got = set == 0 ? (const bf16*)(ws + WS_KCP) + (((size_t)e * 8 + b * 4 + g) * 256 + i) * 128 : (const bf16*)(ws + WS_KCS) + (((size_t)e * 32 + b * 4 + g) * 1024 + i) * 128;
        if (task >= 64) { chk_cmp(F, 2, bf2f(got[lane]), 0.f, 0.f, 0.f); chk_cmp(F, 2, bf2f(got[lane + 64]), 0.f, 0.f, 0.f); continue; }
        double h0 = 0, h1 = 0;
        for (int k = 0; k < 4096; ++k) { const int s = k >> 7, d = k & 127, tok = i * 16 + s; float rv;
            if (set == 0) rv = F.out[O_CMPP + ((size_t)b * SEQ + tok) * 1024 + e * 512 + g * 128 + d];
            else { const int page = page_table[b * 128 + (tok >> 7)]; rv = cache_cmp[((size_t)page * 128 + (tok & 127)) * 1024 + e * 512 + g * 128 + d]; }
            const double x = (double)bfr(rv); const float* wr = w1 + ((size_t)e * 4096 + k) * 128; const double pp = (double)cmp_pos[e * 4096 + k];
            h0 += x * (double)bfr(wr[lane]) + pp * (double)wr[lane]; h1 += x * (double)bfr(wr[lane + 64]) + pp * (double)wr[lane + 64]; }
        h0 += b1[e * 128 + lane]; h1 += b1[e * 128 + lane + 64];
        const float a0 = bfr((float)(0.5 * h0 * (1.0 + tanh(0.7978845608028654 * (h0 + 0.044715 * h0 * h0 * h0))))), a1 = bfr((float)(0.5 * h1 * (1.0 + tanh(0.7978845608028654 * (h1 + 0.044715 * h1 * h1 * h1)))));
        double o0 = 0, o1 = 0;
        for (int h = 0; h < 128; ++h) { const float av = __shfl(h < 64 ? a0 : a1, h & 63); const float* wr = w2 + ((size_t)e * 128 + h) * 128; o0 += (double)av * (double)bfr(wr[lane]); o1 += (double)av * (double)bfr(wr[lane + 64]); }
        chk_cmp(F, 2, bf2f(got[lane]), (float)o0, 2e-2f, 1e-2f); chk_cmp(F, 2, bf2f(got[lane + 64]), (float)o1, 2e-2f, 1e-2f);
    }
}
__device__ void check_attn(Frame& F) {
    unsigned char* ws = F.ws; LAS float* L = (LAS float*)(F.lds + RING_OFF);
    for (int it = blockIdx.x; it < 32; it += F.G) { const int b = it >> 4, ti = it & 15, g = (ti + b) & 3, bg = b * 4 + g;
        const int t = ti == 0 ? 0 : ti == 1 ? 5 : ti == 2 ? 30 : ti == 3 ? 31 : ti == 4 ? 63 : ti == 5 ? 64 : ti == 6 ? 100 : ti == 7 ? 511 : ti == 8 ? 512 : ti == 9 ? 1000 : ti == 10 ? 1023 : ti == 11 ? 1024 : ti == 12 ? 2047 : ti == 13 ? 2048 : ti == 14 ? 3000 : 4095;
        VAttnCtx C{}; C.smp = 0; C.b = b; C.g = g; C.t = t; C.pos = t; C.KC = (const bf16*)(ws + WS_KCP) + (size_t)(0 * 8 + bg) * 256 * 128; C.VC = (const bf16*)(ws + WS_KCP) + (size_t)(1 * 8 + bg) * 256 * 128;
        C.n_cmp = 255; C.n_blk = 64; const bf16* kv = (const bf16*)(ws + WS_KV);
        C.Ks = kv + (size_t)(((0 * 2 + 0) * 2 + b) * 4 + g) * SEQ * 128; C.Vs = kv + (size_t)(((0 * 2 + 1) * 2 + b) * 4 + g) * SEQ * 128;
        C.Kw = kv + (size_t)(((1 * 2 + 0) * 2 + b) * 4 + g) * SEQ * 128; C.Vw = kv + (size_t)(((1 * 2 + 1) * 2 + b) * 4 + g) * SEQ * 128;
        const bf16* qb = (const bf16*)(ws + WS_Q); const bf16* ao = (const bf16*)(ws + WS_AO) + (size_t)(b * SEQ + t) * DM + 4 * g * 128;
        vattn_unit(C, L, [=](int r, int d) { return bf2f(qb[((size_t)(b * 16 + 4 * g + r) * SEQ + t) * 128 + d]); }, (const float*)(ws + WS_GATES) + (size_t)(b * SEQ + t) * 48,
                   [&](int r, int d, float v) { chk_cmp(F, 3, bf2f(ao[r * 128 + d]), v, 2e-2f, 2e-3f); chk_cmp(F, 4, bf2f(ao[r * 128 + d]), v, 1e-1f, 2e-2f); }); }
}
__device__ void diag_emit(Frame& F) {
    const unsigned n0 = F.ctl[CW_CHK + 0] + F.ctl[CW_CHK + 1] + F.ctl[CW_CHK + 2] + F.ctl[CW_CHK + 3], n1 = F.ctl[CW_CHK + 11] + F.ctl[CW_CHK + 10];
    for (size_t i = (size_t)F.gw * 64 + F.lane; i < O_CMPP; i += (size_t)F.NGW * 64) { const bool skip = (i < O_YS) ? (i < n0) : ((i - O_YS) < n1); if (!skip) F.out[i] = 0.f; }
}
#endif
constexpr int NPH = 16;
constexpr size_t SM_XS2 = WS_SMP, SM_RSQ = WS_SMP + 1 * MiB, SM_RSK = SM_RSQ + 256 * 1024, SM_RSV = SM_RSK + 256 * 1024, SM_RSG = SM_RSV + 512 * 1024, SM_ROS = SM_RSG + 512 * 1024, SM_HS = SM_ROS + 512 * 1024;
__global__ void __launch_bounds__(NTHR, 2) mk_fwd(Args args) {
    extern __shared__ __attribute__((aligned(16))) unsigned char lds[];
    Frame F;
    F.lds = (LAS unsigned char*)lds;
    F.MISC = (volatile LAS unsigned*)(F.lds + MISC_OFF);
    F.tid = threadIdx.x; F.lane = F.tid & 63; F.wave = __builtin_amdgcn_readfirstlane(F.tid >> 6);
    F.G = gridDim.x; F.gw = blockIdx.x * NWAVES + F.wave; F.NGW = F.G * NWAVES;
    F.ws = args.ws; F.out = args.out; F.ctl = (gu32*)(args.ws + WS_CTL);
    unsigned char* ws = args.ws;
    for (int u = F.tid; u < (LDS_BYTES - LDSCTL_OFF) / 4; u += NTHR) ((LAS unsigned*)(F.lds + LDSCTL_OFF))[u] = 0u;
    __syncthreads();
#if MK_ONE_LAUNCH
    XcdBarrier bar = xcd_barrier_post((unsigned*)(F.ctl + CW_BAR), F.MISC + 8);
#define GRID_BAR() xcd_barrier(bar)
#else
#define GRID_BAR() do {} while (0)
#endif
    const int lo = args.ph_lo, hi = args.ph_hi;
#if MK_PROBE >= 0
    volatile LAS unsigned long long* TS = (volatile LAS unsigned long long*)(F.lds + LDSCTL_OFF + 8192);
#define STAMP(k) do { if (blockIdx.x == 0 && F.tid == 0) TS[(k)] = __builtin_amdgcn_s_memrealtime(); } while (0)
    STAMP(0);
#else
#define STAMP(k) do {} while (0)
#endif
#define IN(k) (lo <= (k) && (k) < hi)
#define REP(k) for (int rep_ = 0; rep_ < 1 + ((MK_DBL >> (k)) & 1); ++rep_)
#define DUP(k, ...) do { __VA_ARGS__; if ((MK_DBL >> (k)) & 1) { __VA_ARGS__; } } while (0)
#define BOTH(k) (IN(k) && IN((k) + 1))
#define GEMM_LDS ((PG8_LAS unsigned char*)(F.lds + RING_OFF))
#define BF(off) ((bf16*)(ws + (off)))
#define PBF(off) ((const pg8::bf16_t*)(ws + (off)))
    const float* ropeN = (const float*)(ws + WS_ROPEN); const float* ropeR = (const float*)(ws + WS_ROPER);
    float* ssq0 = (float*)(F.ctl + CW_SSQ); float* ssq1 = ssq0 + SSQ_STRIDE; float* ssq2 = ssq1 + SSQ_STRIDE; float* ssq3 = ssq2 + SSQ_STRIDE;
    float* H = (float*)(ws + WS_H1); float* HS = (float*)(ws + SM_HS);
    const float* norm_mix = args.in[7]; const float* norm_ffn = args.in[8];

#ifndef P1_TAIL_CHUNKS
#define P1_TAIL_CHUNKS 0
#endif
#define MK_P0ARGS P0Args{args.in[8], args.in[0], args.in[1], args.in[2], args.in[4], args.in[7], args.in[10], args.in[11], args.in[12], args.in[13], args.in[15], args.in[16], args.in[18], args.in[19], args.in[20], (const int*)args.in[6]}
    if (IN(0)) {
        const P0Args A = MK_P0ARGS; REP(0) p0_prologue(F, A);
        if (BOTH(0)) GRID_BAR(); STAMP(1);
    }
    if (IN(1)) {
        pg8::Gemm g{PBF(WS_XN), PBF(WS_WIN_T), MP, NSA_NP, DM}; pg8::StaticOrder S; S.init(MP, NSA_NP, F.G, (int)blockIdx.x);
        EpiNsaIn E{BF(WS_Q), BF(WS_KV), BF(WS_KVC), (float*)(ws + WS_GATES), F.out, ropeN};
        DUP(1, pg8::gemm_phase<EpiNsaIn, pg8::StaticOrder, true, true>(GEMM_LDS, g, S, E));
        if (F.G == 256 && blockIdx.x >= 160) { const P0Args A = MK_P0ARGS; posp_items(A, ws, F.lane, ((int)blockIdx.x - 160) * 8 + F.wave, 96 * 8); }
        p1_sample(F, BF(WS_XS), BF(WS_WIN_T), ropeN, (float*)(ws + WS_QS), (float*)(ws + WS_GATES) + (size_t)MP * 48);
        { const int nu = (MP / 256) * (NSA_NP / 256); if ((int)blockIdx.x + (nu / F.G) * F.G >= nu && (nu % F.G) != 0) { const P0Args A = MK_P0ARGS; unsigned* conv = (unsigned*)(F.ctl + CW_TMO + 48);
            for (int k = 0; k < P1_TAIL_CHUNKS; ++k) { const int c = next_work(F, conv); if (c >= N_CONV_CHUNKS) break; convert_chunk(F, A, c); } } }
        if (BOTH(1)) GRID_BAR(); STAMP(2);
    }
    if (IN(2)) {
        if (blockIdx.x == 0 && F.tid < 256) { const int e = F.tid >> 7, h = F.tid & 127; float a = args.in[14][F.tid]; const float* pp = (const float*)(ws + WS_POSP) + (size_t)e * 64 * 128 + h;
#pragma unroll 16
            for (int sl = 0; sl < 64; ++sl) a += pp[sl * 128];
            ((float*)(ws + WS_POSB))[F.tid] = a; }
        DUP(2, p2_sample_fused(F, args.in[2], (const int*)args.in[6]); p2_prompt_per(F));
        if (BOTH(2)) GRID_BAR(); STAMP(3);
    }
    if (IN(3)) { REP(3) p3_finish(F); if (BOTH(3)) GRID_BAR(); STAMP(4); }
    if (IN(4)) { { const P0Args A = MK_P0ARGS; p4_all(F, A, args.in[3], args.in[4], (const int*)args.in[6]); } if (BOTH(4)) GRID_BAR(); STAMP(5); }
    if (IN(5)) {
        pg8::Gemm g{PBF(WS_AO), PBF(WS_WO_T), MP, DM, DM}; pg8::StaticOrder S; S.init(MP, DM, F.G, (int)blockIdx.x);
        EpiResid<true> E{args.in[0], BF(WS_XN), ssq0};
        pg8::gemm_phase<EpiResid<true>, pg8::StaticOrder, true, true>(GEMM_LDS, g, S, E);
        skinny_resid(F, BF(WS_AOS), BF(WS_WO_T), DM, args.in[1], HS, BF(WS_XS), ssq0 + MP);
        if (BOTH(5)) GRID_BAR(); STAMP(6);
    }
    if (IN(6)) {
        pg8::Gemm g{PBF(WS_XN), PBF(WS_W1_T), MP, DFF, DM}; pg8::StaticOrder S; S.init(MP, DFF, F.G, (int)blockIdx.x);
        EpiFfn1 E{BF(WS_HFF), ssq0};
        DUP(6, pg8::gemm_phase<EpiFfn1, pg8::StaticOrder, true, true>(GEMM_LDS, g, S, E));
        skinny_ffn1(F, BF(WS_XS), BF(WS_W1_T), BF(WS_HFFS), ssq0 + MP);
        if (BOTH(6)) GRID_BAR(); STAMP(7);
    }
    if (IN(7)) {
        pg8::Gemm g{PBF(WS_HFF), PBF(WS_W2_T), MP, DM, DFF, LDH}; pg8::StaticOrder S; S.init(MP, DM, F.G, (int)blockIdx.x);
        EpiResid<false> E{nullptr, BF(WS_XN), ssq1};
        pg8::gemm_phase<EpiResid<false>, pg8::StaticOrder, true, true>(GEMM_LDS, g, S, E);
        skinny_resid(F, BF(WS_HFFS), BF(WS_W2_T), DFF, HS, HS, BF(WS_XS), ssq1 + MP);
        if (BOTH(7)) GRID_BAR(); STAMP(8);
    }
    if (IN(8)) {
        pg8::Gemm g{PBF(WS_XN), PBF(WS_RIN_T), MP, RET_N, DM}; pg8::StaticOrder S; S.init(MP, RET_N, F.G, (int)blockIdx.x);
        EpiRetIn E{BF(WS_RQ), BF(WS_RK), BF(WS_RV), BF(WS_RG), BF(WS_RKT), ropeR, ssq1};
        DUP(8, pg8::gemm_phase<EpiRetIn, pg8::StaticOrder, true, true>(GEMM_LDS, g, S, E));
        skinny_retin(F, BF(WS_XS), BF(WS_RIN_T), ropeR, ssq1 + MP, (float*)(ws + SM_RSQ), (float*)(ws + SM_RSK), (float*)(ws + SM_RSV), (float*)(ws + SM_RSG));
        if (BOTH(8)) GRID_BAR(); STAMP(9);
    }
    if (IN(9)) {
        if (blockIdx.x & 1) { p_ret_sample(F, args.in[5], (const float*)(ws + SM_RSQ), (const float*)(ws + SM_RSK), (const float*)(ws + SM_RSV), (float*)(ws + SM_ROS)); p_ret_s(F); }
        else { p_ret_s(F); p_ret_sample(F, args.in[5], (const float*)(ws + SM_RSQ), (const float*)(ws + SM_RSK), (const float*)(ws + SM_RSV), (float*)(ws + SM_ROS)); }
        if (BOTH(9)) GRID_BAR(); STAMP(10); }
    if (IN(10)) { REP(10) p_ret_scan(F); if (BOTH(10)) GRID_BAR(); STAMP(11); }
    if (IN(11)) { REP(11) p_ret_gn(F, args.in[17], (const float*)(ws + SM_ROS), (const float*)(ws + SM_RSG)); if (BOTH(11)) GRID_BAR(); STAMP(12); }
    if (IN(12)) {
        pg8::Gemm g{PBF(WS_RGA), PBF(WS_RO_T), MP, DM, 4096}; pg8::StaticOrder S; S.init(MP, DM, F.G, (int)blockIdx.x);
        EpiResid<false> E{nullptr, BF(WS_XN), ssq2};
        pg8::gemm_phase<EpiResid<false>, pg8::StaticOrder, true, true>(GEMM_LDS, g, S, E);
        skinny_resid(F, BF(WS_XS), BF(WS_RO_T), 4096, HS, HS, BF(SM_XS2), ssq2 + MP);
        if (BOTH(12)) GRID_BAR(); STAMP(13);
    }
    if (IN(13)) {
        pg8::Gemm g{PBF(WS_XN), PBF(WS_W1_T + (size_t)DM * DFF * 2), MP, DFF, DM}; pg8::StaticOrder S; S.init(MP, DFF, F.G, (int)blockIdx.x);
        EpiFfn1 E{BF(WS_HFF), ssq2};
        pg8::gemm_phase<EpiFfn1, pg8::StaticOrder, true, true>(GEMM_LDS, g, S, E);
        skinny_ffn1(F, BF(SM_XS2), BF(WS_W1_T + (size_t)DM * DFF * 2), BF(WS_HFFS), ssq2 + MP);
        if (BOTH(13)) GRID_BAR(); STAMP(14);
    }
    const bool fuse_final = (F.G == 256) && !MK_CHECK;
    if (IN(14)) {
        pg8::Gemm g{PBF(WS_HFF), PBF(WS_W2_T + (size_t)DM * DFF * 2), MP, DM, DFF, LDH}; pg8::StaticOrder S; S.init(MP, DM, F.G, (int)blockIdx.x);
        if (fuse_final) {
            EpiFinal E{BF(WS_XN), ssq3, (unsigned*)(F.ctl + CW_PANEL), args.in[9], F.out + O_YP};
            pg8::gemm_phase<EpiFinal, pg8::StaticOrder, true, true>(GEMM_LDS, g, S, E);
            skinny_final(F, BF(WS_HFFS), BF(WS_W2_T + (size_t)DM * DFF * 2), DFF, HS, ssq3 + MP, (unsigned*)(F.ctl + CW_PANEL + 64 * 32), args.in[9], F.out + O_YS);
        } else {
            EpiResid<false> E{nullptr, BF(WS_XN), ssq3};
            pg8::gemm_phase<EpiResid<false>, pg8::StaticOrder, true, true>(GEMM_LDS, g, S, E);
            skinny_resid(F, BF(WS_HFFS), BF(WS_W2_T + (size_t)DM * DFF * 2), DFF, HS, HS, BF(WS_XS), ssq3 + MP);
            if (BOTH(14)) GRID_BAR();
        }
        STAMP(15);
    }
    const unsigned skip0 = 0u, skip1 = 0u;
    if (IN(15) && !MK_CHECK && !fuse_final) { REP(15) p_final_norm(F, BF(WS_XN), HS, args.in[9], skip0, skip1); if (BOTH(15)) GRID_BAR(); STAMP(16); }
#if MK_PROBE >= 0
    if (blockIdx.x == 0 && F.tid == 0) {
        const unsigned long long t1 = __builtin_amdgcn_s_memrealtime(), span = TS[MK_PROBE + 1] - TS[MK_PROBE];
        while (__builtin_amdgcn_s_memrealtime() - t1 < 9ull * span) __builtin_amdgcn_s_sleep(32);
    }
#endif
#undef IN
#undef BOTH
}

#if MK_CHECK
__global__ void __launch_bounds__(NTHR, 2) mk_chk(Args args, int which) {
    extern __shared__ __attribute__((aligned(16))) unsigned char lds[];
    Frame F; F.lds = (LAS unsigned char*)lds; F.MISC = (volatile LAS unsigned*)(F.lds + MISC_OFF);
    F.tid = threadIdx.x; F.lane = F.tid & 63; F.wave = __builtin_amdgcn_readfirstlane(F.tid >> 6);
    F.G = gridDim.x; F.gw = blockIdx.x * NWAVES + F.wave; F.NGW = F.G * NWAVES; F.ws = args.ws; F.out = args.out; F.ctl = (gu32*)(args.ws + WS_CTL);
    if (which == 0) check_p1(F, args.in[0], args.in[1], args.in[7], args.in[10]);
    else if (which == 1) check_cmp(F, args.in[2], (const int*)args.in[6], args.in[12], args.in[13], args.in[14], args.in[15]);
    else if (which == 2) check_attn(F);
    else diag_emit(F);
}
#endif
extern "C" void kernel_launch(void* const* d_in, const int* in_sizes, int n_in, void* d_out, int out_size, void* d_ws, size_t ws_size, hipStream_t stream) {
    static int grid = 0;
    if (grid == 0) {
        if (n_in != 21 || (size_t)out_size != O_END || ws_size < WS_END) { fprintf(stderr, "kernel_launch: unexpected shapes: n_in %d out %d ws %zu\n", n_in, out_size, ws_size); grid = -1; return; }
        int dev = 0, cus = 0, per_cu = 0;
        if (hipGetDevice(&dev) != hipSuccess || hipDeviceGetAttribute(&cus, hipDeviceAttributeMultiprocessorCount, dev) != hipSuccess) { grid = -1; return; }
        if (hipFuncSetAttribute((const void*)mk_fwd, hipFuncAttributeMaxDynamicSharedMemorySize, LDS_BYTES) != hipSuccess) { fprintf(stderr, "kernel_launch: hipFuncSetAttribute failed\n"); grid = -1; return; }
        if (hipOccupancyMaxActiveBlocksPerMultiprocessor(&per_cu, (const void*)mk_fwd, NTHR, LDS_BYTES) != hipSuccess || per_cu < 1) { fprintf(stderr, "kernel_launch: occupancy query says %d\n", per_cu); }
        (void)hipGetLastError();
        grid = cus;
    }
    if (grid < 0) return;
    if (hipMemsetAsync((char*)d_ws + WS_CTL, 0, CTL_ZERO_BYTES, stream) != hipSuccess) return;
    Args a{};
    for (int i = 0; i < 21; ++i) a.in[i] = (const float*)d_in[i];
    a.out = (float*)d_out; a.ws = (unsigned char*)d_ws;
#if MK_ONE_LAUNCH
    a.ph_lo = 0; a.ph_hi = NPH;
    hipLaunchKernelGGL(mk_fwd, dim3(grid), dim3(NTHR), LDS_BYTES, stream, a);
#if MK_CHECK
    hipFuncSetAttribute((const void*)mk_chk, hipFuncAttributeMaxDynamicSharedMemorySize, LDS_BYTES);
    for (int w = 0; w < 4; ++w) hipLaunchKernelGGL(mk_chk, dim3(grid), dim3(NTHR), LDS_BYTES, stream, a, w);
#endif
#else
    for (int p = 0; p < NPH; ++p) { a.ph_lo = p; a.ph_hi = p + 1; hipLaunchKernelGGL(mk_fwd, dim3(grid), dim3(NTHR), LDS_BYTES, stream, a); }
#endif
}
```
